# Optimizing an MI355X kernel written in HIP

```python
import jax, jax.numpy as jnp
from jax import lax
import numpy as np

D_MODEL = 1024
BATCH = 2
SEQ = 16384
DEPTH = 4

GRID_W = 64
CTX_LEN = 256
EPS = 1e-6
MLA_HEADS = 8
MLA_NOPE = 64
MLA_ROPE = 32
MLA_V = 64
MLA_Q_RANK = 384
MLA_KV_RANK = 256
MLA_SCALE = (MLA_NOPE + MLA_ROPE) ** -0.5
ROPE_BASE = 10000.0
Q_BLOCK = 128
CM_CHUNK = 128
CM_GROUPS = 4
CM_GROUP_DIM = 128
CM_WIDTH = CM_GROUPS * CM_GROUP_DIM
GLA_HEADS = 4
GLA_DK = 128
GLA_DV = 256
GLA_GATE_RANK = 16
GLA_TAU = 16.0
GLA_CHUNK = 64
D_FF = 4 * D_MODEL

E_Q = MLA_Q_RANK
E_KV = E_Q + MLA_KV_RANK
E_R = E_KV + MLA_ROPE
E_U = E_R + CM_WIDTH
EVEN_IN = E_U + CM_WIDTH
EVEN_MIX = MLA_HEADS * MLA_V + CM_WIDTH
O_K = GLA_HEADS * GLA_DK
O_V = O_K + GLA_HEADS * GLA_DV
O_ZF = O_V + GLA_GATE_RANK
O_ZB = O_ZF + GLA_GATE_RANK
O_Q = O_ZB + GLA_HEADS * GLA_DK
ODD_MIX = GLA_HEADS * GLA_DV
ODD_IN = O_Q + ODD_MIX
N_EVEN = (DEPTH + 1) // 2
N_ODD = DEPTH // 2

kernel_name = "hybrid_mla_chunkmlp_gla_dit"

F32 = jnp.float32


def rmsnorm(x, g):
    xf = x.astype(F32)
    y = xf * lax.rsqrt(jnp.mean(xf * xf, axis=-1, keepdims=True) + EPS)
    return (y * g.astype(F32)).astype(x.dtype)


def modulate(h, shift, scale):
    return h * (1.0 + scale) + shift


def axial_rope_tables(length):
    rows = length // GRID_W
    r = jnp.repeat(jnp.arange(rows, dtype=F32), GRID_W)
    col = jnp.tile(jnp.arange(GRID_W, dtype=F32), rows)
    half = MLA_ROPE // 2
    inv = ROPE_BASE ** (-jnp.arange(0, half, 2, dtype=F32) / half)
    ang_r = r[:, None] * inv
    ang_c = col[:, None] * inv
    ang = jnp.concatenate([ang_r, ang_r, ang_c, ang_c], axis=-1)
    return jnp.cos(ang), jnp.sin(ang)


def apply_axial_rope(x, cos, sin):
    xs = x.reshape(x.shape[:-1] + (2, 2, MLA_ROPE // 4))
    rot = jnp.stack([-xs[..., 1, :], xs[..., 0, :]], axis=-2).reshape(x.shape)
    return (x.astype(F32) * cos + rot.astype(F32) * sin).astype(x.dtype)


def mla_kv(ckv_raw, kr_raw, kv_norm, w_ukv, cos, sin):
    ckv = rmsnorm(ckv_raw, kv_norm)
    kv = (ckv @ w_ukv).reshape(ckv.shape[:-1] + (MLA_HEADS, MLA_NOPE + MLA_V))
    k_rope = kr_raw if cos is None else apply_axial_rope(kr_raw, cos, sin)
    return kv[..., :MLA_NOPE], k_rope, kv[..., MLA_NOPE:]


def mla_q(cq_raw, q_norm, w_uq, cos, sin):
    q = (rmsnorm(cq_raw, q_norm) @ w_uq).reshape(cq_raw.shape[:-1] + (MLA_HEADS, MLA_NOPE + MLA_ROPE))
    q_nope, q_rope = q[..., :MLA_NOPE], q[..., MLA_NOPE:]
    if cos is not None:
        q_rope = apply_axial_rope(q_rope, cos[:, None, :], sin[:, None, :])
    return q_nope, q_rope


def mla_attend(q_nope, q_rope, k_nope, k_rope, v):
    s = (jnp.einsum('bqhd,bkhd->bhqk', q_nope, k_nope, preferred_element_type=F32)
         + jnp.einsum('bqhd,bkd->bhqk', q_rope, k_rope, preferred_element_type=F32)) * MLA_SCALE
    p = jax.nn.softmax(s, axis=-1).astype(v.dtype)
    return jnp.einsum('bhqk,bkhd->bqhd', p, v)


def mla_attend_blocks(q_nope, q_rope, k_nope, k_rope, v):
    B, L = q_nope.shape[:2]
    nb = L // Q_BLOCK
    qn = q_nope.reshape(B, nb, Q_BLOCK, MLA_HEADS, MLA_NOPE).transpose(1, 0, 2, 3, 4)
    qr = q_rope.reshape(B, nb, Q_BLOCK, MLA_HEADS, MLA_ROPE).transpose(1, 0, 2, 3, 4)
    out = lax.map(lambda qs: mla_attend(qs[0], qs[1], k_nope, k_rope, v), (qn, qr))
    return out.transpose(1, 0, 2, 3, 4).reshape(B, L, MLA_HEADS, MLA_V)


def chunk_mlp(u_raw, v_raw, v_norm, ws, bs):
    B, L = u_raw.shape[:2]
    n = L // CM_CHUNK
    u = jax.nn.gelu(u_raw)
    v = jax.nn.gelu(v_raw).reshape(B, n, CM_CHUNK, CM_GROUPS, CM_GROUP_DIM)
    v = rmsnorm(v, v_norm)
    v = jnp.einsum('gts,bnsgc->bntgc', ws, v) + bs.T[:, :, None]
    return u * v.reshape(B, L, CM_WIDTH)


def even_mixer(hl, hc, w_in, q_norm, w_uq, kv_norm, w_ukv, cm_norm, cm_ws, cm_bs, w_out, cos, sin, need_ctx):
    B, L = hl.shape[:2]
    pl = hl @ w_in
    if need_ctx:
        pc = hc @ w_in
        kvc = pc[..., E_Q:E_R]
    else:
        kvc = hc @ w_in[:, E_Q:E_R]
    kc_n, kc_r, vc = mla_kv(kvc[..., :MLA_KV_RANK], kvc[..., MLA_KV_RANK:], kv_norm, w_ukv, None, None)
    kl_n, kl_r, vl = mla_kv(pl[..., E_Q:E_KV], pl[..., E_KV:E_R], kv_norm, w_ukv, cos, sin)
    ql_n, ql_r = mla_q(pl[..., :E_Q], q_norm, w_uq, cos, sin)
    k_n = jnp.concatenate([kl_n, kc_n], axis=1)
    k_r = jnp.concatenate([kl_r, kc_r], axis=1)
    v_all = jnp.concatenate([vl, vc], axis=1)
    al = mla_attend_blocks(ql_n, ql_r, k_n, k_r, v_all)
    ml = chunk_mlp(pl[..., E_R:E_U], pl[..., E_U:], cm_norm, cm_ws, cm_bs)
    yl = jnp.concatenate([al.reshape(B, L, MLA_HEADS * MLA_V), ml], axis=-1) @ w_out
    yc = None
    if need_ctx:
        qc_n, qc_r = mla_q(pc[..., :E_Q], q_norm, w_uq, None, None)
        ac = mla_attend(qc_n, qc_r, kc_n, kc_r, vc)
        mc = chunk_mlp(pc[..., E_R:E_U], pc[..., E_U:], cm_norm, cm_ws, cm_bs)
        Lc = hc.shape[1]
        yc = jnp.concatenate([ac.reshape(B, Lc, MLA_HEADS * MLA_V), mc], axis=-1) @ w_out
    return yl, yc


def gla_log_decay(z, w_up, b):
    g = (z @ w_up + b).astype(F32)
    return (jax.nn.log_sigmoid(g) / GLA_TAU).reshape(z.shape[:2] + (GLA_HEADS, GLA_DK))


def gla_chunked(q, k, v, logd, s0):
    B, L = q.shape[:2]
    n = L // GLA_CHUNK

    def blk(t):
        return t.reshape(B, n, GLA_CHUNK, GLA_HEADS, t.shape[-1]).transpose(1, 0, 3, 2, 4)

    qb, kb, vb, gb = blk(q), blk(k), blk(v), blk(logd)
    bcum = jnp.cumsum(gb, axis=3)
    blast = bcum[..., -1:, :]
    q_t = qb * jnp.exp(bcum)
    k_t = kb * jnp.exp(-bcum)
    k_end = kb * jnp.exp(blast - bcum)
    mask = jnp.tril(jnp.ones((GLA_CHUNK, GLA_CHUNK), dtype=bool))
    a = jnp.where(mask, jnp.einsum('nbhtd,nbhsd->nbhts', q_t, k_t), 0.0)
    o_intra = jnp.einsum('nbhts,nbhsv->nbhtv', a, vb)
    decay = jnp.exp(blast[..., 0, :])

    def step(s, xs):
        qt, ke, vv, dc = xs
        o = jnp.einsum('bhtd,bhdv->bhtv', qt, s)
        s = dc[..., None] * s + jnp.einsum('bhtd,bhtv->bhdv', ke, vv)
        return s, o

    s_fin, o_inter = lax.scan(step, s0, (q_t, k_end, vb, decay))
    o = (o_intra + o_inter).transpose(1, 0, 3, 2, 4).reshape(B, L, GLA_HEADS, GLA_DV)
    return o, s_fin


def gla_final_state(k, v, logd):
    bcum = jnp.cumsum(logd, axis=1)
    kw = k * jnp.exp(bcum[:, -1:] - bcum)
    return jnp.einsum('blhd,blhv->bhdv', kw, v)


def gla_output(o, r_raw, o_norm, w_out, dtype):
    B, L = o.shape[:2]
    o = rmsnorm(o, o_norm).astype(dtype)
    r = jax.nn.silu(r_raw).reshape(B, L, GLA_HEADS, GLA_DV)
    return (o * r).reshape(B, L, ODD_MIX) @ w_out


def odd_mixer(hl, hc, w_in, w_gf, b_gf, w_gb, b_gb, o_norm, w_out, need_ctx):
    flip = lambda t: jnp.flip(t, axis=1)

    def state_inputs(p):
        shp = p.shape[:2]
        k = p[..., :O_K].reshape(shp + (GLA_HEADS, GLA_DK)).astype(F32)
        v = p[..., O_K:O_V].reshape(shp + (GLA_HEADS, GLA_DV)).astype(F32)
        return k, v, gla_log_decay(p[..., O_V:O_ZF], w_gf, b_gf), gla_log_decay(p[..., O_ZF:O_ZB], w_gb, b_gb)

    def query(p):
        return p[..., O_ZB:O_Q].reshape(p.shape[:2] + (GLA_HEADS, GLA_DK)).astype(F32) * (GLA_DK ** -0.5)

    B = hl.shape[0]
    pl = hl @ w_in
    pc = hc @ (w_in if need_ctx else w_in[:, :O_ZB])
    kc, vc, fc, bc = state_inputs(pc)
    yc = None
    if need_ctx:
        qc = query(pc)
        s0 = jnp.zeros((B, GLA_HEADS, GLA_DK, GLA_DV), F32)
        oc_f, s_f = gla_chunked(qc, kc, vc, fc, s0)
        oc_b, s_b = gla_chunked(flip(qc), flip(kc), flip(vc), flip(bc), s0)
        yc = gla_output(oc_f + flip(oc_b), pc[..., O_Q:], o_norm, w_out, hc.dtype)
    else:
        s_f = gla_final_state(kc, vc, fc)
        s_b = gla_final_state(flip(kc), flip(vc), flip(bc))
    kl, vl, fl, bl = state_inputs(pl)
    ql = query(pl)
    ol_f, _ = gla_chunked(ql, kl, vl, fl, s_f)
    ol_b, _ = gla_chunked(flip(ql), flip(kl), flip(vl), flip(bl), s_b)
    yl = gla_output(ol_f + flip(ol_b), pl[..., O_Q:], o_norm, w_out, hl.dtype)
    return yl, yc


def sqrelu_mlp(h, w1, w2):
    return jnp.square(jax.nn.relu(h @ w1)) @ w2


def setup_inputs(seed: int = 0) -> dict:
    key = jax.random.key(seed)
    ks = iter(jax.random.split(key, 40))
    D = D_MODEL

    def nrm(shape, scale):
        return jax.random.normal(next(ks), shape, F32) * scale

    return {
        "x": nrm((BATCH, SEQ, D), 1.0),
        "c": nrm((BATCH, D), 1.0),
        "ctx": nrm((BATCH, CTX_LEN, D), 1.0),
        "c_ctx": nrm((D,), 1.0),
        "ada_w": nrm((DEPTH, D, 6 * D), 0.5 * D ** -0.5),
        "ada_b": nrm((DEPTH, 6 * D), 0.02),
        "norm1_g": 1.0 + nrm((DEPTH, D), 0.02),
        "norm2_g": 1.0 + nrm((DEPTH, D), 0.02),
        "mlp_w1": nrm((DEPTH, D, D_FF), D ** -0.5),
        "mlp_w2": nrm((DEPTH, D_FF, D), D_FF ** -0.5),
        "ev_w_in": nrm((N_EVEN, D, EVEN_IN), D ** -0.5),
        "ev_q_norm": 1.0 + nrm((N_EVEN, MLA_Q_RANK), 0.02),
        "ev_w_uq": nrm((N_EVEN, MLA_Q_RANK, MLA_HEADS * (MLA_NOPE + MLA_ROPE)), MLA_Q_RANK ** -0.5),
        "ev_kv_norm": 1.0 + nrm((N_EVEN, MLA_KV_RANK), 0.02),
        "ev_w_ukv": nrm((N_EVEN, MLA_KV_RANK, MLA_HEADS * (MLA_NOPE + MLA_V)), MLA_KV_RANK ** -0.5),
        "ev_cm_norm": 1.0 + nrm((N_EVEN, CM_GROUP_DIM), 0.02),
        "ev_cm_ws": nrm((N_EVEN, CM_GROUPS, CM_CHUNK, CM_CHUNK), CM_CHUNK ** -0.5),
        "ev_cm_bs": 1.0 + nrm((N_EVEN, CM_GROUPS, CM_CHUNK), 0.02),
        "ev_w_out": nrm((N_EVEN, EVEN_MIX, D), EVEN_MIX ** -0.5),
        "od_w_in": nrm((N_ODD, D, ODD_IN), D ** -0.5),
        "od_w_gf": nrm((N_ODD, GLA_GATE_RANK, GLA_HEADS * GLA_DK), GLA_GATE_RANK ** -0.5),
        "od_b_gf": nrm((N_ODD, GLA_HEADS * GLA_DK), 0.02),
        "od_w_gb": nrm((N_ODD, GLA_GATE_RANK, GLA_HEADS * GLA_DK), GLA_GATE_RANK ** -0.5),
        "od_b_gb": nrm((N_ODD, GLA_HEADS * GLA_DK), 0.02),
        "od_o_norm": 1.0 + nrm((N_ODD, GLA_DV), 0.02),
        "od_w_out": nrm((N_ODD, ODD_MIX, D), ODD_MIX ** -0.5),
        "final_g": 1.0 + nrm((D,), 0.02),
    }


def reference(x, c, ctx, c_ctx, ada_w, ada_b, norm1_g, norm2_g, mlp_w1, mlp_w2,
              ev_w_in, ev_q_norm, ev_w_uq, ev_kv_norm, ev_w_ukv, ev_cm_norm, ev_cm_ws, ev_cm_bs, ev_w_out,
              od_w_in, od_w_gf, od_b_gf, od_w_gb, od_b_gb, od_o_norm, od_w_out, final_g):
    L = x.shape[1]
    cos, sin = axial_rope_tables(L)
    sc = jax.nn.silu(c)
    scc = jax.nn.silu(c_ctx)
    xl, xc = x, ctx
    for i in range(DEPTH):
        need_ctx = i < DEPTH - 1
        ml = [m[:, None, :] for m in jnp.split(sc @ ada_w[i] + ada_b[i], 6, axis=-1)]
        mc = jnp.split(scc @ ada_w[i] + ada_b[i], 6, axis=-1)
        hl = modulate(rmsnorm(xl, norm1_g[i]), ml[0], ml[1])
        hc = modulate(rmsnorm(xc, norm1_g[i]), mc[0], mc[1])
        if i % 2 == 0:
            j = i // 2
            yl, yc = even_mixer(hl, hc, ev_w_in[j], ev_q_norm[j], ev_w_uq[j], ev_kv_norm[j], ev_w_ukv[j],
                                ev_cm_norm[j], ev_cm_ws[j], ev_cm_bs[j], ev_w_out[j], cos, sin, need_ctx)
        else:
            j = i // 2
            yl, yc = odd_mixer(hl, hc, od_w_in[j], od_w_gf[j], od_b_gf[j], od_w_gb[j], od_b_gb[j],
                               od_o_norm[j], od_w_out[j], need_ctx)
        xl = xl + ml[2] * yl
        xl = xl + ml[5] * sqrelu_mlp(modulate(rmsnorm(xl, norm2_g[i]), ml[3], ml[4]), mlp_w1[i], mlp_w2[i])
        if need_ctx:
            xc = xc + mc[2] * yc
            xc = xc + mc[5] * sqrelu_mlp(modulate(rmsnorm(xc, norm2_g[i]), mc[3], mc[4]), mlp_w1[i], mlp_w2[i])
    return rmsnorm(xl, final_g)
```

```cpp
#include <hip/hip_runtime.h>
#include <hip/hip_cooperative_groups.h>
#include <cstdio>
namespace cg = cooperative_groups;

#define LAS __attribute__((address_space(3)))
typedef unsigned short bf16_t;
typedef short bf16x8 __attribute__((ext_vector_type(8)));
typedef short bf16x4 __attribute__((ext_vector_type(4)));
typedef float f32x4 __attribute__((ext_vector_type(4)));
typedef float f32x16 __attribute__((ext_vector_type(16)));
typedef unsigned u32x4 __attribute__((ext_vector_type(4)));
typedef unsigned u32x2 __attribute__((ext_vector_type(2)));

constexpr int R = 33280, RL = 32768, DM = 1024;
constexpr int LDPE = 1792, LDPO = 3328;
constexpr size_t MiB = (size_t)1 << 20;
constexpr size_t OFF_WIN = 0, OFF_WOUT = 8 * MiB, OFF_WUQ = 10 * MiB, OFF_WUKV = 11 * MiB, OFF_WCM = 12 * MiB, OFF_W1 = 13 * MiB, OFF_W2 = 21 * MiB;
constexpr size_t OFF_MOD = 30 * MiB, OFF_XC = 31 * MiB, OFF_RSQ = 33 * MiB, OFF_RSKV = 33 * MiB + 256 * 1024, OFF_GD = 36 * MiB + 640 * 1024;
constexpr size_t OFF_BAR = 33 * MiB + 768 * 1024;
constexpr size_t OFF_KMS = 33 * MiB + 800 * 1024;
constexpr size_t OFF_DECF = 34 * MiB, OFF_DECB = 35 * MiB + 512 * 1024;
constexpr size_t OFF_H = 37 * MiB, OFF_MIX = 102 * MiB, OFF_BIG = 167 * MiB, OFF_G = 427 * MiB;
constexpr size_t OFF_Q = OFF_BIG + 114 * MiB, OFF_KV = OFF_BIG + 163 * MiB, OFF_KR = OFF_BIG + 228 * MiB;
constexpr size_t OFF_QTF = OFF_H, OFF_KTF = OFF_H + 34078720, OFF_QTB = OFF_BIG + 212 * MiB, OFF_SLOC = OFF_G, OFF_KTB = OFF_G + 34 * MiB;
constexpr size_t OFF_PART = 494 * MiB;
constexpr size_t WS_NEED = 510 * MiB;
constexpr int LDS_BYTES = 144 * 1024;

struct Params {
    const float* in[27];
    float* out;
    unsigned char* ws;
    long long flags;
};

__device__ __forceinline__ float bf2f(bf16_t b) { return __uint_as_float(((unsigned)b) << 16); }
__device__ __forceinline__ float bflo(unsigned u) { return __uint_as_float(u << 16); }
__device__ __forceinline__ float bfhi(unsigned u) { return __uint_as_float(u & 0xffff0000u); }
__device__ __forceinline__ bf16_t f2bf(float f) { unsigned u = __float_as_uint(f); u += 0x7FFFu + ((u >> 16) & 1u); return (bf16_t)(u >> 16); }
typedef __bf16 hwbf2_t __attribute__((ext_vector_type(2)));
typedef float f32x2v_t __attribute__((ext_vector_type(2)));
__device__ __forceinline__ unsigned pk2(float lo, float hi) { const f32x2v_t v = {lo, hi}; const hwbf2_t b = __builtin_convertvector(v, hwbf2_t); return __builtin_bit_cast(unsigned, b); }
__device__ __forceinline__ bf16x8 pack8(float a0, float a1, float a2, float a3, float a4, float a5, float a6, float a7) {
    u32x4 u = {pk2(a0, a1), pk2(a2, a3), pk2(a4, a5), pk2(a6, a7)};
    return __builtin_bit_cast(bf16x8, u);
}
__device__ __forceinline__ float wsum(float v) {
#pragma unroll
    for (int o = 32; o >= 1; o >>= 1) v += __shfl_xor(v, o);
    return v;
}
__device__ __forceinline__ float gelu_t(float x) { const float u = 0.7978845608f * (x + 0.044715f * x * x * x); return x / (1.f + __expf(-2.f * u)); }
__device__ __forceinline__ float silu_f(float x) { return x / (1.f + __expf(-x)); }
__device__ __forceinline__ void sincos_red(float ang, float& s, float& c) {
    const float k = rintf(ang * 0.15915494309f);
    float r = fmaf(-k, 6.2831854820251465f, ang);
    r = fmaf(-k, -1.7484555e-7f, r);
    s = __sinf(r); c = __cosf(r);
}
__device__ __forceinline__ float rope_inv(int jj) { return exp2f(-(float)jj * 1.6609640474f); }

__device__ __forceinline__ bf16x4 tr16(LAS unsigned char* a) { return __builtin_amdgcn_ds_read_tr16_b64_v4i16((LAS bf16x4*)a); }
__device__ __forceinline__ bf16x8 tr_nat(LAS unsigned char* base, int stride, int k0, int n0, int lane) {
    const int i = lane & 15, q = i >> 2, pq = i & 3, hh = lane >> 5, g1 = (lane >> 4) & 1;
    LAS unsigned char* a0 = base + (k0 + 8 * hh + q) * stride + (n0 + 16 * g1 + 4 * pq) * 2;
    const bf16x4 x = tr16(a0), y = tr16(a0 + 4 * stride);
    return __builtin_shufflevector(x, y, 0, 1, 2, 3, 4, 5, 6, 7);
}
__device__ __forceinline__ bf16x8 tr_perm(LAS unsigned char* base, int stride, int k0, int n0, int lane) {
    const int i = lane & 15, q = i >> 2, pq = i & 3, hh = lane >> 5, g1 = (lane >> 4) & 1;
    LAS unsigned char* a0 = base + (k0 + 4 * hh + q) * stride + (n0 + 16 * g1 + 4 * pq) * 2;
    const bf16x4 x = tr16(a0), y = tr16(a0 + 8 * stride);
    return __builtin_shufflevector(x, y, 0, 1, 2, 3, 4, 5, 6, 7);
}
__device__ __forceinline__ int ltid() { int t = threadIdx.x; asm volatile("" : "+v"(t)); return t; }
#define MFMA32(a, b, c) __builtin_amdgcn_mfma_f32_32x32x16_bf16((a), (b), (c), 0, 0, 0)

namespace pg8 {
constexpr int BM = 256, BK = 64, HALF = 128, HTB = HALF * BK * 2, STAGE_BYTES = 8 * HTB, NXCD = 8, WGM = 8;
__device__ __forceinline__ int lds_byte(int r, int c) { const int st = (r >> 4) * 2 + (c >> 5), rr = r & 15, cc = c & 31, ob = rr * 64 + cc * 2; return st * 1024 + (ob ^ (((ob >> 9) & 1) << 5)); }
__device__ __forceinline__ void stage_rc(int b, int& Rr, int& C) { const int st = b / 1024, sb = b % 1024, swz = sb ^ (((sb >> 9) & 1) << 5); Rr = (st >> 1) * 16 + swz / 64; C = (st & 1) * 32 + (swz % 64) / 2; }
__device__ __forceinline__ int perm32(int rho) { const int n = rho >> 4, i = rho & 15; return 8 * (i >> 2) + 4 * n + (i & 3); }
struct Unit { int pm, pn, ko; };
struct Gemm { const bf16_t* A; const bf16_t* Bt; int lda, ldb, M, N, K; };
struct StaticOrder {
    int nM, nN, nwg, G, c;
    __device__ void init(int M, int N, int G_, int c_) { nM = M / BM; nN = N / BM; nwg = nM * nN; G = G_; c = c_; }
    __device__ bool next(int i, Unit& u) const {
        const long L = (long)i * G + c; if (L >= nwg) return false;
        int wgid = (int)L; { const int q = nwg / NXCD, r = nwg % NXCD, xcd = wgid % NXCD, off = wgid / NXCD; wgid = (xcd < r ? xcd * (q + 1) : r * (q + 1) + (xcd - r) * q) + off; }
        const int nig = WGM * nN, gid = wgid / nig, fm = gid * WGM, gsz = (nM - fm) < WGM ? (nM - fm) : WGM;
        u.pm = fm + ((wgid % nig) % gsz); u.pn = (wgid % nig) / gsz; u.ko = 0; return true;
    }
};
struct PieceOrder {
    int nP, Kp, G, c;
    __device__ bool next(int i, Unit& u) const {
        const long L = (long)i * G + c; if (L >= 8 * nP) return false;
        const int kp = (int)L >> 3, r = (int)L & 7; u.pm = r >> 2; u.pn = r & 3; u.ko = kp * Kp; return true;
    }
};

template <class Epi, class Sched>
__device__ __forceinline__ void gemm_phase(LAS unsigned char* lds, const Gemm g, const Sched& S, const Epi& E) {
    const int tid = ltid(), wid = __builtin_amdgcn_readfirstlane(tid >> 6), lane = tid & 63, wr = wid >> 2, wc = wid & 3, fr = lane & 15, fq = lane >> 4;
    const int K = g.K, nt = K / BK;
    unsigned voffA[2], voffB[2];
#pragma unroll
    for (int i = 0; i < 2; ++i) { int Rr, C; stage_rc(tid * 16 + i * 8192, Rr, C); const int Rb = Epi::PERM ? ((Rr & ~31) + perm32(Rr & 31)) : Rr;
        voffA[i] = (unsigned)(Rr * g.lda + C) * 2u; voffB[i] = (unsigned)(Rb * g.ldb + C) * 2u; }
    const size_t kstep = (size_t)(BK * 2);
    const size_t hA = (size_t)HALF * g.lda * 2, hB = (size_t)HALF * g.ldb * 2;
    const size_t tA = 2 * hA, tB = 2 * hB;
    const unsigned ldsw = (unsigned)wid * 1024u;
    const int aoff = lds_byte(wr * 64 + fr, fq * 8), boff = lds_byte(wc * 32 + fr, fq * 8);
#define PG8_SA(b, h) (((b) * 2 + (h)) * HTB)
#define PG8_SB(b, h) ((4 + (b) * 2 + (h)) * HTB)
#define PG8_STAGE(bufoff, gbase, voff) do { _Pragma("unroll") for (int _i = 0; _i < 2; ++_i) \
        __builtin_amdgcn_global_load_lds((const unsigned*)((const char*)(gbase) + (voff)[_i]), (LAS unsigned*)(lds + (bufoff) + ldsw + _i * 8192), 16, 0, 0); } while (0)
#define PG8_LDA(dst, b, h) do { _Pragma("unroll") for (int m = 0; m < 4; ++m) _Pragma("unroll") for (int k = 0; k < 2; ++k) dst[m][k] = *(const LAS bf16x8*)(lds + PG8_SA(b, h) + aoff + m * 2048 + k * 1024); } while (0)
#define PG8_LDB(dst, b, h) do { _Pragma("unroll") for (int n = 0; n < 2; ++n) _Pragma("unroll") for (int k = 0; k < 2; ++k) dst[n][k] = *(const LAS bf16x8*)(lds + PG8_SB(b, h) + boff + n * 2048 + k * 1024); } while (0)
#define PG8_MMA(ai, bj, At, Bt) do { __builtin_amdgcn_s_setprio(1); _Pragma("unroll") for (int m = 0; m < 4; ++m) _Pragma("unroll") for (int n = 0; n < 2; ++n) _Pragma("unroll") for (int k = 0; k < 2; ++k) \
        acc[ai][bj][m][n] = __builtin_amdgcn_mfma_f32_16x16x32_bf16(Bt[n][k], At[m][k], acc[ai][bj][m][n], 0, 0, 0); __builtin_amdgcn_s_setprio(0); } while (0)
#define PG8_WAIT_V(n) asm volatile("s_waitcnt vmcnt(" #n ")" ::: "memory")
#define PG8_WAIT_L(n) asm volatile("s_waitcnt lgkmcnt(" #n ")" ::: "memory")
#define PG8_BAR __builtin_amdgcn_s_barrier()
#define PG8_SCHED __builtin_amdgcn_sched_barrier(0)
    Unit cur, nxt; int ui = 0;
    if (!S.next(0, cur)) return;
    f32x4 acc[2][2][4][2];
#pragma unroll
    for (int a = 0; a < 2; ++a)
#pragma unroll
        for (int b = 0; b < 2; ++b)
#pragma unroll
            for (int m = 0; m < 4; ++m)
#pragma unroll
                for (int n = 0; n < 2; ++n) acc[a][b][m][n] = (f32x4){0.f, 0.f, 0.f, 0.f};
    bf16x8 At[4][2], B0[2][2], B1[2][2];
    const char* cA = (const char*)g.A + (size_t)cur.pm * tA + (size_t)cur.ko * 2; const char* cB = (const char*)g.Bt + (size_t)cur.pn * tB + (size_t)cur.ko * 2;
    PG8_STAGE(PG8_SB(0, 0), cB, voffB); PG8_STAGE(PG8_SA(0, 0), cA, voffA); PG8_STAGE(PG8_SB(0, 1), cB + hB, voffB); PG8_STAGE(PG8_SA(0, 1), cA + hA, voffA);
    if (wr == 1) PG8_BAR;
    PG8_WAIT_V(4); PG8_BAR;
    PG8_STAGE(PG8_SB(1, 0), cB + kstep, voffB); PG8_STAGE(PG8_SA(1, 0), cA + kstep, voffA); PG8_STAGE(PG8_SB(1, 1), cB + hB + kstep, voffB);
    PG8_WAIT_V(6); PG8_BAR;
    for (;;) {
        const bool has_next = S.next(ui + 1, nxt);
        const char* nA = has_next ? (const char*)g.A + (size_t)nxt.pm * tA + (size_t)nxt.ko * 2 : cA; const char* nB = has_next ? (const char*)g.Bt + (size_t)nxt.pn * tB + (size_t)nxt.ko * 2 : cB;
        for (int t = 0; t < nt; t += 2) {
            const bool last = (t == nt - 2);
            const char* a1 = cA + (size_t)(t + 1) * kstep;
            const char* a2 = last ? nA : cA + (size_t)(t + 2) * kstep; const char* b2 = last ? nB : cB + (size_t)(t + 2) * kstep;
            const char* a3 = a2 + kstep; const char* b3 = b2 + kstep;
            PG8_LDB(B0, 0, 0); PG8_SCHED; PG8_LDA(At, 0, 0); PG8_STAGE(PG8_SA(1, 1), a1 + hA, voffA);
            PG8_WAIT_L(8); PG8_BAR; PG8_WAIT_L(0); PG8_MMA(0, 0, At, B0); PG8_BAR; PG8_SCHED;
            PG8_LDB(B1, 0, 1); PG8_STAGE(PG8_SB(0, 0), b2, voffB);
            PG8_BAR; PG8_WAIT_L(0); PG8_MMA(0, 1, At, B1); PG8_BAR;
            PG8_LDA(At, 0, 1); PG8_STAGE(PG8_SA(0, 0), a2, voffA);
            PG8_BAR; PG8_WAIT_L(0); PG8_MMA(1, 0, At, B0); PG8_BAR; PG8_SCHED;
            PG8_STAGE(PG8_SB(0, 1), b2 + hB, voffB);
            PG8_WAIT_V(6); PG8_BAR; PG8_MMA(1, 1, At, B1); PG8_BAR;
            PG8_LDB(B0, 1, 0); PG8_SCHED; PG8_LDA(At, 1, 0); PG8_STAGE(PG8_SA(0, 1), a2 + hA, voffA);
            PG8_WAIT_L(8); PG8_BAR; PG8_WAIT_L(0); PG8_MMA(0, 0, At, B0); PG8_BAR; PG8_SCHED;
            PG8_LDB(B1, 1, 1); PG8_STAGE(PG8_SB(1, 0), b3, voffB);
            PG8_BAR; PG8_WAIT_L(0); PG8_MMA(0, 1, At, B1); PG8_BAR;
            PG8_LDA(At, 1, 1); PG8_STAGE(PG8_SA(1, 0), a3, voffA);
            PG8_BAR; PG8_WAIT_L(0); PG8_MMA(1, 0, At, B0); PG8_BAR; PG8_SCHED;
            PG8_STAGE(PG8_SB(1, 1), b3 + hB, voffB);
            PG8_WAIT_V(6); PG8_BAR; PG8_MMA(1, 1, At, B1); PG8_BAR;
        }
        E(acc, cur, wr, wc, fr, fq);
        if (!has_next) break;
#pragma unroll
        for (int a = 0; a < 2; ++a)
#pragma unroll
            for (int b = 0; b < 2; ++b)
#pragma unroll
                for (int m = 0; m < 4; ++m)
#pragma unroll
                    for (int n = 0; n < 2; ++n) acc[a][b][m][n] = (f32x4){0.f, 0.f, 0.f, 0.f};
        cur = nxt; cA = nA; cB = nB; ++ui;
    }
    PG8_WAIT_V(0);
    if (wr == 0) PG8_BAR;
    PG8_BAR;
#undef PG8_SA
#undef PG8_SB
#undef PG8_STAGE
#undef PG8_LDA
#undef PG8_LDB
#undef PG8_MMA
#undef PG8_WAIT_V
#undef PG8_WAIT_L
#undef PG8_BAR
#undef PG8_SCHED
}

struct EpiB {
    static constexpr bool PERM = true;
    bf16_t* O; int ldo; const float* rs; int mode;
    __device__ __forceinline__ void operator()(const f32x4 (&acc)[2][2][4][2], const Unit& u, int wr, int wc, int fr, int fq) const {
        const int row0 = u.pm * BM + wr * 64 + fr, col0 = u.pn * BM + wc * 32 + 8 * fq;
#pragma unroll
        for (int ai = 0; ai < 2; ++ai)
#pragma unroll
            for (int m = 0; m < 4; ++m) {
                const int row = row0 + ai * HALF + m * 16;
                const float s = rs ? rs[row] : 1.f;
                bf16_t* rowp = O + (size_t)row * ldo + col0;
#pragma unroll
                for (int bj = 0; bj < 2; ++bj) {
                    f32x4 v0 = acc[ai][bj][m][0] * s, v1 = acc[ai][bj][m][1] * s;
                    if (mode == 1) {
#pragma unroll
                        for (int e = 0; e < 4; ++e) { const float a = fmaxf(v0[e], 0.f), b = fmaxf(v1[e], 0.f); v0[e] = a * a; v1[e] = b * b; }
                    }
                    const u32x4 o = {pk2(v0[0], v0[1]), pk2(v0[2], v0[3]), pk2(v1[0], v1[1]), pk2(v1[2], v1[3])};
                    *(u32x4*)(rowp + bj * HALF) = o;
                }
            }
    }
};
struct EpiR {
    static constexpr bool PERM = false;
    const float* xin_l; const float* xin_c; float* xout_l; float* xout_c; const float* gate;
    __device__ __forceinline__ void operator()(const f32x4 (&acc)[2][2][4][2], const Unit& u, int wr, int wc, int fr, int fq) const {
        const int var = u.pm < 64 ? 0 : (u.pm < 128 ? 1 : 2);
        const float* gp = gate + var * 6144;
        const int rowt = (u.pm < 128 ? u.pm : u.pm - 128) * BM + wr * 64 + fr;
        const float* xi = u.pm < 128 ? xin_l : xin_c; float* xo = u.pm < 128 ? xout_l : xout_c;
        const int col0 = u.pn * BM + wc * 32 + 4 * fq;
        f32x4 gv[2][2];
#pragma unroll
        for (int bj = 0; bj < 2; ++bj)
#pragma unroll
            for (int n = 0; n < 2; ++n) gv[bj][n] = *(const f32x4*)(gp + col0 + bj * HALF + n * 16);
#pragma unroll
        for (int ai = 0; ai < 2; ++ai)
#pragma unroll
            for (int m = 0; m < 4; ++m) {
                const size_t ro = (size_t)(rowt + ai * HALF + m * 16) * DM + col0;
#pragma unroll
                for (int bj = 0; bj < 2; ++bj)
#pragma unroll
                    for (int n = 0; n < 2; ++n) {
                        const f32x4 x = *(const f32x4*)(xi + ro + bj * HALF + n * 16);
                        *(f32x4*)(xo + ro + bj * HALF + n * 16) = x + gv[bj][n] * acc[ai][bj][m][n];
                    }
            }
    }
};
struct EpiP {
    static constexpr bool PERM = false;
    float* part; int kpiece;
    __device__ __forceinline__ void operator()(const f32x4 (&acc)[2][2][4][2], const Unit& u, int wr, int wc, int fr, int fq) const {
        const int kp = u.ko / kpiece;
        const int rowt = u.pm * BM + wr * 64 + fr, col0 = u.pn * BM + wc * 32 + 4 * fq;
        float* base = part + (size_t)kp * 512 * DM;
#pragma unroll
        for (int ai = 0; ai < 2; ++ai)
#pragma unroll
            for (int m = 0; m < 4; ++m) {
                const size_t ro = (size_t)(rowt + ai * HALF + m * 16) * DM + col0;
#pragma unroll
                for (int bj = 0; bj < 2; ++bj)
#pragma unroll
                    for (int n = 0; n < 2; ++n) *(f32x4*)(base + ro + bj * HALF + n * 16) = acc[ai][bj][m][n];
            }
    }
};
}

template <class Epi>
__device__ __forceinline__ void run_gemm(LAS unsigned char* lds, const bf16_t* A, int lda, const bf16_t* Bt, int ldb, int M, int N, int K, const Epi& E, bool rev = false) {
    pg8::Gemm g; g.A = A; g.Bt = Bt; g.lda = lda; g.ldb = ldb; g.M = M; g.N = N; g.K = K;
    pg8::StaticOrder S; S.init(M, N, (int)gridDim.x, rev ? (int)(gridDim.x - 1 - blockIdx.x) : (int)blockIdx.x);
    pg8::gemm_phase<Epi, pg8::StaticOrder>(lds, g, S, E);
}
__device__ __forceinline__ void run_pieces(LAS unsigned char* lds, const bf16_t* A, int lda, const bf16_t* Bt, int ldb, int nP, int Kp, float* part) {
    pg8::Gemm g; g.A = A; g.Bt = Bt; g.lda = lda; g.ldb = ldb; g.M = 512; g.N = 1024; g.K = Kp;
    pg8::PieceOrder S; S.nP = nP; S.Kp = Kp; S.G = (int)gridDim.x; S.c = (int)blockIdx.x;
    pg8::EpiP E; E.part = part; E.kpiece = Kp;
    pg8::gemm_phase<pg8::EpiP, pg8::PieceOrder>(lds, g, S, E);
}

__device__ void phase_ada(const Params& p, unsigned char* ldsg) {
    float* sl = (float*)ldsg;
    float* red = sl + 3072;
    const int tid = ltid();
    float* MOD = (float*)(p.ws + OFF_MOD);
    for (int idx = tid; idx < 3072; idx += 512) { const int var = idx >> 10, k = idx & 1023; const float v = var < 2 ? p.in[1][var * 1024 + k] : p.in[3][k]; sl[idx] = silu_f(v); }
    __syncthreads();
    for (int item = blockIdx.x; item < 192; item += gridDim.x) {
        const int i = item / 48, cb = item % 48, cc = tid & 127, kq = tid >> 7, col = cb * 128 + cc;
        const float* w = p.in[4] + ((size_t)i * 1024 + kq * 256) * 6144 + col;
        const float* s0 = sl + kq * 256;
        float a0 = 0.f, a1 = 0.f, a2 = 0.f;
#pragma unroll 8
        for (int k = 0; k < 256; ++k) { const float wv = w[(size_t)k * 6144]; a0 = fmaf(s0[k], wv, a0); a1 = fmaf(s0[1024 + k], wv, a1); a2 = fmaf(s0[2048 + k], wv, a2); }
        red[(kq * 3 + 0) * 128 + cc] = a0; red[(kq * 3 + 1) * 128 + cc] = a1; red[(kq * 3 + 2) * 128 + cc] = a2;
        __syncthreads();
        if (tid < 384) { const int var = tid >> 7, c2 = tid & 127; float s = p.in[5][i * 6144 + cb * 128 + c2];
#pragma unroll
            for (int q = 0; q < 4; ++q) s += red[(q * 3 + var) * 128 + c2];
            MOD[(size_t)(i * 3 + var) * 6144 + cb * 128 + c2] = s; }
        __syncthreads();
    }
}

__device__ void tjob(const float* src, int K, int N, int Npad, bf16_t* dst, const float* rs, float mult, unsigned char* ldsg) {
    float* tile = (float*)ldsg;
    const int tid = ltid(), ntk = K / 64, ntn = Npad / 64;
    for (int t = blockIdx.x; t < ntk * ntn; t += gridDim.x) {
        const int tk = t % ntk, tn = t / ntk;
        const int nl = tid & 63, kl0 = tid >> 6;
#pragma unroll
        for (int j = 0; j < 8; ++j) { const int kl = kl0 + 8 * j, k = tk * 64 + kl, n = tn * 64 + nl;
            float v = n < N ? src[(size_t)k * N + n] : 0.f; if (rs) v *= rs[k]; tile[kl * 65 + nl] = v * mult; }
        __syncthreads();
        const int nl2 = tid >> 3, kc = tid & 7;
        u32x4 o;
#pragma unroll
        for (int e = 0; e < 4; ++e) o[e] = pk2(tile[(kc * 8 + 2 * e) * 65 + nl2], tile[(kc * 8 + 2 * e + 1) * 65 + nl2]);
        *(u32x4*)(dst + (size_t)(tn * 64 + nl2) * K + tk * 64 + kc * 8) = o;
        __syncthreads();
    }
}
__device__ void phase_weights(const Params& p, int i, unsigned char* ldsg) {
    unsigned char* ws = p.ws; const int j = i >> 1;
    if (!(i & 1)) {
        tjob(p.in[10] + (size_t)j * 1024 * 1696, 1024, 1696, 1792, (bf16_t*)(ws + OFF_WIN), nullptr, 1.f, ldsg);
        tjob(p.in[12] + (size_t)j * 384 * 768, 384, 768, 768, (bf16_t*)(ws + OFF_WUQ), p.in[11] + j * 384, 0.10206207262f * 1.44269504089f, ldsg);
        tjob(p.in[14] + (size_t)j * 256 * 1024, 256, 1024, 1024, (bf16_t*)(ws + OFF_WUKV), p.in[13] + j * 256, 1.f, ldsg);
        tjob(p.in[18] + (size_t)j * 1024 * 1024, 1024, 1024, 1024, (bf16_t*)(ws + OFF_WOUT), nullptr, 1.f, ldsg);
        bf16_t* wcm = (bf16_t*)(ws + OFF_WCM); const float* src = p.in[16] + (size_t)j * 65536;
        for (int e = blockIdx.x * 512 + ltid(); e < 65536; e += gridDim.x * 512) wcm[e] = f2bf(src[e]);
    } else {
        tjob(p.in[19] + (size_t)j * 1024 * 3104, 1024, 3104, 3328, (bf16_t*)(ws + OFF_WIN), nullptr, 1.f, ldsg);
        tjob(p.in[25] + (size_t)j * 1024 * 1024, 1024, 1024, 1024, (bf16_t*)(ws + OFF_WOUT), nullptr, 1.f, ldsg);
    }
    tjob(p.in[8] + (size_t)i * 1024 * 4096, 1024, 4096, 4096, (bf16_t*)(ws + OFF_W1), nullptr, 1.f, ldsg);
    tjob(p.in[9] + (size_t)i * 4096 * 1024, 4096, 1024, 1024, (bf16_t*)(ws + OFF_W2), nullptr, 1.f, ldsg);
}

__device__ void phase_norm(const float* xl, const float* xc, const float* g, const float* mod  , int shift_i, int scale_i, bf16_t* H,
                           int nrows, const float* part, int npart, const float* pgate, float* xc_out) {
    const int lane = ltid() & 63, gw = blockIdx.x * 8 + (ltid() >> 6), nw = gridDim.x * 8;
    for (int row = gw; row < nrows; row += nw) {
        const float* src = row < RL ? xl + (size_t)row * DM : xc + (size_t)(row - RL) * DM;
        const int var = row < 16384 ? 0 : (row < RL ? 1 : 2);
        const float* sh = mod + var * 6144 + shift_i * 1024; const float* sc = mod + var * 6144 + scale_i * 1024;
        f32x4 x[4]; float ss = 0.f;
#pragma unroll
        for (int q = 0; q < 4; ++q) x[q] = *(const f32x4*)(src + q * 256 + lane * 4);
        if (row >= RL && part) {
#pragma unroll
            for (int q = 0; q < 4; ++q) { const int c = q * 256 + lane * 4;
                f32x4 acc = {0.f, 0.f, 0.f, 0.f};
                for (int kp = 0; kp < npart; ++kp) acc += *(const f32x4*)(part + ((size_t)kp * 512 + (row - RL)) * DM + c);
                x[q] += *(const f32x4*)(pgate + c) * acc;
                *(f32x4*)(xc_out + (size_t)(row - RL) * DM + c) = x[q]; }
        }
#pragma unroll
        for (int q = 0; q < 4; ++q) ss += x[q][0] * x[q][0] + x[q][1] * x[q][1] + x[q][2] * x[q][2] + x[q][3] * x[q][3];
        ss = wsum(ss);
        const float rstd = rsqrtf(ss * (1.f / 1024.f) + 1e-6f);
#pragma unroll
        for (int q = 0; q < 4; ++q) { const int c = q * 256 + lane * 4;
            const f32x4 gg = *(const f32x4*)(g + c), s1 = *(const f32x4*)(sc + c), s0 = *(const f32x4*)(sh + c);
            float o[4];
#pragma unroll
            for (int e = 0; e < 4; ++e) o[e] = x[q][e] * rstd * gg[e] * (1.f + s1[e]) + s0[e];
            const u32x2 pk = {pk2(o[0], o[1]), pk2(o[2], o[3])};
            *(u32x2*)(H + (size_t)row * DM + c) = pk; }
    }
}
__device__ void phase_final(const float* g, float* X) {
    const int lane = ltid() & 63, gw = blockIdx.x * 8 + (ltid() >> 6), nw = gridDim.x * 8;
    for (int row = gw; row < RL; row += nw) {
        float* src = X + (size_t)row * DM;
        f32x4 x[4]; float ss = 0.f;
#pragma unroll
        for (int q = 0; q < 4; ++q) { x[q] = *(const f32x4*)(src + q * 256 + lane * 4); ss += x[q][0] * x[q][0] + x[q][1] * x[q][1] + x[q][2] * x[q][2] + x[q][3] * x[q][3]; }
        ss = wsum(ss);
        const float rstd = rsqrtf(ss * (1.f / 1024.f) + 1e-6f);
#pragma unroll
        for (int q = 0; q < 4; ++q) { const int c = q * 256 + lane * 4; const f32x4 gg = *(const f32x4*)(g + c); *(f32x4*)(src + c) = x[q] * rstd * gg; }
    }
}

__device__ void phase_even_prep(const Params& p, int j, unsigned char* ldsg) {
    unsigned char* ws = p.ws;
    const bf16_t* P = (const bf16_t*)(ws + OFF_BIG);
    float* RSQ = (float*)(ws + OFF_RSQ); float* RSKV = (float*)(ws + OFF_RSKV);
    bf16_t* KR = (bf16_t*)(ws + OFF_KR); bf16_t* MIX = (bf16_t*)(ws + OFF_MIX);
    const int tid = ltid(), lane = tid & 63, w = tid >> 6, l32 = lane & 31, hh = lane >> 5;
    {
        const int gw = blockIdx.x * 8 + w, nw = gridDim.x * 8;
        for (int row = gw; row < R; row += nw) {
            const bf16_t* pr = P + (size_t)row * LDPE;
            float ss = 0.f;
#pragma unroll
            for (int q = 0; q < 3; ++q) { const unsigned u = *(const unsigned*)(pr + 2 * lane + 128 * q); const float a = bflo(u), b = bfhi(u); ss += a * a + b * b; }
            ss = wsum(ss);
            const u32x2 u2 = *(const u32x2*)(pr + 384 + 4 * lane);
            float s2 = bflo(u2[0]) * bflo(u2[0]) + bfhi(u2[0]) * bfhi(u2[0]) + bflo(u2[1]) * bflo(u2[1]) + bfhi(u2[1]) * bfhi(u2[1]);
            s2 = wsum(s2);
            if (lane == 0) { RSQ[row] = rsqrtf(ss * (1.f / 384.f) + 1e-6f); RSKV[row] = rsqrtf(s2 * (1.f / 256.f) + 1e-6f); }
            const float x = bf2f(pr[640 + l32]); const float y = __shfl_xor(x, 8);
            float o = x;
            if (row < RL) { const int l = row & 16383; const float pos = (float)(l32 < 16 ? (l >> 6) : (l & 63));
                float s, c; sincos_red(pos * rope_inv(l32 & 7), s, c);
                o = (l32 & 8) ? x * c + y * s : x * c - y * s; }
            if (lane < 32) KR[(size_t)row * 32 + lane] = f2bf(o);
        }
    }
    LAS unsigned char* lds = (LAS unsigned char*)ldsg;
    const bf16_t* WCM = (const bf16_t*)(ws + OFF_WCM);
    const float* cmn = p.in[15] + j * 128; const float* bs = p.in[17] + j * 512;
    for (int item = blockIdx.x; item < 1040; item += gridDim.x) {
        const int n = item >> 2, g = item & 3, r0 = n * 128;
        {
            const int s = tid >> 2, cq = tid & 3;
            const bf16_t* src = P + (size_t)(r0 + s) * LDPE + 1184 + g * 128 + cq * 32;
            float v[32]; float ss = 0.f;
#pragma unroll
            for (int q = 0; q < 4; ++q) { const u32x4 u = *(const u32x4*)(src + q * 8);
#pragma unroll
                for (int e = 0; e < 4; ++e) { const float a = gelu_t(bflo(u[e])), b = gelu_t(bfhi(u[e])); v[q * 8 + 2 * e] = a; v[q * 8 + 2 * e + 1] = b; ss += a * a + b * b; } }
            ss += __shfl_xor(ss, 1); ss += __shfl_xor(ss, 2);
            const float rstd = rsqrtf(ss * (1.f / 128.f) + 1e-6f);
#pragma unroll
            for (int q = 0; q < 4; ++q) { u32x4 o;
#pragma unroll
                for (int e = 0; e < 4; ++e) { const int c = cq * 32 + q * 8 + 2 * e; o[e] = pk2(v[q * 8 + 2 * e] * rstd * cmn[c], v[q * 8 + 2 * e + 1] * rstd * cmn[c + 1]); }
                *(LAS u32x4*)(lds + s * 272 + (cq * 32 + q * 8) * 2) = o; }
        }
        __syncthreads();
        const int tt = w >> 1, cp = (w & 1) * 2;
        f32x16 acc[2];
#pragma unroll
        for (int e = 0; e < 16; ++e) { acc[0][e] = 0.f; acc[1][e] = 0.f; }
#pragma unroll
        for (int ks = 0; ks < 8; ++ks) {
            const bf16x8 a = *(const bf16x8*)(WCM + g * 16384 + (32 * tt + l32) * 128 + 16 * ks + 8 * hh);
#pragma unroll
            for (int ct = 0; ct < 2; ++ct) { const bf16x8 b = tr_nat(lds, 272, 16 * ks, 32 * (cp + ct), lane); acc[ct] = MFMA32(a, b, acc[ct]); }
        }
#pragma unroll
        for (int ct = 0; ct < 2; ++ct)
#pragma unroll
            for (int i = 0; i < 16; ++i) {
                const int t = 32 * tt + (i >> 2) * 8 + 4 * hh + (i & 3), c = 32 * (cp + ct) + l32;
                const float val = acc[ct][i] + bs[g * 128 + t];
                const float u = gelu_t(bf2f(P[(size_t)(r0 + t) * LDPE + 672 + g * 128 + c]));
                MIX[(size_t)(r0 + t) * DM + 512 + g * 128 + c] = f2bf(u * val);
            }
        __syncthreads();
    }
}

__device__ void phase_kmax(const Params& p, unsigned char* ldsg) {
    unsigned char* ws = p.ws;
    const bf16_t* KV = (const bf16_t*)(ws + OFF_KV); const bf16_t* KR = (const bf16_t*)(ws + OFF_KR);
    float* KMS = (float*)(ws + OFF_KMS);
    float* red = (float*)ldsg;
    const int tid = ltid(), lane = tid & 63, w = tid >> 6, h = lane >> 3, jj = lane & 7;
    float mx0 = 0.f, mx1 = 0.f;
    for (int row = blockIdx.x * 8 + w; row < R; row += gridDim.x * 8) {
        const u32x4 a = *(const u32x4*)(KV + (size_t)row * 1024 + h * 128 + jj * 8);
        const u32x4 r = *(const u32x4*)(KR + (size_t)row * 32 + (jj & 3) * 8);
        float ss = 0.f, sr = 0.f;
#pragma unroll
        for (int e = 0; e < 4; ++e) { ss += bflo(a[e]) * bflo(a[e]) + bfhi(a[e]) * bfhi(a[e]); sr += bflo(r[e]) * bflo(r[e]) + bfhi(r[e]) * bfhi(r[e]); }
        ss += 0.5f * sr;
        ss += __shfl_xor(ss, 1); ss += __shfl_xor(ss, 2); ss += __shfl_xor(ss, 4);
        const int b = row < 16384 ? 0 : (row < RL ? 1 : ((row - RL) >> 8));
        if (b == 0) mx0 = fmaxf(mx0, ss); else mx1 = fmaxf(mx1, ss);
    }
    if (jj == 0) { red[w * 16 + h] = mx0; red[w * 16 + 8 + h] = mx1; }
    __syncthreads();
    if (tid < 16) { float m = red[tid];
#pragma unroll
        for (int q = 1; q < 8; ++q) m = fmaxf(m, red[q * 16 + tid]);
        KMS[blockIdx.x * 16 + tid] = m; }
    __syncthreads();
}

__device__ void phase_attn(const Params& p, unsigned char* ldsg) {
    unsigned char* ws = p.ws;
    const bf16_t* Q = (const bf16_t*)(ws + OFF_Q); const bf16_t* KV = (const bf16_t*)(ws + OFF_KV); const bf16_t* KR = (const bf16_t*)(ws + OFF_KR);
    bf16_t* MIX = (bf16_t*)(ws + OFF_MIX);
    LAS unsigned char* lds = (LAS unsigned char*)ldsg;
    const int tid = ltid(), lane = tid & 63, w = tid >> 6, l32 = lane & 31, hh = lane >> 5;
    constexpr int KROW = 208, VROW = 192, KBUF = 64 * KROW, VBUF = 64 * VROW, VBASE = 2 * KBUF;
    for (int it = blockIdx.x; it < 1040; it += gridDim.x) {
        int b, h, q0row, nkt; bool isctx;
        if (it < 1024) { h = it & 7; const int rest = it >> 3; b = rest >> 6; q0row = b * 16384 + (rest & 63) * 256; nkt = 260; isctx = false; }
        else { const int e = it - 1024; b = e >> 3; h = e & 7; q0row = RL + b * 256; nkt = 4; isctx = true; }
        const int qrow = q0row + w * 32 + l32;
        const bf16_t* qp = Q + (size_t)qrow * 768 + h * 96;
        bf16x8 qf[6];
#pragma unroll
        for (int s = 0; s < 4; ++s) qf[s] = *(const bf16x8*)(qp + 16 * s + 8 * hh);
#pragma unroll
        for (int s = 4; s < 6; ++s) {
            const bf16x8 own = *(const bf16x8*)(qp + 16 * s + 8 * hh);
            const bf16x8 oth = *(const bf16x8*)(qp + 16 * s + 8 * (1 - hh));
            if (!isctx) {
                const int l = qrow & 16383; const float pos = (float)(s == 4 ? (l >> 6) : (l & 63));
                float r[8];
#pragma unroll
                for (int jj = 0; jj < 8; ++jj) { float sn, cs; sincos_red(pos * rope_inv(jj), sn, cs);
                    const float x = bf2f((bf16_t)own[jj]), y = bf2f((bf16_t)oth[jj]); r[jj] = hh ? x * cs + y * sn : x * cs - y * sn; }
                qf[s] = pack8(r[0], r[1], r[2], r[3], r[4], r[5], r[6], r[7]);
            } else qf[s] = own;
        }
        float negm;
        {
            float qs = 0.f;
#pragma unroll
            for (int s = 0; s < 6; ++s)
#pragma unroll
                for (int e = 0; e < 8; ++e) { const float x = bf2f((bf16_t)qf[s][e]); qs += x * x; }
            qs += __shfl_xor(qs, 32);
            const float* KMS = (const float*)(ws + OFF_KMS) + b * 8 + h;
            float km = 0.f;
            for (int q = lane; q < (int)gridDim.x; q += 64) km = fmaxf(km, KMS[q * 16]);
#pragma unroll
            for (int o2 = 32; o2 >= 1; o2 >>= 1) km = fmaxf(km, __shfl_xor(km, o2));
            negm = -sqrtf(qs * km) * 1.0001f - 1e-3f;
        }
        const bf16_t* kp[2]; int kst[2]; int kdo[2]; bool kv_[2];
#pragma unroll
        for (int pp = 0; pp < 2; ++pp) {
            int c = tid + 512 * pp; if (c >= 768) c -= 512; kv_[pp] = true; const int key = c / 12, part = c % 12;
            if (part < 8) { kp[pp] = KV + (size_t)key * 1024 + h * 128 + part * 8; kst[pp] = 1024; }
            else { kp[pp] = KR + (size_t)key * 32 + (part - 8) * 8; kst[pp] = 32; }
            kdo[pp] = key * KROW + part * 16;
        }
        const bf16_t* vp = KV + (size_t)(tid >> 3) * 1024 + h * 128 + 64 + (tid & 7) * 8; const int vdo = (tid >> 3) * VROW + (tid & 7) * 16;
        auto rowbase = [&](int kt) -> int { return isctx ? (RL + b * 256 + kt * 64) : (kt < 256 ? b * 16384 + kt * 64 : RL + b * 256 + (kt - 256) * 64); };
        u32x4 prk[2], prv;
        auto loadK = [&](int kt) { const int rb = rowbase(kt);
#pragma unroll
            for (int pp = 0; pp < 2; ++pp) prk[pp] = *(const u32x4*)(kp[pp] + (size_t)rb * kst[pp]); };
        auto storeK = [&](int buf) {
#pragma unroll
            for (int pp = 0; pp < 2; ++pp) *(LAS u32x4*)(lds + buf * KBUF + kdo[pp]) = prk[pp]; };
        auto loadV = [&](int kt) { prv = *(const u32x4*)(vp + (size_t)rowbase(kt) * 1024); };
        auto storeV = [&](int buf) { *(LAS u32x4*)(lds + VBASE + buf * VBUF + vdo) = prv; };
        f32x16 pA[2], pB[2];
        f32x16 o[2];
#pragma unroll
        for (int e = 0; e < 16; ++e) { o[0][e] = 0.f; o[1][e] = 0.f; }
        float lsum = 0.f;
        auto qk = [&](int buf, f32x16 (&st)[2]) {
            LAS unsigned char* kb = lds + buf * KBUF;
#pragma unroll
            for (int e = 0; e < 16; ++e) { st[0][e] = negm; st[1][e] = negm; }
#pragma unroll
            for (int half = 0; half < 2; ++half) {
                bf16x8 kf[6];
#pragma unroll
                for (int s = 0; s < 3; ++s) {
                    kf[2 * s] = *(const LAS bf16x8*)(kb + l32 * KROW + (16 * (3 * half + s) + 8 * hh) * 2);
                    kf[2 * s + 1] = *(const LAS bf16x8*)(kb + (32 + l32) * KROW + (16 * (3 * half + s) + 8 * hh) * 2);
                }
                __builtin_amdgcn_sched_barrier(0);
#pragma unroll
                for (int s = 0; s < 3; ++s) { st[0] = MFMA32(kf[2 * s], qf[3 * half + s], st[0]); st[1] = MFMA32(kf[2 * s + 1], qf[3 * half + s], st[1]); }
            }
        };
        auto partialSM = [&](f32x16 (&pp)[2]) {
#pragma unroll
            for (int e = 0; e < 16; ++e) pp[0][e] = __builtin_amdgcn_exp2f(pp[0][e]);
        };
        bf16x8 pa[4];
        auto finishSM = [&](f32x16 (&pp)[2]) {
#pragma unroll
            for (int e = 0; e < 16; ++e) pp[1][e] = __builtin_amdgcn_exp2f(pp[1][e]);
            float ps = 0.f;
#pragma unroll
            for (int e = 0; e < 16; ++e) ps += pp[0][e] + pp[1][e];
            lsum += ps;
            pa[0] = pack8(pp[0][0], pp[0][1], pp[0][2], pp[0][3], pp[0][4], pp[0][5], pp[0][6], pp[0][7]);
            pa[1] = pack8(pp[0][8], pp[0][9], pp[0][10], pp[0][11], pp[0][12], pp[0][13], pp[0][14], pp[0][15]);
            pa[2] = pack8(pp[1][0], pp[1][1], pp[1][2], pp[1][3], pp[1][4], pp[1][5], pp[1][6], pp[1][7]);
            pa[3] = pack8(pp[1][8], pp[1][9], pp[1][10], pp[1][11], pp[1][12], pp[1][13], pp[1][14], pp[1][15]);
        };
        auto pv = [&](int buf) {
            LAS unsigned char* vb = lds + VBASE + buf * VBUF;
            bf16x8 vf[8];
#pragma unroll
            for (int vt = 0; vt < 2; ++vt)
#pragma unroll
                for (int q = 0; q < 4; ++q) vf[vt * 4 + q] = tr_perm(vb, VROW, 16 * q, 32 * vt, lane);
            __builtin_amdgcn_sched_barrier(0);
#pragma unroll
            for (int vt = 0; vt < 2; ++vt)
#pragma unroll
                for (int q = 0; q < 4; ++q) o[vt] = MFMA32(vf[vt * 4 + q], pa[q], o[vt]);
        };
        auto step = [&](int j, f32x16 (&pc)[2], f32x16 (&pn)[2]) {
            const int j2 = j + 2 < nkt ? j + 2 : nkt - 1;
            __builtin_amdgcn_sched_barrier(0);
            qk((j + 1) & 1, pn);
            finishSM(pc);
            __builtin_amdgcn_sched_barrier(0);
            loadK(j2); loadV(j + 1);
            __builtin_amdgcn_sched_barrier(0);
            pv(j & 1);
            partialSM(pn);
            __builtin_amdgcn_sched_barrier(0);
            storeK(j & 1); storeV((j + 1) & 1);
            __syncthreads();
        };
        loadK(0); loadV(0); storeK(0); storeV(0);
        loadK(1); storeK(1);
        __syncthreads();
        qk(0, pA); partialSM(pA);
        __syncthreads();
        for (int kt = 0; kt + 2 < nkt; kt += 2) {
            step(kt, pA, pB);
            step(kt + 1, pB, pA);
        }
        step(nkt - 2, pA, pB);
        finishSM(pB);
        pv((nkt - 1) & 1);
        __syncthreads();
        lsum += __shfl_xor(lsum, 32);
        const float inv = 1.f / lsum;
        bf16_t* op = MIX + (size_t)qrow * DM + h * 64;
#pragma unroll
        for (int vt = 0; vt < 2; ++vt)
#pragma unroll
            for (int g4 = 0; g4 < 4; ++g4) {
                const u32x2 pk = {pk2(o[vt][4 * g4] * inv, o[vt][4 * g4 + 1] * inv), pk2(o[vt][4 * g4 + 2] * inv, o[vt][4 * g4 + 3] * inv)};
                *(u32x2*)(op + 32 * vt + 8 * g4 + 4 * hh) = pk;
            }
    }
}

__device__ void phase_gla_prep(const Params& p, int j, unsigned char* ldsg) {
    unsigned char* ws = p.ws;
    const bf16_t* P = (const bf16_t*)(ws + OFF_BIG);
    bf16_t* QTF = (bf16_t*)(ws + OFF_QTF); bf16_t* KTF = (bf16_t*)(ws + OFF_KTF); bf16_t* QTB = (bf16_t*)(ws + OFF_QTB); bf16_t* KTB = (bf16_t*)(ws + OFF_KTB);
    float* DECF = (float*)(ws + OFF_DECF); float* DECB = (float*)(ws + OFF_DECB);
    float* zl = (float*)ldsg;
    float* seg = zl + 2048;
    const int tid = ltid();
    const float* wgf = p.in[20] + (size_t)j * 16 * 512; const float* wgb = p.in[22] + (size_t)j * 16 * 512;
    const float* bgf = p.in[21] + j * 512; const float* bgb = p.in[23] + j * 512;
    for (int item = blockIdx.x; item < 2080; item += gridDim.x) {
        const int ck = item >> 2, h = item & 3, r0 = ck * 64;
        { const int t = tid >> 3, j0 = (tid & 7) * 4; const u32x2 u = *(const u32x2*)(P + (size_t)(r0 + t) * LDPO + 1536 + j0);
          zl[t * 32 + j0] = bflo(u[0]); zl[t * 32 + j0 + 1] = bfhi(u[0]); zl[t * 32 + j0 + 2] = bflo(u[1]); zl[t * 32 + j0 + 3] = bfhi(u[1]); }
        __syncthreads();
        const int d = tid & 127, tq = tid >> 7, hd = h * 128 + d;
        float wf[16], wb[16];
#pragma unroll
        for (int q = 0; q < 16; ++q) { wf[q] = wgf[q * 512 + hd]; wb[q] = wgb[q * 512 + hd]; }
        const float bf_ = bgf[hd], bb_ = bgb[hd];
        float lf[16], lb[16];
#pragma unroll
        for (int i = 0; i < 16; ++i) {
            const float* zr = zl + (tq * 16 + i) * 32;
            float gf = bf_, gb = bb_;
#pragma unroll
            for (int q = 0; q < 16; ++q) { gf = fmaf(zr[q], wf[q], gf); gb = fmaf(zr[16 + q], wb[q], gb); }
            lf[i] = (fminf(gf, 0.f) - __logf(1.f + __expf(-fabsf(gf)))) * 0.0625f;
            lb[i] = (fminf(gb, 0.f) - __logf(1.f + __expf(-fabsf(gb)))) * 0.0625f;
        }
        float run = 0.f;
#pragma unroll
        for (int i = 0; i < 16; ++i) { run += lf[i]; lf[i] = run; }
        const float segF = run; run = 0.f;
#pragma unroll
        for (int i = 15; i >= 0; --i) { run += lb[i]; lb[i] = run; }
        const float segB = run;
        seg[tq * 128 + d] = segF; seg[512 + tq * 128 + d] = segB;
        __syncthreads();
        float offF = 0.f, totF = 0.f, offB = 0.f, totB = 0.f;
#pragma unroll
        for (int q = 0; q < 4; ++q) { const float a = seg[q * 128 + d], b2 = seg[512 + q * 128 + d]; totF += a; totB += b2; if (q < tq) offF += a; if (q > tq) offB += b2; }
#pragma unroll
        for (int i = 0; i < 16; ++i) {
            const size_t row = (size_t)(r0 + tq * 16 + i);
            const float q = bf2f(P[row * LDPO + 1568 + hd]) * 0.08838834764f, k = bf2f(P[row * LDPO + hd]);
            const float cf = lf[i] + offF, cb = lb[i] + offB;
            QTF[row * 512 + hd] = f2bf(q * __expf(cf)); KTF[row * 512 + hd] = f2bf(k * __expf(-cf));
            QTB[row * 512 + hd] = f2bf(q * __expf(cb)); KTB[row * 512 + hd] = f2bf(k * __expf(-cb));
        }
        if (tq == 0) { DECF[(size_t)(ck * 4 + h) * 128 + d] = __expf(totF); DECB[(size_t)(ck * 4 + h) * 128 + d] = __expf(totB); }
        __syncthreads();
    }
}

constexpr int NGC = 8, NGRP = 256 / NGC, NSLOT = NGRP + 1;
constexpr int G_QOFF = 0, G_KOFF = 17408, G_VOFF = 34816, G_DOFF = 68608, G_BUF = 69120, G_SSQ = 2 * G_BUF;
template <bool OUT>
__device__ __forceinline__ void gla_seq(const Params& p, int j, LAS unsigned char* lds, int b, int h, int dir, bool ctx, int g, f32x16 (&S)[4], float* gdout) {
    unsigned char* ws = p.ws;
    const bf16_t* P = (const bf16_t*)(ws + OFF_BIG);
    const bf16_t* QT = (const bf16_t*)(ws + (dir ? OFF_QTB : OFF_QTF)); const bf16_t* KT = (const bf16_t*)(ws + (dir ? OFF_KTB : OFF_KTF));
    const float* DEC = (const float*)(ws + (dir ? OFF_DECB : OFF_DECF));
    bf16_t* MIX = (bf16_t*)(ws + OFF_MIX);
    const float* onorm = p.in[24] + j * 256;
    const int tid = ltid(), lane = tid & 63, w = tid >> 6, l32 = lane & 31, hh = lane >> 5;
    const int nsteps = ctx ? 4 : NGC;
    auto chunk_of = [&](int i) -> int { const int c = ctx ? (dir ? 3 - i : i) : (dir ? NGC * g + NGC - 1 - i : NGC * g + i); return ctx ? 512 + b * 4 + c : b * 256 + c; };
    u32x4 pq[2], pk[2], pv[4], pd;
    auto gload = [&](int ck, int tid) {
        const size_t rb = (size_t)ck * 64;
#pragma unroll
        for (int pp = 0; pp < 2; ++pp) { const int c = tid + 512 * pp, row = c >> 4, cc = c & 15;
            if (OUT) pq[pp] = *(const u32x4*)(QT + (rb + row) * 512 + h * 128 + cc * 8);
            pk[pp] = *(const u32x4*)(KT + (rb + row) * 512 + h * 128 + cc * 8); }
#pragma unroll
        for (int pp = 0; pp < 4; ++pp) { const int c = tid + 512 * pp, row = c >> 5, cc = c & 31; pv[pp] = *(const u32x4*)(P + (rb + row) * LDPO + 512 + h * 256 + cc * 8); }
        if (tid < 32) pd = *(const u32x4*)(DEC + (size_t)(ck * 4 + h) * 128 + tid * 4);
    };
    auto lstore = [&](LAS unsigned char* bb, int tid) {
#pragma unroll
        for (int pp = 0; pp < 2; ++pp) { const int c = tid + 512 * pp, row = c >> 4, cc = c & 15;
            if (OUT) *(LAS u32x4*)(bb + G_QOFF + row * 272 + cc * 16) = pq[pp];
            *(LAS u32x4*)(bb + G_KOFF + row * 272 + cc * 16) = pk[pp]; }
#pragma unroll
        for (int pp = 0; pp < 4; ++pp) { const int c = tid + 512 * pp, row = c >> 5, cc = c & 31; *(LAS u32x4*)(bb + G_VOFF + row * 528 + cc * 16) = pv[pp]; }
        if (tid < 32) *(LAS u32x4*)(bb + G_DOFF + tid * 16) = pd;
    };
    float gd = 1.f;
    gload(chunk_of(0), tid); lstore(lds, tid);
    __syncthreads();
    for (int i = 0; i < nsteps; ++i) {
        const bool more = i + 1 < nsteps;
        const int ck = chunk_of(i);
        const int tid2 = ltid();
        if (more) gload(chunk_of(i + 1), tid2);
        LAS unsigned char* bb = lds + (i & 1) * G_BUF;
        LAS unsigned char* qb = bb + G_QOFF; LAS unsigned char* kb = bb + G_KOFF; LAS unsigned char* vb = bb + G_VOFF;
        const LAS float* dec = (const LAS float*)(bb + G_DOFF);
        if (!OUT) { if (tid < 128) gd *= dec[tid]; }
        if (OUT) {
            f32x16 o[2];
#pragma unroll
            for (int e = 0; e < 16; ++e) { o[0][e] = 0.f; o[1][e] = 0.f; }
#pragma unroll
            for (int st = 0; st < 2; ++st)
#pragma unroll
                for (int tt = 0; tt < 2; ++tt) {
                    f32x16 am;
#pragma unroll
                    for (int e = 0; e < 16; ++e) am[e] = 0.f;
#pragma unroll
                    for (int ks = 0; ks < 8; ++ks) {
                        const bf16x8 a = *(const LAS bf16x8*)(kb + (32 * st + l32) * 272 + (16 * ks + 8 * hh) * 2);
                        const bf16x8 bq = *(const LAS bf16x8*)(qb + (32 * tt + l32) * 272 + (16 * ks + 8 * hh) * 2);
                        am = MFMA32(a, bq, am);
                    }
                    const int t = 32 * tt + l32;
#pragma unroll
                    for (int e = 0; e < 16; ++e) { const int s = 32 * st + (e >> 2) * 8 + 4 * hh + (e & 3); const bool keep = dir ? (t <= s) : (t >= s); am[e] = keep ? am[e] : 0.f; }
                    const bf16x8 pm0 = pack8(am[0], am[1], am[2], am[3], am[4], am[5], am[6], am[7]);
                    const bf16x8 pm1 = pack8(am[8], am[9], am[10], am[11], am[12], am[13], am[14], am[15]);
                    const bf16x8 a0 = tr_perm(vb, 528, 32 * st, 32 * w, lane);
                    o[tt] = MFMA32(a0, pm0, o[tt]);
                    const bf16x8 a1 = tr_perm(vb, 528, 32 * st + 16, 32 * w, lane);
                    o[tt] = MFMA32(a1, pm1, o[tt]);
                    __builtin_amdgcn_sched_barrier(0);
                }
#pragma unroll
            for (int dt = 0; dt < 4; ++dt)
#pragma unroll
                for (int ks2 = 0; ks2 < 2; ++ks2) {
                    const bf16x8 a = pack8(S[dt][8 * ks2], S[dt][8 * ks2 + 1], S[dt][8 * ks2 + 2], S[dt][8 * ks2 + 3], S[dt][8 * ks2 + 4], S[dt][8 * ks2 + 5], S[dt][8 * ks2 + 6], S[dt][8 * ks2 + 7]);
#pragma unroll
                    for (int tt = 0; tt < 2; ++tt) {
                        LAS unsigned char* qa = qb + (32 * tt + l32) * 272 + (32 * dt + 16 * ks2 + 4 * hh) * 2;
                        const bf16x4 x = *(const LAS bf16x4*)qa, y = *(const LAS bf16x4*)(qa + 16);
                        const bf16x8 bq = __builtin_shufflevector(x, y, 0, 1, 2, 3, 4, 5, 6, 7);
                        o[tt] = MFMA32(a, bq, o[tt]);
                    }
                    __builtin_amdgcn_sched_barrier(0);
                }
            {
                LAS unsigned char* stg = lds + ((i + 1) & 1) * G_BUF + G_VOFF;
#pragma unroll
                for (int tt = 0; tt < 2; ++tt)
#pragma unroll
                    for (int g4 = 0; g4 < 4; ++g4) {
                        const u32x2 pkv = {pk2(o[tt][4 * g4], o[tt][4 * g4 + 1]), pk2(o[tt][4 * g4 + 2], o[tt][4 * g4 + 3])};
                        *(LAS u32x2*)(stg + (32 * tt + l32) * 528 + (32 * w + 8 * g4 + 4 * hh) * 2) = pkv;
                    }
                __syncthreads();
                const size_t rbase = (size_t)ck * 64;
                const int tq = tid2 >> 5, cc = tid2 & 31;
                if (dir == 0) {
#pragma unroll
                    for (int pp = 0; pp < 4; ++pp) {
                        const int t = tq + 16 * pp;
                        *(u32x4*)(MIX + (rbase + t) * DM + h * 256 + cc * 8) = *(const LAS u32x4*)(stg + t * 528 + cc * 16);
                    }
                } else {
                    u32x4 of[4], rg[4];
#pragma unroll
                    for (int pp = 0; pp < 4; ++pp) {
                        const int t = tq + 16 * pp;
                        of[pp] = *(const u32x4*)(MIX + (rbase + t) * DM + h * 256 + cc * 8);
                        rg[pp] = *(const u32x4*)(P + (rbase + t) * LDPO + 2080 + h * 256 + cc * 8);
                    }
                    const f32x4 gn0 = *(const f32x4*)(onorm + cc * 8), gn1 = *(const f32x4*)(onorm + cc * 8 + 4);
#pragma unroll
                    for (int pp = 0; pp < 4; ++pp) {
                        const int t = tq + 16 * pp;
                        const u32x4 ob = *(const LAS u32x4*)(stg + t * 528 + cc * 16);
                        float v[8]; float ss = 0.f;
#pragma unroll
                        for (int e = 0; e < 4; ++e) { v[2 * e] = bflo(ob[e]) + bflo(of[pp][e]); v[2 * e + 1] = bfhi(ob[e]) + bfhi(of[pp][e]); ss += v[2 * e] * v[2 * e] + v[2 * e + 1] * v[2 * e + 1]; }
#pragma unroll
                        for (int o2 = 16; o2 >= 1; o2 >>= 1) ss += __shfl_xor(ss, o2);
                        const float rstd = rsqrtf(ss * (1.f / 256.f) + 1e-6f);
                        u32x4 ov;
#pragma unroll
                        for (int e = 0; e < 4; ++e) {
                            const float g0 = e < 2 ? gn0[2 * e] : gn1[2 * e - 4], g1 = e < 2 ? gn0[2 * e + 1] : gn1[2 * e - 3];
                            ov[e] = pk2(v[2 * e] * rstd * g0 * silu_f(bflo(rg[pp][e])), v[2 * e + 1] * rstd * g1 * silu_f(bfhi(rg[pp][e])));
                        }
                        *(u32x4*)(MIX + (rbase + t) * DM + h * 256 + cc * 8) = ov;
                    }
                }
            }
        }
        if (OUT) { __builtin_amdgcn_sched_barrier(0); }
#pragma unroll
        for (int ks = 0; ks < 4; ++ks) {
            const bf16x8 bv = tr_nat(vb, 528, 16 * ks, 32 * w, lane);
#pragma unroll
            for (int dt = 0; dt < 4; ++dt) { const bf16x8 a = tr_nat(kb, 272, 16 * ks, 32 * dt, lane); S[dt] = MFMA32(a, bv, S[dt]); }
        }
#pragma unroll
        for (int dt = 0; dt < 4; ++dt)
#pragma unroll
            for (int g4 = 0; g4 < 4; ++g4) { const f32x4 dv = *(const LAS f32x4*)(dec + 32 * dt + 8 * g4 + 4 * hh);
#pragma unroll
                for (int e = 0; e < 4; ++e) S[dt][4 * g4 + e] *= dv[e]; }
        if (OUT) __syncthreads();
        if (more) lstore(lds + ((i + 1) & 1) * G_BUF, tid2);
        __syncthreads();
    }
    if (!OUT) { if (tid < 128) gdout[tid] = gd; }
}
__device__ __forceinline__ void s_zero(f32x16 (&S)[4]) {
#pragma unroll
    for (int dt = 0; dt < 4; ++dt)
#pragma unroll
        for (int e = 0; e < 16; ++e) S[dt][e] = 0.f;
}
__device__ __forceinline__ void s_store(const f32x16 (&S)[4], bf16_t* slot) {
    const int lane = ltid() & 63, w = ltid() >> 6, l32 = lane & 31, hh = lane >> 5;
#pragma unroll
    for (int dt = 0; dt < 4; ++dt)
#pragma unroll
        for (int e = 0; e < 16; ++e) slot[(32 * dt + (e >> 2) * 8 + 4 * hh + (e & 3)) * 256 + 32 * w + l32] = f2bf(S[dt][e]);
}
__device__ __forceinline__ void s_load(f32x16 (&S)[4], const bf16_t* slot) {
    const int lane = ltid() & 63, w = ltid() >> 6, l32 = lane & 31, hh = lane >> 5;
#pragma unroll
    for (int dt = 0; dt < 4; ++dt)
#pragma unroll
        for (int e = 0; e < 16; ++e) S[dt][e] = bf2f(slot[(32 * dt + (e >> 2) * 8 + 4 * hh + (e & 3)) * 256 + 32 * w + l32]);
}
__device__ void phase_gla_a(const Params& p, int j, unsigned char* ldsg) {
    bf16_t* SLOC = (bf16_t*)(p.ws + OFF_SLOC); float* GD = (float*)(p.ws + OFF_GD);
    for (int item = blockIdx.x; item < 16 * NSLOT; item += gridDim.x) {
        const int combo = item < 16 * NGRP ? item / NGRP : item - 16 * NGRP, g = item < 16 * NGRP ? item % NGRP : NGRP;
        const int dir = combo & 1, h = (combo >> 1) & 3, b = combo >> 3, slot = combo * NSLOT + g;
        f32x16 S[4]; s_zero(S);
        gla_seq<false>(p, j, (LAS unsigned char*)ldsg, b, h, dir, g == NGRP, g, S, GD + (size_t)slot * 128);
        s_store(S, SLOC + (size_t)slot * 32768);
    }
}
__device__ void phase_gla_b(const Params& p) {
    bf16_t* SLOC = (bf16_t*)(p.ws + OFF_SLOC); const float* GD = (const float*)(p.ws + OFF_GD);
    for (int e = blockIdx.x * 512 + ltid(); e < 16 * 32768; e += gridDim.x * 512) {
        const int combo = e >> 15, dv = e & 32767, d = dv >> 8, dir = combo & 1, base = combo * NSLOT;
        float S = bf2f(SLOC[(size_t)(base + NGRP) * 32768 + dv]);
        for (int q = 0; q < NGRP; ++q) {
            const int g = dir ? NGRP - 1 - q : q;
            const size_t o = (size_t)(base + g) * 32768 + dv;
            const float tmp = bf2f(SLOC[o]); SLOC[o] = f2bf(S); S = GD[(base + g) * 128 + d] * S + tmp;
        }
    }
}
__device__ void phase_gla_c(const Params& p, int j, unsigned char* ldsg) {
    const bf16_t* SLOC = (const bf16_t*)(p.ws + OFF_SLOC);
    for (int item = blockIdx.x; item < 8 * NSLOT; item += gridDim.x) {
        const int bh = item < 8 * NGRP ? item / NGRP : item - 8 * NGRP, g = item < 8 * NGRP ? item % NGRP : NGRP;
        const int h = bh & 3, b = bh >> 2;
        f32x16 S[4];
        for (int dir = 0; dir < 2; ++dir) {
            if (g == NGRP) s_zero(S); else s_load(S, SLOC + (size_t)((bh * 2 + dir) * NSLOT + g) * 32768);
            gla_seq<true>(p, j, (LAS unsigned char*)ldsg, b, h, dir, g == NGRP, g, S, nullptr);
        }
    }
}

#define XB_TMO      128
#define XB_XCNT(j)  (256  + 64 * (j))
#define XB_XSUB(j)  (1280 + 64 * (j))
#define XB_XGEN(j)  (2304 + 64 * (j))
#define XB_TOP      3328
#define XB_TOPGEN   3392
#define XCD_BAR_WORDS 3456
#define XB_SPIN_CAP (1u << 18)
__device__ __forceinline__ unsigned xb_ld(unsigned* p)              { return __hip_atomic_load(p, __ATOMIC_RELAXED, __HIP_MEMORY_SCOPE_AGENT); }
__device__ __forceinline__ unsigned xb_add(unsigned* p, unsigned v) { return __hip_atomic_fetch_add(p, v, __ATOMIC_RELAXED, __HIP_MEMORY_SCOPE_AGENT); }
__device__ __forceinline__ unsigned xb_xcc_id() { return (unsigned)__builtin_amdgcn_s_getreg((3 << 11) | 20) & 0xFu; }
#define XB_SPIN(cond, bar) do { unsigned _sp = 0; while (cond) { __builtin_amdgcn_s_sleep(1); \
    if ((++_sp & 255u) == 0u) { if (xb_ld(&(bar)[XB_TMO])) break; if (_sp > XB_SPIN_CAP) { atomicAdd(&(bar)[XB_TMO], 1u); break; } } } } while (0)
struct XcdBarrier { unsigned* bar; unsigned x; volatile LAS unsigned* st; };
__device__ __forceinline__ XcdBarrier xcd_barrier_post(unsigned* bar, volatile LAS unsigned* st) {
    XcdBarrier b; b.bar = bar; b.x = xb_xcc_id(); b.st = st;
    if (threadIdx.x == 0) (void)xb_add(&bar[XB_XCNT(b.x)], 1u);
    return b;
}
__device__ __forceinline__ void xcd_barrier_complete(unsigned* bar, unsigned x, unsigned& nloc, unsigned& nx) {
    const unsigned G = gridDim.x * gridDim.y * gridDim.z;
    unsigned sum, cnt, mine, sp = 0u;
    for (;;) {
        sum = 0u; cnt = 0u; mine = 0u;
#pragma unroll
        for (unsigned j = 0; j < 16; ++j) { const unsigned c = xb_ld(&bar[XB_XCNT(j)]); sum += c; cnt += (c > 0u) ? 1u : 0u; mine = (j == x) ? c : mine; }
        if (sum == G) break;
        __builtin_amdgcn_s_sleep(1);
        if ((++sp & 255u) == 0u) { if (xb_ld(&bar[XB_TMO])) break; if (sp > XB_SPIN_CAP) { atomicAdd(&bar[XB_TMO], 1u); break; } }
    }
    nloc = mine > 0u ? mine : 1u; nx = cnt > 0u ? cnt : 1u;
}
__device__ __forceinline__ void xcd_barrier(const XcdBarrier& b) {
    asm volatile("s_waitcnt vmcnt(0)" ::: "memory");
    __syncthreads();
    if (threadIdx.x == 0) {
        unsigned* bar = b.bar;
        __builtin_amdgcn_s_waitcnt(0);
        unsigned nloc = b.st[0], nx = b.st[1];
        if (nloc == 0u) { xcd_barrier_complete(bar, b.x, nloc, nx); b.st[0] = nloc; b.st[1] = nx; }
        const unsigned old = xb_add(&bar[XB_XSUB(b.x)], 1u);
        const unsigned gen = old / nloc;
        if (old + 1u == (gen + 1u) * nloc) {
            __builtin_amdgcn_fence(__ATOMIC_RELEASE, "agent");
            asm volatile("s_waitcnt vmcnt(0)" ::: "memory");
            const unsigned og = xb_add(&bar[XB_TOP], 1u);
            const unsigned tg = og / nx;
            if (og + 1u == (tg + 1u) * nx) xb_add(&bar[XB_TOPGEN], 1u);
            else XB_SPIN(xb_ld(&bar[XB_TOPGEN]) == tg, bar);
            __builtin_amdgcn_fence(__ATOMIC_ACQUIRE, "agent");
            xb_add(&bar[XB_XGEN(b.x)], 1u);
            asm volatile("s_waitcnt vmcnt(0)" ::: "memory");
        } else {
            XB_SPIN(xb_ld(&bar[XB_XGEN(b.x)]) == gen, bar);
            __builtin_amdgcn_fence(__ATOMIC_ACQUIRE, "agent");
            asm volatile("s_waitcnt vmcnt(0)" ::: "memory");
        }
    }
    __syncthreads();
}
#ifndef PROBE_REP
#define PROBE_REP 0
#endif
#ifndef PHM
#define PHM 0xFFFF
#endif
#define PH(b) if (PHM & (1 << (b)))
enum { K_N1 = 0, K_GIN, K_PREP, K_GQ, K_GKV, K_ATT, K_GPREP, K_GA, K_GB, K_GC, K_GOUT, K_N2, K_GUP, K_GDN, K_COPY, K_NONE, K_KMAX };
__global__ void __launch_bounds__(512, 2) mega(Params p) {
    extern __shared__ __attribute__((aligned(16))) unsigned char ldsg[];
    LAS unsigned char* lds = (LAS unsigned char*)ldsg;
    cg::grid_group grid = cg::this_grid();
    unsigned char* ws = p.ws;
    float* MOD = (float*)(ws + OFF_MOD);
    float* XC = (float*)(ws + OFF_XC);
    bf16_t* H = (bf16_t*)(ws + OFF_H); bf16_t* MIX = (bf16_t*)(ws + OFF_MIX);
    bf16_t* PB = (bf16_t*)(ws + OFF_BIG);
    const bool en_even = p.flags & 1, en_odd = p.flags & 2, en_mlp = p.flags & 4;

    volatile LAS unsigned* xst = (volatile LAS unsigned*)(lds + LDS_BYTES - 16);
    if (threadIdx.x == 0) { xst[0] = 0u; xst[1] = 0u; }
    __syncthreads();
    const XcdBarrier xbar = xcd_barrier_post((unsigned*)(ws + OFF_BAR), xst);
    PH(0) phase_ada(p, ldsg);
    grid.sync();
    for (int step = 0; step < 44; ++step) {
        const int i = step / 11, s = step % 11, j = i >> 1; const bool even = !(i & 1);
        const float* mod = MOD + (size_t)i * 3 * 6144;
        const bool en_mix = even ? en_even : en_odd;
        const bool first = (i == 0) && (s <= 7);
        const float* xl = first ? p.in[0] : p.out; const float* xc = ((i == 0) && (s <= 8)) ? p.in[2] : XC;
        float* PART = (float*)(ws + OFF_PART);
        int kind;
        switch (s) {
            case 0: kind = K_N1; break;
            case 1: kind = K_GIN; break;
            case 2: kind = even ? K_PREP : K_GPREP; break;
            case 3: kind = even ? K_GQ : K_GA; break;
            case 4: kind = even ? K_GKV : K_GB; break;
            case 5: kind = even ? K_KMAX : K_GC; break;
            case 6: kind = even ? K_ATT : K_NONE; break;
            case 7: kind = K_GOUT; break;
            case 8: kind = K_N2; break;
            case 9: kind = K_GUP; break;
            default: kind = K_GDN; break;
        }
        if (s <= 7 && !en_mix) kind = (s == 0) ? K_NONE : ((i == 0 && s == 7) ? K_COPY : K_NONE);
        if (s >= 8 && !en_mlp) kind = K_NONE;
        if (s == 0) { PH(1) phase_weights(p, i, ldsg); }
        if (kind == K_NONE) { if (s == 0) xcd_barrier(xbar); continue; }
        bool gemmB = false, gemmR = false, nosync = false;
        pg8::EpiB EB; EB.O = PB; EB.ldo = 0; EB.rs = nullptr; EB.mode = 0;
        pg8::EpiR ER; ER.xin_l = xl; ER.xin_c = xc; ER.xout_l = p.out; ER.xout_c = XC; ER.gate = mod;
        const bf16_t* gA = H; const bf16_t* gB = (const bf16_t*)(ws + OFF_WIN); int lda = 1024, ldb = 1024, gN = 1024, gK = 1024, gM = R, nP = 0, Kp = 256;
        const int reps = ((p.flags >> (8 + kind)) & 1) ? 2 : 1;
        for (int rep = 0; rep < reps; ++rep) {
        if (rep) __syncthreads();
        switch (kind) {
            case K_N1: PH(2) phase_norm(xl, xc, p.in[6] + i * 1024, mod, 0, 1, H, R, i > 0 ? PART : nullptr, 8, mod - 3 * 6144 + 2 * 6144 + 5 * 1024, XC); break;
            case K_N2: PH(2) phase_norm(xl, xc, p.in[7] + i * 1024, mod, 3, 4, H, i < 3 ? R : RL, PART, 4, mod + 2 * 6144 + 2 * 1024, XC); break;
            case K_GIN: gemmB = true; gN = even ? 1792 : 3328; EB.ldo = gN; break;
            case K_PREP: PH(4) phase_even_prep(p, j, ldsg); break;
            case K_GQ: gemmB = true; nosync = true; gA = PB; lda = LDPE; gB = (const bf16_t*)(ws + OFF_WUQ); ldb = 384; gN = 768; gK = 384; EB.O = (bf16_t*)(ws + OFF_Q); EB.ldo = 768; EB.rs = (const float*)(ws + OFF_RSQ); break;
            case K_GKV: gemmB = true; gA = PB + 384; lda = LDPE; gB = (const bf16_t*)(ws + OFF_WUKV); ldb = 256; gN = 1024; gK = 256; EB.O = (bf16_t*)(ws + OFF_KV); EB.ldo = 1024; EB.rs = (const float*)(ws + OFF_RSKV); break;
            case K_KMAX: PH(4) phase_kmax(p, ldsg); break;
            case K_ATT: PH(5) phase_attn(p, ldsg); break;
            case K_GPREP: PH(6) phase_gla_prep(p, j, ldsg); break;
            case K_GA: PH(7) phase_gla_a(p, j, ldsg); break;
            case K_GB: PH(8) phase_gla_b(p); break;
            case K_GC: PH(9) phase_gla_c(p, j, ldsg); break;
            case K_GOUT: gemmR = true; gA = MIX; gB = (const bf16_t*)(ws + OFF_WOUT); ER.gate = mod + 2 * 1024; gM = RL; nP = i < 3 ? 4 : 0; Kp = 256; break;
            case K_GUP: gemmB = true; gB = (const bf16_t*)(ws + OFF_W1); gN = 4096; EB.ldo = 4096; EB.mode = 1; gM = i < 3 ? R : RL; break;
            case K_GDN: gemmR = true; gA = PB; lda = 4096; gB = (const bf16_t*)(ws + OFF_W2); ldb = 4096; gK = 4096; ER.gate = mod + 5 * 1024; gM = RL; nP = i < 3 ? 8 : 0; Kp = 512; break;
            case K_COPY:
                for (size_t e = (size_t)blockIdx.x * 512 + ltid(); e < (size_t)R * 256; e += (size_t)gridDim.x * 512) {
                    const size_t row = e >> 8, c4 = (e & 255) * 4;
                    if (row < RL) *(f32x4*)(p.out + row * DM + c4) = *(const f32x4*)(xl + row * DM + c4);
                    else *(f32x4*)(XC + (row - RL) * DM + c4) = *(const f32x4*)(xc + (row - RL) * DM + c4);
                }
                break;
            default: break;
        }
        if (gemmB) { PH(3) run_gemm(lds, gA, lda, gB, ldb, gM, gN, gK, EB, kind == K_GKV); }
        if (gemmR) { PH(10) { run_gemm(lds, gA, lda, gB, ldb, gM, gN, gK, ER); if (nP) run_pieces(lds, gA + (size_t)RL * lda, lda, gB, ldb, nP, Kp, PART); } }
        }
        if (!nosync) xcd_barrier(xbar);
    }
    PH(11) phase_final(p.in[26], p.out);
}

extern "C" void kernel_launch(void* const* d_in, const int* in_sizes, int n_in, void* d_out, int out_size, void* d_ws, size_t ws_size, hipStream_t stream) {
    static int grid = 0;
    if (grid == 0) {
        if (n_in != 27 || ws_size < WS_NEED) { fprintf(stderr, "kernel_launch: unexpected n_in %d / ws %zu\n", n_in, ws_size); grid = -1; return; }
        int dev = 0, cus = 0, per_cu = 0;
        hipGetDevice(&dev);
        hipDeviceGetAttribute(&cus, hipDeviceAttributeMultiprocessorCount, dev);
        hipFuncSetAttribute((const void*)mega, hipFuncAttributeMaxDynamicSharedMemorySize, LDS_BYTES);
        hipOccupancyMaxActiveBlocksPerMultiprocessor(&per_cu, (const void*)mega, 512, LDS_BYTES);
        (void)hipGetLastError();
        if (per_cu < 1) fprintf(stderr, "kernel_launch: occupancy query reports %d blocks per CU\n", per_cu);
        grid = cus > 0 ? cus : 256;
    }
    if (grid < 0) return;
    if (hipMemsetAsync((char*)d_ws + OFF_BAR, 0, 16384, stream) != hipSuccess) { fprintf(stderr, "kernel_launch: memset failed\n"); return; }
    Params p{};
    for (int i = 0; i < 27; ++i) p.in[i] = (const float*)d_in[i];
    p.out = (float*)d_out; p.ws = (unsigned char*)d_ws; p.flags = 7 | PROBE_REP;
    void* args[] = {&p};
    hipError_t e = hipLaunchCooperativeKernel((const void*)mega, dim3(grid), dim3(512), args, LDS_BYTES, stream);
    if (e != hipSuccess) fprintf(stderr, "cooperative launch failed: %s (grid %d)\n", hipGetErrorString(e), grid);
}
```

```cpp
#include <hip/hip_runtime.h>
#include <hip/hip_cooperative_groups.h>
#include <cstdio>
namespace cg = cooperative_groups;

#define LAS __attribute__((address_space(3)))
typedef unsigned short bf16_t;
typedef short bf16x8 __attribute__((ext_vector_type(8)));
typedef short bf16x4 __attribute__((ext_vector_type(4)));
typedef float f32x4 __attribute__((ext_vector_type(4)));
typedef float f32x16 __attribute__((ext_vector_type(16)));
typedef unsigned u32x4 __attribute__((ext_vector_type(4)));
typedef unsigned u32x2 __attribute__((ext_vector_type(2)));

constexpr int R = 33280, RL = 32768, DM = 1024;
constexpr int LDPE = 1792, LDPO = 3328;
constexpr size_t MiB = (size_t)1 << 20;
constexpr size_t OFF_WIN = 0, OFF_WOUT = 8 * MiB, OFF_WUQ = 10 * MiB, OFF_WUKV = 11 * MiB, OFF_WCM = 12 * MiB, OFF_W1 = 13 * MiB, OFF_W2 = 21 * MiB;
constexpr size_t OFF_MOD = 30 * MiB, OFF_XC = 31 * MiB, OFF_RSQ = 33 * MiB, OFF_RSKV = 33 * MiB + 256 * 1024, OFF_GD = 36 * MiB + 640 * 1024;
constexpr size_t OFF_BAR = 33 * MiB + 768 * 1024;
constexpr size_t OFF_KMS = 33 * MiB + 800 * 1024;
constexpr size_t OFF_DECF = 34 * MiB, OFF_DECB = 35 * MiB + 512 * 1024;
constexpr size_t OFF_H = 37 * MiB, OFF_MIX = 102 * MiB, OFF_BIG = 167 * MiB, OFF_G = 427 * MiB;
constexpr size_t OFF_Q = OFF_BIG + 114 * MiB, OFF_KV = OFF_BIG + 163 * MiB, OFF_KR = OFF_BIG + 228 * MiB;
constexpr size_t OFF_QTF = OFF_H, OFF_KTF = OFF_H + 34078720, OFF_QTB = OFF_BIG + 212 * MiB, OFF_SLOC = OFF_G, OFF_KTB = OFF_G + 34 * MiB;
constexpr size_t OFF_PART = 494 * MiB;
constexpr size_t WS_NEED = 510 * MiB;
constexpr int LDS_BYTES = 144 * 1024;

struct Params {
    const float* in[27];
    float* out;
    unsigned char* ws;
    long long flags;
};

__device__ __forceinline__ float bf2f(bf16_t b) { return __uint_as_float(((unsigned)b) << 16); }
__device__ __forceinline__ float bflo(unsigned u) { return __uint_as_float(u << 16); }
__device__ __forceinline__ float bfhi(unsigned u) { return __uint_as_float(u & 0xffff0000u); }
__device__ __forceinline__ bf16_t f2bf(float f) { unsigned u = __float_as_uint(f); u += 0x7FFFu + ((u >> 16) & 1u); return (bf16_t)(u >> 16); }
typedef __bf16 hwbf2_t __attribute__((ext_vector_type(2)));
typedef float f32x2v_t __attribute__((ext_vector_type(2)));
__device__ __forceinline__ unsigned pk2(float lo, float hi) { const f32x2v_t v = {lo, hi}; const hwbf2_t b = __builtin_convertvector(v, hwbf2_t); return __builtin_bit_cast(unsigned, b); }
__device__ __forceinline__ bf16x8 pack8(float a0, float a1, float a2, float a3, float a4, float a5, float a6, float a7) {
    u32x4 u = {pk2(a0, a1), pk2(a2, a3), pk2(a4, a5), pk2(a6, a7)};
    return __builtin_bit_cast(bf16x8, u);
}
__device__ __forceinline__ float wsum(float v) {
#pragma unroll
    for (int o = 32; o >= 1; o >>= 1) v += __shfl_xor(v, o);
    return v;
}
__device__ __forceinline__ float gelu_t(float x) { const float u = 0.7978845608f * (x + 0.044715f * x * x * x); return x / (1.f + __expf(-2.f * u)); }
__device__ __forceinline__ float silu_f(float x) { return x / (1.f + __expf(-x)); }
__device__ __forceinline__ void sincos_red(float ang, float& s, float& c) {
    const float k = rintf(ang * 0.15915494309f);
    float r = fmaf(-k, 6.2831854820251465f, ang);
    r = fmaf(-k, -1.7484555e-7f, r);
    s = __sinf(r); c = __cosf(r);
}
__device__ __forceinline__ float rope_inv(int jj) { return exp2f(-(float)jj * 1.6609640474f); }

__device__ __forceinline__ bf16x4 tr16(LAS unsigned char* a) { return __builtin_amdgcn_ds_read_tr16_b64_v4i16((LAS bf16x4*)a); }
__device__ __forceinline__ bf16x8 tr_nat(LAS unsigned char* base, int stride, int k0, int n0, int lane) {
    const int i = lane & 15, q = i >> 2, pq = i & 3, hh = lane >> 5, g1 = (lane >> 4) & 1;
    LAS unsigned char* a0 = base + (k0 + 8 * hh + q) * stride + (n0 + 16 * g1 + 4 * pq) * 2;
    const bf16x4 x = tr16(a0), y = tr16(a0 + 4 * stride);
    return __builtin_shufflevector(x, y, 0, 1, 2, 3, 4, 5, 6, 7);
}
__device__ __forceinline__ bf16x8 tr_perm(LAS unsigned char* base, int stride, int k0, int n0, int lane) {
    const int i = lane & 15, q = i >> 2, pq = i & 3, hh = lane >> 5, g1 = (lane >> 4) & 1;
    LAS unsigned char* a0 = base + (k0 + 4 * hh + q) * stride + (n0 + 16 * g1 + 4 * pq) * 2;
    const bf16x4 x = tr16(a0), y = tr16(a0 + 8 * stride);
    return __builtin_shufflevector(x, y, 0, 1, 2, 3, 4, 5, 6, 7);
}
__device__ __forceinline__ int ltid() { int t = threadIdx.x; asm volatile("" : "+v"(t)); return t; }
#define MFMA32(a, b, c) __builtin_amdgcn_mfma_f32_32x32x16_bf16((a), (b), (c), 0, 0, 0)

namespace pg8 {
constexpr int BM = 256, BK = 64, HALF = 128, HTB = HALF * BK * 2, STAGE_BYTES = 8 * HTB, NXCD = 8, WGM = 8;
__device__ __forceinline__ int lds_byte(int r, int c) { const int st = (r >> 4) * 2 + (c >> 5), rr = r & 15, cc = c & 31, ob = rr * 64 + cc * 2; return st * 1024 + (ob ^ (((ob >> 9) & 1) << 5)); }
__device__ __forceinline__ void stage_rc(int b, int& Rr, int& C) { const int st = b / 1024, sb = b % 1024, swz = sb ^ (((sb >> 9) & 1) << 5); Rr = (st >> 1) * 16 + swz / 64; C = (st & 1) * 32 + (swz % 64) / 2; }
__device__ __forceinline__ int perm32(int rho) { const int n = rho >> 4, i = rho & 15; return 8 * (i >> 2) + 4 * n + (i & 3); }
struct Unit { int pm, pn, ko; };
struct Gemm { const bf16_t* A; const bf16_t* Bt; int lda, ldb, M, N, K; };
struct StaticOrder {
    int nM, nN, nwg, G, c;
    __device__ void init(int M, int N, int G_, int c_) { nM = M / BM; nN = N / BM; nwg = nM * nN; G = G_; c = c_; }
    __device__ bool next(int i, Unit& u) const {
        const long L = (long)i * G + c; if (L >= nwg) return false;
        int wgid = (int)L; { const int q = nwg / NXCD, r = nwg % NXCD, xcd = wgid % NXCD, off = wgid / NXCD; wgid = (xcd < r ? xcd * (q + 1) : r * (q + 1) + (xcd - r) * q) + off; }
        const int nig = WGM * nN, gid = wgid / nig, fm = gid * WGM, gsz = (nM - fm) < WGM ? (nM - fm) : WGM;
        u.pm = fm + ((wgid % nig) % gsz); u.pn = (wgid % nig) / gsz; u.ko = 0; return true;
    }
};
struct PieceOrder {
    int nP, Kp, G, c;
    __device__ bool next(int i, Unit& u) const {
        const long L = (long)i * G + c; if (L >= 8 * nP) return false;
        const int kp = (int)L >> 3, r = (int)L & 7; u.pm = r >> 2; u.pn = r & 3; u.ko = kp * Kp; return true;
    }
};

template <class Epi, class Sched>
__device__ __forceinline__ void gemm_phase(LAS unsigned char* lds, const Gemm g, const Sched& S, const Epi& E) {
    const int tid = ltid(), wid = __builtin_amdgcn_readfirstlane(tid >> 6), lane = tid & 63, wr = wid >> 2, wc = wid & 3, fr = lane & 15, fq = lane >> 4;
    const int K = g.K, nt = K / BK;
    unsigned voffA[2], voffB[2];
#pragma unroll
    for (int i = 0; i < 2; ++i) { int Rr, C; stage_rc(tid * 16 + i * 8192, Rr, C); const int Rb = Epi::PERM ? ((Rr & ~31) + perm32(Rr & 31)) : Rr;
        voffA[i] = (unsigned)(Rr * g.lda + C) * 2u; voffB[i] = (unsigned)(Rb * g.ldb + C) * 2u; }
    const size_t kstep = (size_t)(BK * 2);
    const size_t hA = (size_t)HALF * g.lda * 2, hB = (size_t)HALF * g.ldb * 2;
    const size_t tA = 2 * hA, tB = 2 * hB;
    const unsigned ldsw = (unsigned)wid * 1024u;
    const int aoff = lds_byte(wr * 64 + fr, fq * 8), boff = lds_byte(wc * 32 + fr, fq * 8);
#define PG8_SA(b, h) (((b) * 2 + (h)) * HTB)
#define PG8_SB(b, h) ((4 + (b) * 2 + (h)) * HTB)
#define PG8_STAGE(bufoff, gbase, voff) do { _Pragma("unroll") for (int _i = 0; _i < 2; ++_i) \
        __builtin_amdgcn_global_load_lds((const unsigned*)((const char*)(gbase) + (voff)[_i]), (LAS unsigned*)(lds + (bufoff) + ldsw + _i * 8192), 16, 0, 0); } while (0)
#define PG8_LDA(dst, b, h) do { _Pragma("unroll") for (int m = 0; m < 4; ++m) _Pragma("unroll") for (int k = 0; k < 2; ++k) dst[m][k] = *(const LAS bf16x8*)(lds + PG8_SA(b, h) + aoff + m * 2048 + k * 1024); } while (0)
#define PG8_LDB(dst, b, h) do { _Pragma("unroll") for (int n = 0; n < 2; ++n) _Pragma("unroll") for (int k = 0; k < 2; ++k) dst[n][k] = *(const LAS bf16x8*)(lds + PG8_SB(b, h) + boff + n * 2048 + k * 1024); } while (0)
#define PG8_MMA(ai, bj, At, Bt) do { __builtin_amdgcn_s_setprio(1); _Pragma("unroll") for (int m = 0; m < 4; ++m) _Pragma("unroll") for (int n = 0; n < 2; ++n) _Pragma("unroll") for (int k = 0; k < 2; ++k) \
        acc[ai][bj][m][n] = __builtin_amdgcn_mfma_f32_16x16x32_bf16(Bt[n][k], At[m][k], acc[ai][bj][m][n], 0, 0, 0); __builtin_amdgcn_s_setprio(0); } while (0)
#define PG8_WAIT_V(n) asm volatile("s_waitcnt vmcnt(" #n ")" ::: "memory")
#define PG8_WAIT_L(n) asm volatile("s_waitcnt lgkmcnt(" #n ")" ::: "memory")
#define PG8_BAR __builtin_amdgcn_s_barrier()
#define PG8_SCHED __builtin_amdgcn_sched_barrier(0)
    Unit cur, nxt; int ui = 0;
    if (!S.next(0, cur)) return;
    f32x4 acc[2][2][4][2];
#pragma unroll
    for (int a = 0; a < 2; ++a)
#pragma unroll
        for (int b = 0; b < 2; ++b)
#pragma unroll
            for (int m = 0; m < 4; ++m)
#pragma unroll
                for (int n = 0; n < 2; ++n) acc[a][b][m][n] = (f32x4){0.f, 0.f, 0.f, 0.f};
    bf16x8 At[4][2], B0[2][2], B1[2][2];
    const char* cA = (const char*)g.A + (size_t)cur.pm * tA + (size_t)cur.ko * 2; const char* cB = (const char*)g.Bt + (size_t)cur.pn * tB + (size_t)cur.ko * 2;
    PG8_STAGE(PG8_SB(0, 0), cB, voffB); PG8_STAGE(PG8_SA(0, 0), cA, voffA); PG8_STAGE(PG8_SB(0, 1), cB + hB, voffB); PG8_STAGE(PG8_SA(0, 1), cA + hA, voffA);
    if (wr == 1) PG8_BAR;
    PG8_WAIT_V(4); PG8_BAR;
    PG8_STAGE(PG8_SB(1, 0), cB + kstep, voffB); PG8_STAGE(PG8_SA(1, 0), cA + kstep, voffA); PG8_STAGE(PG8_SB(1, 1), cB + hB + kstep, voffB);
    PG8_WAIT_V(6); PG8_BAR;
    for (;;) {
        const bool has_next = S.next(ui + 1, nxt);
        const char* nA = has_next ? (const char*)g.A + (size_t)nxt.pm * tA + (size_t)nxt.ko * 2 : cA; const char* nB = has_next ? (const char*)g.Bt + (size_t)nxt.pn * tB + (size_t)nxt.ko * 2 : cB;
        for (int t = 0; t < nt; t += 2) {
            const bool last = (t == nt - 2);
            const char* a1 = cA + (size_t)(t + 1) * kstep;
            const char* a2 = last ? nA : cA + (size_t)(t + 2) * kstep; const char* b2 = last ? nB : cB + (size_t)(t + 2) * kstep;
            const char* a3 = a2 + kstep; const char* b3 = b2 + kstep;
            PG8_LDB(B0, 0, 0); PG8_SCHED; PG8_LDA(At, 0, 0); PG8_STAGE(PG8_SA(1, 1), a1 + hA, voffA);
            PG8_WAIT_L(8); PG8_BAR; PG8_WAIT_L(0); PG8_MMA(0, 0, At, B0); PG8_BAR; PG8_SCHED;
            PG8_LDB(B1, 0, 1); PG8_STAGE(PG8_SB(0, 0), b2, voffB);
            PG8_BAR; PG8_WAIT_L(0); PG8_MMA(0, 1, At, B1); PG8_BAR;
            PG8_LDA(At, 0, 1); PG8_STAGE(PG8_SA(0, 0), a2, voffA);
            PG8_BAR; PG8_WAIT_L(0); PG8_MMA(1, 0, At, B0); PG8_BAR; PG8_SCHED;
            PG8_STAGE(PG8_SB(0, 1), b2 + hB, voffB);
            PG8_WAIT_V(6); PG8_BAR; PG8_MMA(1, 1, At, B1); PG8_BAR;
            PG8_LDB(B0, 1, 0); PG8_SCHED; PG8_LDA(At, 1, 0); PG8_STAGE(PG8_SA(0, 1), a2 + hA, voffA);
            PG8_WAIT_L(8); PG8_BAR; PG8_WAIT_L(0); PG8_MMA(0, 0, At, B0); PG8_BAR; PG8_SCHED;
            PG8_LDB(B1, 1, 1); PG8_STAGE(PG8_SB(1, 0), b3, voffB);
            PG8_BAR; PG8_WAIT_L(0); PG8_MMA(0, 1, At, B1); PG8_BAR;
            PG8_LDA(At, 1, 1); PG8_STAGE(PG8_SA(1, 0), a3, voffA);
            PG8_BAR; PG8_WAIT_L(0); PG8_MMA(1, 0, At, B0); PG8_BAR; PG8_SCHED;
            PG8_STAGE(PG8_SB(1, 1), b3 + hB, voffB);
            PG8_WAIT_V(6); PG8_BAR; PG8_MMA(1, 1, At, B1); PG8_BAR;
        }
        E(acc, cur, wr, wc, fr, fq);
        if (!has_next) break;
#pragma unroll
        for (int a = 0; a < 2; ++a)
#pragma unroll
            for (int b = 0; b < 2; ++b)
#pragma unroll
                for (int m = 0; m < 4; ++m)
#pragma unroll
                    for (int n = 0; n < 2; ++n) acc[a][b][m][n] = (f32x4){0.f, 0.f, 0.f, 0.f};
        cur = nxt; cA = nA; cB = nB; ++ui;
    }
    PG8_WAIT_V(0);
    if (wr == 0) PG8_BAR;
    PG8_BAR;
#undef PG8_SA
#undef PG8_SB
#undef PG8_STAGE
#undef PG8_LDA
#undef PG8_LDB
#undef PG8_MMA
#undef PG8_WAIT_V
#undef PG8_WAIT_L
#undef PG8_BAR
#undef PG8_SCHED
}

struct EpiB {
    static constexpr bool PERM = true;
    bf16_t* O; int ldo; const float* rs; int mode;
    __device__ __forceinline__ void operator()(const f32x4 (&acc)[2][2][4][2], const Unit& u, int wr, int wc, int fr, int fq) const {
        const int row0 = u.pm * BM + wr * 64 + fr, col0 = u.pn * BM + wc * 32 + 8 * fq;
#pragma unroll
        for (int ai = 0; ai < 2; ++ai)
#pragma unroll
            for (int m = 0; m < 4; ++m) {
                const int row = row0 + ai * HALF + m * 16;
                const float s = rs ? rs[row] : 1.f;
                bf16_t* rowp = O + (size_t)row * ldo + col0;
#pragma unroll
                for (int bj = 0; bj < 2; ++bj) {
                    f32x4 v0 = acc[ai][bj][m][0] * s, v1 = acc[ai][bj][m][1] * s;
                    if (mode == 1) {
#pragma unroll
                        for (int e = 0; e < 4; ++e) { const float a = fmaxf(v0[e], 0.f), b = fmaxf(v1[e], 0.f); v0[e] = a * a; v1[e] = b * b; }
                    }
                    const u32x4 o = {pk2(v0[0], v0[1]), pk2(v0[2], v0[3]), pk2(v1[0], v1[1]), pk2(v1[2], v1[3])};
                    *(u32x4*)(rowp + bj * HALF) = o;
                }
            }
    }
};
struct EpiR {
    static constexpr bool PERM = false;
    const float* xin_l; const float* xin_c; float* xout_l; float* xout_c; const float* gate;
    __device__ __forceinline__ void operator()(const f32x4 (&acc)[2][2][4][2], const Unit& u, int wr, int wc, int fr, int fq) const {
        const int var = u.pm < 64 ? 0 : (u.pm < 128 ? 1 : 2);
        const float* gp = gate + var * 6144;
        const int rowt = (u.pm < 128 ? u.pm : u.pm - 128) * BM + wr * 64 + fr;
        const float* xi = u.pm < 128 ? xin_l : xin_c; float* xo = u.pm < 128 ? xout_l : xout_c;
        const int col0 = u.pn * BM + wc * 32 + 4 * fq;
        f32x4 gv[2][2];
#pragma unroll
        for (int bj = 0; bj < 2; ++bj)
#pragma unroll
            for (int n = 0; n < 2; ++n) gv[bj][n] = *(const f32x4*)(gp + col0 + bj * HALF + n * 16);
#pragma unroll
        for (int ai = 0; ai < 2; ++ai)
#pragma unroll
            for (int m = 0; m < 4; ++m) {
                const size_t ro = (size_t)(rowt + ai * HALF + m * 16) * DM + col0;
#pragma unroll
                for (int bj = 0; bj < 2; ++bj)
#pragma unroll
                    for (int n = 0; n < 2; ++n) {
                        const f32x4 x = *(const f32x4*)(xi + ro + bj * HALF + n * 16);
                        *(f32x4*)(xo + ro + bj * HALF + n * 16) = x + gv[bj][n] * acc[ai][bj][m][n];
                    }
            }
    }
};
struct EpiP {
    static constexpr bool PERM = false;
    float* part; int kpiece;
    __device__ __forceinline__ void operator()(const f32x4 (&acc)[2][2][4][2], const Unit& u, int wr, int wc, int fr, int fq) const {
        const int kp = u.ko / kpiece;
        const int rowt = u.pm * BM + wr * 64 + fr, col0 = u.pn * BM + wc * 32 + 4 * fq;
        float* base = part + (size_t)kp * 512 * DM;
#pragma unroll
        for (int ai = 0; ai < 2; ++ai)
#pragma unroll
            for (int m = 0; m < 4; ++m) {
                const size_t ro = (size_t)(rowt + ai * HALF + m * 16) * DM + col0;
#pragma unroll
                for (int bj = 0; bj < 2; ++bj)
#pragma unroll
                    for (int n = 0; n < 2; ++n) *(f32x4*)(base + ro + bj * HALF + n * 16) = acc[ai][bj][m][n];
            }
    }
};
}

template <class Epi>
__device__ __forceinline__ void run_gemm(LAS unsigned char* lds, const bf16_t* A, int lda, const bf16_t* Bt, int ldb, int M, int N, int K, const Epi& E, bool rev = false) {
    pg8::Gemm g; g.A = A; g.Bt = Bt; g.lda = lda; g.ldb = ldb; g.M = M; g.N = N; g.K = K;
    pg8::StaticOrder S; S.init(M, N, (int)gridDim.x, rev ? (int)(gridDim.x - 1 - blockIdx.x) : (int)blockIdx.x);
    pg8::gemm_phase<Epi, pg8::StaticOrder>(lds, g, S, E);
}
__device__ __forceinline__ void run_pieces(LAS unsigned char* lds, const bf16_t* A, int lda, const bf16_t* Bt, int ldb, int nP, int Kp, float* part) {
    pg8::Gemm g; g.A = A; g.Bt = Bt; g.lda = lda; g.ldb = ldb; g.M = 512; g.N = 1024; g.K = Kp;
    pg8::PieceOrder S; S.nP = nP; S.Kp = Kp; S.G = (int)gridDim.x; S.c = (int)blockIdx.x;
    pg8::EpiP E; E.part = part; E.kpiece = Kp;
    pg8::gemm_phase<pg8::EpiP, pg8::PieceOrder>(lds, g, S, E);
}

__device__ void phase_ada(const Params& p, unsigned char* ldsg) {
    float* sl = (float*)ldsg;
    float* red = sl + 3072;
    const int tid = ltid();
    float* MOD = (float*)(p.ws + OFF_MOD);
    for (int idx = tid; idx < 3072; idx += 512) { const int var = idx >> 10, k = idx & 1023; const float v = var < 2 ? p.in[1][var * 1024 + k] : p.in[3][k]; sl[idx] = silu_f(v); }
    __syncthreads();
    for (int item = blockIdx.x; item < 192; item += gridDim.x) {
        const int i = item / 48, cb = item % 48, cc = tid & 127, kq = tid >> 7, col = cb * 128 + cc;
        const float* w = p.in[4] + ((size_t)i * 1024 + kq * 256) * 6144 + col;
        const float* s0 = sl + kq * 256;
        float a0 = 0.f, a1 = 0.f, a2 = 0.f;
#pragma unroll 8
        for (int k = 0; k < 256; ++k) { const float wv = w[(size_t)k * 6144]; a0 = fmaf(s0[k], wv, a0); a1 = fmaf(s0[1024 + k], wv, a1); a2 = fmaf(s0[2048 + k], wv, a2); }
        red[(kq * 3 + 0) * 128 + cc] = a0; red[(kq * 3 + 1) * 128 + cc] = a1; red[(kq * 3 + 2) * 128 + cc] = a2;
        __syncthreads();
        if (tid < 384) { const int var = tid >> 7, c2 = tid & 127; float s = p.in[5][i * 6144 + cb * 128 + c2];
#pragma unroll
            for (int q = 0; q < 4; ++q) s += red[(q * 3 + var) * 128 + c2];
            MOD[(size_t)(i * 3 + var) * 6144 + cb * 128 + c2] = s; }
        __syncthreads();
    }
}

__device__ void tjob(const float* src, int K, int N, int Npad, bf16_t* dst, const float* rs, float mult, unsigned char* ldsg) {
    float* tile = (float*)ldsg;
    const int tid = ltid(), ntk = K / 64, ntn = Npad / 64;
    for (int t = blockIdx.x; t < ntk * ntn; t += gridDim.x) {
        const int tk = t % ntk, tn = t / ntk;
        const int nl = tid & 63, kl0 = tid >> 6;
#pragma unroll
        for (int j = 0; j < 8; ++j) { const int kl = kl0 + 8 * j, k = tk * 64 + kl, n = tn * 64 + nl;
            float v = n < N ? src[(size_t)k * N + n] : 0.f; if (rs) v *= rs[k]; tile[kl * 65 + nl] = v * mult; }
        __syncthreads();
        const int nl2 = tid >> 3, kc = tid & 7;
        u32x4 o;
#pragma unroll
        for (int e = 0; e < 4; ++e) o[e] = pk2(tile[(kc * 8 + 2 * e) * 65 + nl2], tile[(kc * 8 + 2 * e + 1) * 65 + nl2]);
        *(u32x4*)(dst + (size_t)(tn * 64 + nl2) * K + tk * 64 + kc * 8) = o;
        __syncthreads();
    }
}
__device__ void phase_weights(const Params& p, int i, unsigned char* ldsg) {
    unsigned char* ws = p.ws; const int j = i >> 1;
    if (!(i & 1)) {
        tjob(p.in[10] + (size_t)j * 1024 * 1696, 1024, 1696, 1792, (bf16_t*)(ws + OFF_WIN), nullptr, 1.f, ldsg);
        tjob(p.in[12] + (size_t)j * 384 * 768, 384, 768, 768, (bf16_t*)(ws + OFF_WUQ), p.in[11] + j * 384, 0.10206207262f * 1.44269504089f, ldsg);
        tjob(p.in[14] + (size_t)j * 256 * 1024, 256, 1024, 1024, (bf16_t*)(ws + OFF_WUKV), p.in[13] + j * 256, 1.f, ldsg);
        tjob(p.in[18] + (size_t)j * 1024 * 1024, 1024, 1024, 1024, (bf16_t*)(ws + OFF_WOUT), nullptr, 1.f, ldsg);
        bf16_t* wcm = (bf16_t*)(ws + OFF_WCM); const float* src = p.in[16] + (size_t)j * 65536;
        for (int e = blockIdx.x * 512 + ltid(); e < 65536; e += gridDim.x * 512) wcm[e] = f2bf(src[e]);
    } else {
        tjob(p.in[19] + (size_t)j * 1024 * 3104, 1024, 3104, 3328, (bf16_t*)(ws + OFF_WIN), nullptr, 1.f, ldsg);
        tjob(p.in[25] + (size_t)j * 1024 * 1024, 1024, 1024, 1024, (bf16_t*)(ws + OFF_WOUT), nullptr, 1.f, ldsg);
    }
    tjob(p.in[8] + (size_t)i * 1024 * 4096, 1024, 4096, 4096, (bf16_t*)(ws + OFF_W1), nullptr, 1.f, ldsg);
    tjob(p.in[9] + (size_t)i * 4096 * 1024, 4096, 1024, 1024, (bf16_t*)(ws + OFF_W2), nullptr, 1.f, ldsg);
}

__device__ void phase_norm(const float* xl, const float* xc, const float* g, const float* mod  , int shift_i, int scale_i, bf16_t* H,
                           int nrows, const float* part, int npart, const float* pgate, float* xc_out) {
    const int lane = ltid() & 63, gw = blockIdx.x * 8 + (ltid() >> 6), nw = gridDim.x * 8;
    for (int row = gw; row < nrows; row += nw) {
        const float* src = row < RL ? xl + (size_t)row * DM : xc + (size_t)(row - RL) * DM;
        const int var = row < 16384 ? 0 : (row < RL ? 1 : 2);
        const float* sh = mod + var * 6144 + shift_i * 1024; const float* sc = mod + var * 6144 + scale_i * 1024;
        f32x4 x[4]; float ss = 0.f;
#pragma unroll
        for (int q = 0; q < 4; ++q) x[q] = *(const f32x4*)(src + q * 256 + lane * 4);
        if (row >= RL && part) {
#pragma unroll
            for (int q = 0; q < 4; ++q) { const int c = q * 256 + lane * 4;
                f32x4 acc = {0.f, 0.f, 0.f, 0.f};
                for (int kp = 0; kp < npart; ++kp) acc += *(const f32x4*)(part + ((size_t)kp * 512 + (row - RL)) * DM + c);
                x[q] += *(const f32x4*)(pgate + c) * acc;
                *(f32x4*)(xc_out + (size_t)(row - RL) * DM + c) = x[q]; }
        }
#pragma unroll
        for (int q = 0; q < 4; ++q) ss += x[q][0] * x[q][0] + x[q][1] * x[q][1] + x[q][2] * x[q][2] + x[q][3] * x[q][3];
        ss = wsum(ss);
        const float rstd = rsqrtf(ss * (1.f / 1024.f) + 1e-6f);
#pragma unroll
        for (int q = 0; q < 4; ++q) { const int c = q * 256 + lane * 4;
            const f32x4 gg = *(const f32x4*)(g + c), s1 = *(const f32x4*)(sc + c), s0 = *(const f32x4*)(sh + c);
            float o[4];
#pragma unroll
            for (int e = 0; e < 4; ++e) o[e] = x[q][e] * rstd * gg[e] * (1.f + s1[e]) + s0[e];
            const u32x2 pk = {pk2(o[0], o[1]), pk2(o[2], o[3])};
            *(u32x2*)(H + (size_t)row * DM + c) = pk; }
    }
}
__device__ void phase_final(const float* g, float* X) {
    const int lane = ltid() & 63, gw = blockIdx.x * 8 + (ltid() >> 6), nw = gridDim.x * 8;
    for (int row = gw; row < RL; row += nw) {
        float* src = X + (size_t)row * DM;
        f32x4 x[4]; float ss = 0.f;
#pragma unroll
        for (int q = 0; q < 4; ++q) { x[q] = *(const f32x4*)(src + q * 256 + lane * 4); ss += x[q][0] * x[q][0] + x[q][1] * x[q][1] + x[q][2] * x[q][2] + x[q][3] * x[q][3]; }
        ss = wsum(ss);
        const float rstd = rsqrtf(ss * (1.f / 1024.f) + 1e-6f);
#pragma unroll
        for (int q = 0; q < 4; ++q) { const int c = q * 256 + lane * 4; const f32x4 gg = *(const f32x4*)(g + c); *(f32x4*)(src + c) = x[q] * rstd * gg; }
    }
}

__device__ void phase_even_prep(const Params& p, int j, unsigned char* ldsg) {
    unsigned char* ws = p.ws;
    const bf16_t* P = (const bf16_t*)(ws + OFF_BIG);
    float* RSQ = (float*)(ws + OFF_RSQ); float* RSKV = (float*)(ws + OFF_RSKV);
    bf16_t* KR = (bf16_t*)(ws + OFF_KR); bf16_t* MIX = (bf16_t*)(ws + OFF_MIX);
    const int tid = ltid(), lane = tid & 63, w = tid >> 6, l32 = lane & 31, hh = lane >> 5;
    {
        const int gw = blockIdx.x * 8 + w, nw = gridDim.x * 8;
        for (int row = gw; row < R; row += nw) {
            const bf16_t* pr = P + (size_t)row * LDPE;
            float ss = 0.f;
#pragma unroll
            for (int q = 0; q < 3; ++q) { const unsigned u = *(const unsigned*)(pr + 2 * lane + 128 * q); const float a = bflo(u), b = bfhi(u); ss += a * a + b * b; }
            ss = wsum(ss);
            const u32x2 u2 = *(const u32x2*)(pr + 384 + 4 * lane);
            float s2 = bflo(u2[0]) * bflo(u2[0]) + bfhi(u2[0]) * bfhi(u2[0]) + bflo(u2[1]) * bflo(u2[1]) + bfhi(u2[1]) * bfhi(u2[1]);
            s2 = wsum(s2);
            if (lane == 0) { RSQ[row] = rsqrtf(ss * (1.f / 384.f) + 1e-6f); RSKV[row] = rsqrtf(s2 * (1.f / 256.f) + 1e-6f); }
            const float x = bf2f(pr[640 + l32]); const float y = __shfl_xor(x, 8);
            float o = x;
            if (row < RL) { const int l = row & 16383; const float pos = (float)(l32 < 16 ? (l >> 6) : (l & 63));
                float s, c; sincos_red(pos * rope_inv(l32 & 7), s, c);
                o = (l32 & 8) ? x * c + y * s : x * c - y * s; }
            if (lane < 32) KR[(size_t)row * 32 + lane] = f2bf(o);
        }
    }
    LAS unsigned char* lds = (LAS unsigned char*)ldsg;
    const bf16_t* WCM = (const bf16_t*)(ws + OFF_WCM);
    const float* cmn = p.in[15] + j * 128; const float* bs = p.in[17] + j * 512;
    for (int item = blockIdx.x; item < 1040; item += gridDim.x) {
        const int n = item >> 2, g = item & 3, r0 = n * 128;
        {
            const int s = tid >> 2, cq = tid & 3;
            const bf16_t* src = P + (size_t)(r0 + s) * LDPE + 1184 + g * 128 + cq * 32;
            float v[32]; float ss = 0.f;
#pragma unroll
            for (int q = 0; q < 4; ++q) { const u32x4 u = *(const u32x4*)(src + q * 8);
#pragma unroll
                for (int e = 0; e < 4; ++e) { const float a = gelu_t(bflo(u[e])), b = gelu_t(bfhi(u[e])); v[q * 8 + 2 * e] = a; v[q * 8 + 2 * e + 1] = b; ss += a * a + b * b; } }
            ss += __shfl_xor(ss, 1); ss += __shfl_xor(ss, 2);
            const float rstd = rsqrtf(ss * (1.f / 128.f) + 1e-6f);
#pragma unroll
            for (int q = 0; q < 4; ++q) { u32x4 o;
#pragma unroll
                for (int e = 0; e < 4; ++e) { const int c = cq * 32 + q * 8 + 2 * e; o[e] = pk2(v[q * 8 + 2 * e] * rstd * cmn[c], v[q * 8 + 2 * e + 1] * rstd * cmn[c + 1]); }
                *(LAS u32x4*)(lds + s * 272 + (cq * 32 + q * 8) * 2) = o; }
        }
        __syncthreads();
        const int tt = w >> 1, cp = (w & 1) * 2;
        f32x16 acc[2];
#pragma unroll
        for (int e = 0; e < 16; ++e) { acc[0][e] = 0.f; acc[1][e] = 0.f; }
#pragma unroll
        for (int ks = 0; ks < 8; ++ks) {
            const bf16x8 a = *(const bf16x8*)(WCM + g * 16384 + (32 * tt + l32) * 128 + 16 * ks + 8 * hh);
#pragma unroll
            for (int ct = 0; ct < 2; ++ct) { const bf16x8 b = tr_nat(lds, 272, 16 * ks, 32 * (cp + ct), lane); acc[ct] = MFMA32(a, b, acc[ct]); }
        }
#pragma unroll
        for (int ct = 0; ct < 2; ++ct)
#pragma unroll
            for (int i = 0; i < 16; ++i) {
                const int t = 32 * tt + (i >> 2) * 8 + 4 * hh + (i & 3), c = 32 * (cp + ct) + l32;
                const float val = acc[ct][i] + bs[g * 128 + t];
                const float u = gelu_t(bf2f(P[(size_t)(r0 + t) * LDPE + 672 + g * 128 + c]));
                MIX[(size_t)(r0 + t) * DM + 512 + g * 128 + c] = f2bf(u * val);
            }
        __syncthreads();
    }
}

__device__ void phase_kmax(const Params& p, unsigned char* ldsg) {
    unsigned char* ws = p.ws;
    const bf16_t* KV = (const bf16_t*)(ws + OFF_KV); const bf16_t* KR = (const bf16_t*)(ws + OFF_KR);
    float* KMS = (float*)(ws + OFF_KMS);
    float* red = (float*)ldsg;
    const int tid = ltid(), lane = tid & 63, w = tid >> 6, h = lane >> 3, jj = lane & 7;
    float mx0 = 0.f, mx1 = 0.f;
    for (int row = blockIdx.x * 8 + w; row < R; row += gridDim.x * 8) {
        const u32x4 a = *(const u32x4*)(KV + (size_t)row * 1024 + h * 128 + jj * 8);
        const u32x4 r = *(const u32x4*)(KR + (size_t)row * 32 + (jj & 3) * 8);
        float ss = 0.f, sr = 0.f;
#pragma unroll
        for (int e = 0; e < 4; ++e) { ss += bflo(a[e]) * bflo(a[e]) + bfhi(a[e]) * bfhi(a[e]); sr += bflo(r[e]) * bflo(r[e]) + bfhi(r[e]) * bfhi(r[e]); }
        ss += 0.5f * sr;
        ss += __shfl_xor(ss, 1); ss += __shfl_xor(ss, 2); ss += __shfl_xor(ss, 4);
        const int b = row < 16384 ? 0 : (row < RL ? 1 : ((row - RL) >> 8));
        if (b == 0) mx0 = fmaxf(mx0, ss); else mx1 = fmaxf(mx1, ss);
    }
    if (jj == 0) { red[w * 16 + h] = mx0; red[w * 16 + 8 + h] = mx1; }
    __syncthreads();
    if (tid < 16) { float m = red[tid];
#pragma unroll
        for (int q = 1; q < 8; ++q) m = fmaxf(m, red[q * 16 + tid]);
        KMS[blockIdx.x * 16 + tid] = m; }
    __syncthreads();
}

__device__ void phase_attn(const Params& p, unsigned char* ldsg) {
    unsigned char* ws = p.ws;
    const bf16_t* Q = (const bf16_t*)(ws + OFF_Q); const bf16_t* KV = (const bf16_t*)(ws + OFF_KV); const bf16_t* KR = (const bf16_t*)(ws + OFF_KR);
    bf16_t* MIX = (bf16_t*)(ws + OFF_MIX);
    LAS unsigned char* lds = (LAS unsigned char*)ldsg;
    const int tid = ltid(), lane = tid & 63, w = tid >> 6, l32 = lane & 31, hh = lane >> 5;
    constexpr int KROW = 208, VROW = 192, KBUF = 64 * KROW, VBUF = 64 * VROW, VBASE = 2 * KBUF;
    for (int it = blockIdx.x; it < 1040; it += gridDim.x) {
        int b, h, q0row, nkt; bool isctx;
        if (it < 1024) { h = it & 7; const int rest = it >> 3; b = rest >> 6; q0row = b * 16384 + (rest & 63) * 256; nkt = 260; isctx = false; }
        else { const int e = it - 1024; b = e >> 3; h = e & 7; q0row = RL + b * 256; nkt = 4; isctx = true; }
        const int qrow = q0row + w * 32 + l32;
        const bf16_t* qp = Q + (size_t)qrow * 768 + h * 96;
        bf16x8 qf[6];
#pragma unroll
        for (int s = 0; s < 4; ++s) qf[s] = *(const bf16x8*)(qp + 16 * s + 8 * hh);
#pragma unroll
        for (int s = 4; s < 6; ++s) {
            const bf16x8 own = *(const bf16x8*)(qp + 16 * s + 8 * hh);
            const bf16x8 oth = *(const bf16x8*)(qp + 16 * s + 8 * (1 - hh));
            if (!isctx) {
                const int l = qrow & 16383; const float pos = (float)(s == 4 ? (l >> 6) : (l & 63));
                float r[8];
#pragma unroll
                for (int jj = 0; jj < 8; ++jj) { float sn, cs; sincos_red(pos * rope_inv(jj), sn, cs);
                    const float x = bf2f((bf16_t)own[jj]), y = bf2f((bf16_t)oth[jj]); r[jj] = hh ? x * cs + y * sn : x * cs - y * sn; }
                qf[s] = pack8(r[0], r[1], r[2], r[3], r[4], r[5], r[6], r[7]);
            } else qf[s] = own;
        }
        float negm;
        {
            float qs = 0.f;
#pragma unroll
            for (int s = 0; s < 6; ++s)
#pragma unroll
                for (int e = 0; e < 8; ++e) { const float x = bf2f((bf16_t)qf[s][e]); qs += x * x; }
            qs += __shfl_xor(qs, 32);
            const float* KMS = (const float*)(ws + OFF_KMS) + b * 8 + h;
            float km = 0.f;
            for (int q = lane; q < (int)gridDim.x; q += 64) km = fmaxf(km, KMS[q * 16]);
#pragma unroll
            for (int o2 = 32; o2 >= 1; o2 >>= 1) km = fmaxf(km, __shfl_xor(km, o2));
            negm = -sqrtf(qs * km) * 1.0001f - 1e-3f;
        }
        const bf16_t* kp[2]; int kst[2]; int kdo[2]; bool kv_[2];
#pragma unroll
        for (int pp = 0; pp < 2; ++pp) {
            int c = tid + 512 * pp; if (c >= 768) c -= 512; kv_[pp] = true; const int key = c / 12, part = c % 12;
            if (part < 8) { kp[pp] = KV + (size_t)key * 1024 + h * 128 + part * 8; kst[pp] = 1024; }
            else { kp[pp] = KR + (size_t)key * 32 + (part - 8) * 8; kst[pp] = 32; }
            kdo[pp] = key * KROW + part * 16;
        }
        const bf16_t* vp = KV + (size_t)(tid >> 3) * 1024 + h * 128 + 64 + (tid & 7) * 8; const int vdo = (tid >> 3) * VROW + (tid & 7) * 16;
        auto rowbase = [&](int kt) -> int { return isctx ? (RL + b * 256 + kt * 64) : (kt < 256 ? b * 16384 + kt * 64 : RL + b * 256 + (kt - 256) * 64); };
        u32x4 prk[2], prv;
        auto loadK = [&](int kt) { const int rb = rowbase(kt);
#pragma unroll
            for (int pp = 0; pp < 2; ++pp) prk[pp] = *(const u32x4*)(kp[pp] + (size_t)rb * kst[pp]); };
        auto storeK = [&](int buf) {
#pragma unroll
            for (int pp = 0; pp < 2; ++pp) *(LAS u32x4*)(lds + buf * KBUF + kdo[pp]) = prk[pp]; };
        auto loadV = [&](int kt) { prv = *(const u32x4*)(vp + (size_t)rowbase(kt) * 1024); };
        auto storeV = [&](int buf) { *(LAS u32x4*)(lds + VBASE + buf * VBUF + vdo) = prv; };
        f32x16 pA[2], pB[2];
        f32x16 o[2];
#pragma unroll
        for (int e = 0; e < 16; ++e) { o[0][e] = 0.f; o[1][e] = 0.f; }
        float lsum = 0.f;
        auto qk = [&](int buf, f32x16 (&st)[2]) {
            LAS unsigned char* kb = lds + buf * KBUF;
#pragma unroll
            for (int e = 0; e < 16; ++e) { st[0][e] = negm; st[1][e] = negm; }
#pragma unroll
            for (int half = 0; half < 2; ++half) {
                bf16x8 kf[6];
#pragma unroll
                for (int s = 0; s < 3; ++s) {
                    kf[2 * s] = *(const LAS bf16x8*)(kb + l32 * KROW + (16 * (3 * half + s) + 8 * hh) * 2);
                    kf[2 * s + 1] = *(const LAS bf16x8*)(kb + (32 + l32) * KROW + (16 * (3 * half + s) + 8 * hh) * 2);
                }
                __builtin_amdgcn_sched_barrier(0);
#pragma unroll
                for (int s = 0; s < 3; ++s) { st[0] = MFMA32(kf[2 * s], qf[3 * half + s], st[0]); st[1] = MFMA32(kf[2 * s + 1], qf[3 * half + s], st[1]); }
            }
        };
        auto partialSM = [&](f32x16 (&pp)[2]) {
#pragma unroll
            for (int e = 0; e < 16; ++e) pp[0][e] = __builtin_amdgcn_exp2f(pp[0][e]);
        };
        bf16x8 pa[4];
        auto finishSM = [&](f32x16 (&pp)[2]) {
#pragma unroll
            for (int e = 0; e < 16; ++e) pp[1][e] = __builtin_amdgcn_exp2f(pp[1][e]);
            float ps = 0.f;
#pragma unroll
            for (int e = 0; e < 16; ++e) ps += pp[0][e] + pp[1][e];
            lsum += ps;
            pa[0] = pack8(pp[0][0], pp[0][1], pp[0][2], pp[0][3], pp[0][4], pp[0][5], pp[0][6], pp[0][7]);
            pa[1] = pack8(pp[0][8], pp[0][9], pp[0][10], pp[0][11], pp[0][12], pp[0][13], pp[0][14], pp[0][15]);
            pa[2] = pack8(pp[1][0], pp[1][1], pp[1][2], pp[1][3], pp[1][4], pp[1][5], pp[1][6], pp[1][7]);
            pa[3] = pack8(pp[1][8], pp[1][9], pp[1][10], pp[1][11], pp[1][12], pp[1][13], pp[1][14], pp[1][15]);
        };
        auto pv = [&](int buf) {
            LAS unsigned char* vb = lds + VBASE + buf * VBUF;
            bf16x8 vf[8];
#pragma unroll
            for (int vt = 0; vt < 2; ++vt)
#pragma unroll
                for (int q = 0; q < 4; ++q) vf[vt * 4 + q] = tr_perm(vb, VROW, 16 * q, 32 * vt, lane);
            __builtin_amdgcn_sched_barrier(0);
#pragma unroll
            for (int vt = 0; vt < 2; ++vt)
#pragma unroll
                for (int q = 0; q < 4; ++q) o[vt] = MFMA32(vf[vt * 4 + q], pa[q], o[vt]);
        };
        auto step = [&](int j, f32x16 (&pc)[2], f32x16 (&pn)[2]) {
            const int j2 = j + 2 < nkt ? j + 2 : nkt - 1;
            __builtin_amdgcn_sched_barrier(0);
            qk((j + 1) & 1, pn);
            finishSM(pc);
            __builtin_amdgcn_sched_barrier(0);
            loadK(j2); loadV(j + 1);
            __builtin_amdgcn_sched_barrier(0);
            pv(j & 1);
            partialSM(pn);
            __builtin_amdgcn_sched_barrier(0);
            storeK(j & 1); storeV((j + 1) & 1);
            __syncthreads();
        };
        loadK(0); loadV(0); storeK(0); storeV(0);
        loadK(1); storeK(1);
        __syncthreads();
        qk(0, pA); partialSM(pA);
        __syncthreads();
        for (int kt = 0; kt + 2 < nkt; kt += 2) {
            step(kt, pA, pB);
            step(kt + 1, pB, pA);
        }
        step(nkt - 2, pA, pB);
        finishSM(pB);
        pv((nkt - 1) & 1);
        __syncthreads();
        lsum += __shfl_xor(lsum, 32);
        const float inv = 1.f / lsum;
        bf16_t* op = MIX + (size_t)qrow * DM + h * 64;
#pragma unroll
        for (int vt = 0; vt < 2; ++vt)
#pragma unroll
            for (int g4 = 0; g4 < 4; ++g4) {
                const u32x2 pk = {pk2(o[vt][4 * g4] * inv, o[vt][4 * g4 + 1] * inv), pk2(o[vt][4 * g4 + 2] * inv, o[vt][4 * g4 + 3] * inv)};
                *(u32x2*)(op + 32 * vt + 8 * g4 + 4 * hh) = pk;
            }
    }
}

__device__ void phase_gla_prep(const Params& p, int j, unsigned char* ldsg) {
    unsigned char* ws = p.ws;
    const bf16_t* P = (const bf16_t*)(ws + OFF_BIG);
    bf16_t* QTF = (bf16_t*)(ws + OFF_QTF); bf16_t* KTF = (bf16_t*)(ws + OFF_KTF); bf16_t* QTB = (bf16_t*)(ws + OFF_QTB); bf16_t* KTB = (bf16_t*)(ws + OFF_KTB);
    float* DECF = (float*)(ws + OFF_DECF); float* DECB = (float*)(ws + OFF_DECB);
    float* zl = (float*)ldsg;
    float* seg = zl + 2048;
    const int tid = ltid();
    const float* wgf = p.in[20] + (size_t)j * 16 * 512; const float* wgb = p.in[22] + (size_t)j * 16 * 512;
    const float* bgf = p.in[21] + j * 512; const float* bgb = p.in[23] + j * 512;
    for (int item = blockIdx.x; item < 2080; item += gridDim.x) {
        const int ck = item >> 2, h = item & 3, r0 = ck * 64;
        { const int t = tid >> 3, j0 = (tid & 7) * 4; const u32x2 u = *(const u32x2*)(P + (size_t)(r0 + t) * LDPO + 1536 + j0);
          zl[t * 32 + j0] = bflo(u[0]); zl[t * 32 + j0 + 1] = bfhi(u[0]); zl[t * 32 + j0 + 2] = bflo(u[1]); zl[t * 32 + j0 + 3] = bfhi(u[1]); }
        __syncthreads();
        const int d = tid & 127, tq = tid >> 7, hd = h * 128 + d;
        float wf[16], wb[16];
#pragma unroll
        for (int q = 0; q < 16; ++q) { wf[q] = wgf[q * 512 + hd]; wb[q] = wgb[q * 512 + hd]; }
        const float bf_ = bgf[hd], bb_ = bgb[hd];
        float lf[16], lb[16];
#pragma unroll
        for (int i = 0; i < 16; ++i) {
            const float* zr = zl + (tq * 16 + i) * 32;
            float gf = bf_, gb = bb_;
#pragma unroll
            for (int q = 0; q < 16; ++q) { gf = fmaf(zr[q], wf[q], gf); gb = fmaf(zr[16 + q], wb[q], gb); }
            lf[i] = (fminf(gf, 0.f) - __logf(1.f + __expf(-fabsf(gf)))) * 0.0625f;
            lb[i] = (fminf(gb, 0.f) - __logf(1.f + __expf(-fabsf(gb)))) * 0.0625f;
        }
        float run = 0.f;
#pragma unroll
        for (int i = 0; i < 16; ++i) { run += lf[i]; lf[i] = run; }
        const float segF = run; run = 0.f;
#pragma unroll
        for (int i = 15; i >= 0; --i) { run += lb[i]; lb[i] = run; }
        const float segB = run;
        seg[tq * 128 + d] = segF; seg[512 + tq * 128 + d] = segB;
        __syncthreads();
        float offF = 0.f, totF = 0.f, offB = 0.f, totB = 0.f;
#pragma unroll
        for (int q = 0; q < 4; ++q) { const float a = seg[q * 128 + d], b2 = seg[512 + q * 128 + d]; totF += a; totB += b2; if (q < tq) offF += a; if (q > tq) offB += b2; }
#pragma unroll
        for (int i = 0; i < 16; ++i) {
            const size_t row = (size_t)(r0 + tq * 16 + i);
            const float q = bf2f(P[row * LDPO + 1568 + hd]) * 0.08838834764f, k = bf2f(P[row * LDPO + hd]);
            const float cf = lf[i] + offF, cb = lb[i] + offB;
            QTF[row * 512 + hd] = f2bf(q * __expf(cf)); KTF[row * 512 + hd] = f2bf(k * __expf(-cf));
            QTB[row * 512 + hd] = f2bf(q * __expf(cb)); KTB[row * 512 + hd] = f2bf(k * __expf(-cb));
        }
        if (tq == 0) { DECF[(size_t)(ck * 4 + h) * 128 + d] = __expf(totF); DECB[(size_t)(ck * 4 + h) * 128 + d] = __expf(totB); }
        __syncthreads();
    }
}

constexpr int NGC = 8, NGRP = 256 / NGC, NSLOT = NGRP + 1;
constexpr int G_QOFF = 0, G_KOFF = 17408, G_VOFF = 34816, G_DOFF = 68608, G_BUF = 69120, G_SSQ = 2 * G_BUF;
template <bool OUT>
__device__ __forceinline__ void gla_seq(const Params& p, int j, LAS unsigned char* lds, int b, int h, int dir, bool ctx, int g, f32x16 (&S)[4], float* gdout) {
    unsigned char* ws = p.ws;
    const bf16_t* P = (const bf16_t*)(ws + OFF_BIG);
    const bf16_t* QT = (const bf16_t*)(ws + (dir ? OFF_QTB : OFF_QTF)); const bf16_t* KT = (const bf16_t*)(ws + (dir ? OFF_KTB : OFF_KTF));
    const float* DEC = (const float*)(ws + (dir ? OFF_DECB : OFF_DECF));
    bf16_t* MIX = (bf16_t*)(ws + OFF_MIX);
    const float* onorm = p.in[24] + j * 256;
    const int tid = ltid(), lane = tid & 63, w = tid >> 6, l32 = lane & 31, hh = lane >> 5;
    const int nsteps = ctx ? 4 : NGC;
    auto chunk_of = [&](int i) -> int { const int c = ctx ? (dir ? 3 - i : i) : (dir ? NGC * g + NGC - 1 - i : NGC * g + i); return ctx ? 512 + b * 4 + c : b * 256 + c; };
    u32x4 pq[2], pk[2], pv[4], pd;
    auto gload = [&](int ck, int tid) {
        const size_t rb = (size_t)ck * 64;
#pragma unroll
        for (int pp = 0; pp < 2; ++pp) { const int c = tid + 512 * pp, row = c >> 4, cc = c & 15;
            if (OUT) pq[pp] = *(const u32x4*)(QT + (rb + row) * 512 + h * 128 + cc * 8);
            pk[pp] = *(const u32x4*)(KT + (rb + row) * 512 + h * 128 + cc * 8); }
#pragma unroll
        for (int pp = 0; pp < 4; ++pp) { const int c = tid + 512 * pp, row = c >> 5, cc = c & 31; pv[pp] = *(const u32x4*)(P + (rb + row) * LDPO + 512 + h * 256 + cc * 8); }
        if (tid < 32) pd = *(const u32x4*)(DEC + (size_t)(ck * 4 + h) * 128 + tid * 4);
    };
    auto lstore = [&](LAS unsigned char* bb, int tid) {
#pragma unroll
        for (int pp = 0; pp < 2; ++pp) { const int c = tid + 512 * pp, row = c >> 4, cc = c & 15;
            if (OUT) *(LAS u32x4*)(bb + G_QOFF + row * 272 + cc * 16) = pq[pp];
            *(LAS u32x4*)(bb + G_KOFF + row * 272 + cc * 16) = pk[pp]; }
#pragma unroll
        for (int pp = 0; pp < 4; ++pp) { const int c = tid + 512 * pp, row = c >> 5, cc = c & 31; *(LAS u32x4*)(bb + G_VOFF + row * 528 + cc * 16) = pv[pp]; }
        if (tid < 32) *(LAS u32x4*)(bb + G_DOFF + tid * 16) = pd;
    };
    float gd = 1.f;
    gload(chunk_of(0), tid); lstore(lds, tid);
    __syncthreads();
    for (int i = 0; i < nsteps; ++i) {
        const bool more = i + 1 < nsteps;
        const int ck = chunk_of(i);
        const int tid2 = ltid();
        if (more) gload(chunk_of(i + 1), tid2);
        LAS unsigned char* bb = lds + (i & 1) * G_BUF;
        LAS unsigned char* qb = bb + G_QOFF; LAS unsigned char* kb = bb + G_KOFF; LAS unsigned char* vb = bb + G_VOFF;
        const LAS float* dec = (const LAS float*)(bb + G_DOFF);
        if (!OUT) { if (tid < 128) gd *= dec[tid]; }
        if (OUT) {
            f32x16 o[2];
#pragma unroll
            for (int e = 0; e < 16; ++e) { o[0][e] = 0.f; o[1][e] = 0.f; }
#pragma unroll
            for (int st = 0; st < 2; ++st)
#pragma unroll
                for (int tt = 0; tt < 2; ++tt) {
                    if (dir ? (st == 0 && tt == 1) : (st == 1 && tt == 0)) continue;
                    f32x16 am;
#pragma unroll
                    for (int e = 0; e < 16; ++e) am[e] = 0.f;
#pragma unroll
                    for (int ks = 0; ks < 8; ++ks) {
                        const bf16x8 a = *(const LAS bf16x8*)(kb + (32 * st + l32) * 272 + (16 * ks + 8 * hh) * 2);
                        const bf16x8 bq = *(const LAS bf16x8*)(qb + (32 * tt + l32) * 272 + (16 * ks + 8 * hh) * 2);
                        am = MFMA32(a, bq, am);
                    }
                    const int t = 32 * tt + l32;
#pragma unroll
                    for (int e = 0; e < 16; ++e) { const int s = 32 * st + (e >> 2) * 8 + 4 * hh + (e & 3); const bool keep = dir ? (t <= s) : (t >= s); am[e] = keep ? am[e] : 0.f; }
                    const bf16x8 pm0 = pack8(am[0], am[1], am[2], am[3], am[4], am[5], am[6], am[7]);
                    const bf16x8 pm1 = pack8(am[8], am[9], am[10], am[11], am[12], am[13], am[14], am[15]);
                    const bf16x8 a0 = tr_perm(vb, 528, 32 * st, 32 * w, lane);
                    o[tt] = MFMA32(a0, pm0, o[tt]);
                    const bf16x8 a1 = tr_perm(vb, 528, 32 * st + 16, 32 * w, lane);
                    o[tt] = MFMA32(a1, pm1, o[tt]);
                    __builtin_amdgcn_sched_barrier(0);
                }
#pragma unroll
            for (int dt = 0; dt < 4; ++dt)
#pragma unroll
                for (int ks2 = 0; ks2 < 2; ++ks2) {
                    const bf16x8 a = pack8(S[dt][8 * ks2], S[dt][8 * ks2 + 1], S[dt][8 * ks2 + 2], S[dt][8 * ks2 + 3], S[dt][8 * ks2 + 4], S[dt][8 * ks2 + 5], S[dt][8 * ks2 + 6], S[dt][8 * ks2 + 7]);
#pragma unroll
                    for (int tt = 0; tt < 2; ++tt) {
                        LAS unsigned char* qa = qb + (32 * tt + l32) * 272 + (32 * dt + 16 * ks2 + 4 * hh) * 2;
                        const bf16x4 x = *(const LAS bf16x4*)qa, y = *(const LAS bf16x4*)(qa + 16);
                        const bf16x8 bq = __builtin_shufflevector(x, y, 0, 1, 2, 3, 4, 5, 6, 7);
                        o[tt] = MFMA32(a, bq, o[tt]);
                    }
                    __builtin_amdgcn_sched_barrier(0);
                }
            {
                LAS unsigned char* stg = lds + ((i + 1) & 1) * G_BUF + G_VOFF;
#pragma unroll
                for (int tt = 0; tt < 2; ++tt)
#pragma unroll
                    for (int g4 = 0; g4 < 4; ++g4) {
                        const u32x2 pkv = {pk2(o[tt][4 * g4], o[tt][4 * g4 + 1]), pk2(o[tt][4 * g4 + 2], o[tt][4 * g4 + 3])};
                        *(LAS u32x2*)(stg + (32 * tt + l32) * 528 + (32 * w + 8 * g4 + 4 * hh) * 2) = pkv;
                    }
                __syncthreads();
                const size_t rbase = (size_t)ck * 64;
                const int tq = tid2 >> 5, cc = tid2 & 31;
                if (dir == 0) {
#pragma unroll
                    for (int pp = 0; pp < 4; ++pp) {
                        const int t = tq + 16 * pp;
                        *(u32x4*)(MIX + (rbase + t) * DM + h * 256 + cc * 8) = *(const LAS u32x4*)(stg + t * 528 + cc * 16);
                    }
                } else {
                    u32x4 of[4], rg[4];
#pragma unroll
                    for (int pp = 0; pp < 4; ++pp) {
                        const int t = tq + 16 * pp;
                        of[pp] = *(const u32x4*)(MIX + (rbase + t) * DM + h * 256 + cc * 8);
                        rg[pp] = *(const u32x4*)(P + (rbase + t) * LDPO + 2080 + h * 256 + cc * 8);
                    }
                    const f32x4 gn0 = *(const f32x4*)(onorm + cc * 8), gn1 = *(const f32x4*)(onorm + cc * 8 + 4);
#pragma unroll
                    for (int pp = 0; pp < 4; ++pp) {
                        const int t = tq + 16 * pp;
                        const u32x4 ob = *(const LAS u32x4*)(stg + t * 528 + cc * 16);
                        float v[8]; float ss = 0.f;
#pragma unroll
                        for (int e = 0; e < 4; ++e) { v[2 * e] = bflo(ob[e]) + bflo(of[pp][e]); v[2 * e + 1] = bfhi(ob[e]) + bfhi(of[pp][e]); ss += v[2 * e] * v[2 * e] + v[2 * e + 1] * v[2 * e + 1]; }
#pragma unroll
                        for (int o2 = 16; o2 >= 1; o2 >>= 1) ss += __shfl_xor(ss, o2);
                        const float rstd = rsqrtf(ss * (1.f / 256.f) + 1e-6f);
                        u32x4 ov;
#pragma unroll
                        for (int e = 0; e < 4; ++e) {
                            const float g0 = e < 2 ? gn0[2 * e] : gn1[2 * e - 4], g1 = e < 2 ? gn0[2 * e + 1] : gn1[2 * e - 3];
                            ov[e] = pk2(v[2 * e] * rstd * g0 * silu_f(bflo(rg[pp][e])), v[2 * e + 1] * rstd * g1 * silu_f(bfhi(rg[pp][e])));
                        }
                        *(u32x4*)(MIX + (rbase + t) * DM + h * 256 + cc * 8) = ov;
                    }
                }
            }
        }
        if (OUT) { __builtin_amdgcn_sched_barrier(0); }
#pragma unroll
        for (int ks = 0; ks < 4; ++ks) {
            const bf16x8 bv = tr_nat(vb, 528, 16 * ks, 32 * w, lane);
#pragma unroll
            for (int dt = 0; dt < 4; ++dt) { const bf16x8 a = tr_nat(kb, 272, 16 * ks, 32 * dt, lane); S[dt] = MFMA32(a, bv, S[dt]); }
        }
#pragma unroll
        for (int dt = 0; dt < 4; ++dt)
#pragma unroll
            for (int g4 = 0; g4 < 4; ++g4) { const f32x4 dv = *(const LAS f32x4*)(dec + 32 * dt + 8 * g4 + 4 * hh);
#pragma unroll
                for (int e = 0; e < 4; ++e) S[dt][4 * g4 + e] *= dv[e]; }
        if (OUT) __syncthreads();
        if (more) lstore(lds + ((i + 1) & 1) * G_BUF, tid2);
        __syncthreads();
    }
    if (!OUT) { if (tid < 128) gdout[tid] = gd; }
}
__device__ __forceinline__ void s_zero(f32x16 (&S)[4]) {
#pragma unroll
    for (int dt = 0; dt < 4; ++dt)
#pragma unroll
        for (int e = 0; e < 16; ++e) S[dt][e] = 0.f;
}
__device__ __forceinline__ void s_store(const f32x16 (&S)[4], bf16_t* slot) {
    const int lane = ltid() & 63, w = ltid() >> 6, l32 = lane & 31, hh = lane >> 5;
#pragma unroll
    for (int dt = 0; dt < 4; ++dt)
#pragma unroll
        for (int e = 0; e < 16; ++e) slot[(32 * dt + (e >> 2) * 8 + 4 * hh + (e & 3)) * 256 + 32 * w + l32] = f2bf(S[dt][e]);
}
__device__ __forceinline__ void s_load(f32x16 (&S)[4], const bf16_t* slot) {
    const int lane = ltid() & 63, w = ltid() >> 6, l32 = lane & 31, hh = lane >> 5;
#pragma unroll
    for (int dt = 0; dt < 4; ++dt)
#pragma unroll
        for (int e = 0; e < 16; ++e) S[dt][e] = bf2f(slot[(32 * dt + (e >> 2) * 8 + 4 * hh + (e & 3)) * 256 + 32 * w + l32]);
}
__device__ void phase_gla_a(const Params& p, int j, unsigned char* ldsg) {
    bf16_t* SLOC = (bf16_t*)(p.ws + OFF_SLOC); float* GD = (float*)(p.ws + OFF_GD);
    for (int item = blockIdx.x; item < 16 * NSLOT; item += gridDim.x) {
        const int combo = item < 16 * NGRP ? item / NGRP : item - 16 * NGRP, g = item < 16 * NGRP ? item % NGRP : NGRP;
        const int dir = combo & 1, h = (combo >> 1) & 3, b = combo >> 3, slot = combo * NSLOT + g;
        f32x16 S[4]; s_zero(S);
        gla_seq<false>(p, j, (LAS unsigned char*)ldsg, b, h, dir, g == NGRP, g, S, GD + (size_t)slot * 128);
        s_store(S, SLOC + (size_t)slot * 32768);
    }
}
__device__ void phase_gla_b(const Params& p) {
    bf16_t* SLOC = (bf16_t*)(p.ws + OFF_SLOC); const float* GD = (const float*)(p.ws + OFF_GD);
    for (int e = blockIdx.x * 512 + ltid(); e < 16 * 32768; e += gridDim.x * 512) {
        const int combo = e >> 15, dv = e & 32767, d = dv >> 8, dir = combo & 1, base = combo * NSLOT;
        float S = bf2f(SLOC[(size_t)(base + NGRP) * 32768 + dv]);
        for (int q = 0; q < NGRP; ++q) {
            const int g = dir ? NGRP - 1 - q : q;
            const size_t o = (size_t)(base + g) * 32768 + dv;
            const float tmp = bf2f(SLOC[o]); SLOC[o] = f2bf(S); S = GD[(base + g) * 128 + d] * S + tmp;
        }
    }
}
__device__ void phase_gla_c(const Params& p, int j, unsigned char* ldsg) {
    const bf16_t* SLOC = (const bf16_t*)(p.ws + OFF_SLOC);
    for (int item = blockIdx.x; item < 8 * NSLOT; item += gridDim.x) {
        const int bh = item < 8 * NGRP ? item / NGRP : item - 8 * NGRP, g = item < 8 * NGRP ? item % NGRP : NGRP;
        const int h = bh & 3, b = bh >> 2;
        f32x16 S[4];
        for (int dir = 0; dir < 2; ++dir) {
            if (g == NGRP) s_zero(S); else s_load(S, SLOC + (size_t)((bh * 2 + dir) * NSLOT + g) * 32768);
            gla_seq<true>(p, j, (LAS unsigned char*)ldsg, b, h, dir, g == NGRP, g, S, nullptr);
        }
    }
}

#define XB_TMO      128
#define XB_XCNT(j)  (256  + 64 * (j))
#define XB_XSUB(j)  (1280 + 64 * (j))
#define XB_XGEN(j)  (2304 + 64 * (j))
#define XB_TOP      3328
#define XB_TOPGEN   3392
#define XCD_BAR_WORDS 3456
#define XB_SPIN_CAP (1u << 18)
__device__ __forceinline__ unsigned xb_ld(unsigned* p)              { return __hip_atomic_load(p, __ATOMIC_RELAXED, __HIP_MEMORY_SCOPE_AGENT); }
__device__ __forceinline__ unsigned xb_add(unsigned* p, unsigned v) { return __hip_atomic_fetch_add(p, v, __ATOMIC_RELAXED, __HIP_MEMORY_SCOPE_AGENT); }
__device__ __forceinline__ unsigned xb_xcc_id() { return (unsigned)__builtin_amdgcn_s_getreg((3 << 11) | 20) & 0xFu; }
#define XB_SPIN(cond, bar) do { unsigned _sp = 0; while (cond) { __builtin_amdgcn_s_sleep(1); \
    if ((++_sp & 255u) == 0u) { if (xb_ld(&(bar)[XB_TMO])) break; if (_sp > XB_SPIN_CAP) { atomicAdd(&(bar)[XB_TMO], 1u); break; } } } } while (0)
struct XcdBarrier { unsigned* bar; unsigned x; volatile LAS unsigned* st; };
__device__ __forceinline__ XcdBarrier xcd_barrier_post(unsigned* bar, volatile LAS unsigned* st) {
    XcdBarrier b; b.bar = bar; b.x = xb_xcc_id(); b.st = st;
    if (threadIdx.x == 0) (void)xb_add(&bar[XB_XCNT(b.x)], 1u);
    return b;
}
__device__ __forceinline__ void xcd_barrier_complete(unsigned* bar, unsigned x, unsigned& nloc, unsigned& nx) {
    const unsigned G = gridDim.x * gridDim.y * gridDim.z;
    unsigned sum, cnt, mine, sp = 0u;
    for (;;) {
        sum = 0u; cnt = 0u; mine = 0u;
#pragma unroll
        for (unsigned j = 0; j < 16; ++j) { const unsigned c = xb_ld(&bar[XB_XCNT(j)]); sum += c; cnt += (c > 0u) ? 1u : 0u; mine = (j == x) ? c : mine; }
        if (sum == G) break;
        __builtin_amdgcn_s_sleep(1);
        if ((++sp & 255u) == 0u) { if (xb_ld(&bar[XB_TMO])) break; if (sp > XB_SPIN_CAP) { atomicAdd(&bar[XB_TMO], 1u); break; } }
    }
    nloc = mine > 0u ? mine : 1u; nx = cnt > 0u ? cnt : 1u;
}
__device__ __forceinline__ void xcd_barrier(const XcdBarrier& b) {
    asm volatile("s_waitcnt vmcnt(0)" ::: "memory");
    __syncthreads();
    if (threadIdx.x == 0) {
        unsigned* bar = b.bar;
        __builtin_amdgcn_s_waitcnt(0);
        unsigned nloc = b.st[0], nx = b.st[1];
        if (nloc == 0u) { xcd_barrier_complete(bar, b.x, nloc, nx); b.st[0] = nloc; b.st[1] = nx; }
        const unsigned old = xb_add(&bar[XB_XSUB(b.x)], 1u);
        const unsigned gen = old / nloc;
        if (old + 1u == (gen + 1u) * nloc) {
            __builtin_amdgcn_fence(__ATOMIC_RELEASE, "agent");
            asm volatile("s_waitcnt vmcnt(0)" ::: "memory");
            const unsigned og = xb_add(&bar[XB_TOP], 1u);
            const unsigned tg = og / nx;
            if (og + 1u == (tg + 1u) * nx) xb_add(&bar[XB_TOPGEN], 1u);
            else XB_SPIN(xb_ld(&bar[XB_TOPGEN]) == tg, bar);
            __builtin_amdgcn_fence(__ATOMIC_ACQUIRE, "agent");
            xb_add(&bar[XB_XGEN(b.x)], 1u);
            asm volatile("s_waitcnt vmcnt(0)" ::: "memory");
        } else {
            XB_SPIN(xb_ld(&bar[XB_XGEN(b.x)]) == gen, bar);
            __builtin_amdgcn_fence(__ATOMIC_ACQUIRE, "agent");
            asm volatile("s_waitcnt vmcnt(0)" ::: "memory");
        }
    }
    __syncthreads();
}
#ifndef PROBE_REP
#define PROBE_REP 0
#endif
#ifndef PHM
#define PHM 0xFFFF
#endif
#define PH(b) if (PHM & (1 << (b)))
enum { K_N1 = 0, K_GIN, K_PREP, K_GQ, K_GKV, K_ATT, K_GPREP, K_GA, K_GB, K_GC, K_GOUT, K_N2, K_GUP, K_GDN, K_COPY, K_NONE, K_KMAX };
__global__ void __launch_bounds__(512, 2) mega(Params p) {
    extern __shared__ __attribute__((aligned(16))) unsigned char ldsg[];
    LAS unsigned char* lds = (LAS unsigned char*)ldsg;
    cg::grid_group grid = cg::this_grid();
    unsigned char* ws = p.ws;
    float* MOD = (float*)(ws + OFF_MOD);
    float* XC = (float*)(ws + OFF_XC);
    bf16_t* H = (bf16_t*)(ws + OFF_H); bf16_t* MIX = (bf16_t*)(ws + OFF_MIX);
    bf16_t* PB = (bf16_t*)(ws + OFF_BIG);
    const bool en_even = p.flags & 1, en_odd = p.flags & 2, en_mlp = p.flags & 4;

    volatile LAS unsigned* xst = (volatile LAS unsigned*)(lds + LDS_BYTES - 16);
    if (threadIdx.x == 0) { xst[0] = 0u; xst[1] = 0u; }
    __syncthreads();
    const XcdBarrier xbar = xcd_barrier_post((unsigned*)(ws + OFF_BAR), xst);
    PH(0) phase_ada(p, ldsg);
    grid.sync();
    for (int step = 0; step < 44; ++step) {
        const int i = step / 11, s = step % 11, j = i >> 1; const bool even = !(i & 1);
        const float* mod = MOD + (size_t)i * 3 * 6144;
        const bool en_mix = even ? en_even : en_odd;
        const bool first = (i == 0) && (s <= 7);
        const float* xl = first ? p.in[0] : p.out; const float* xc = ((i == 0) && (s <= 8)) ? p.in[2] : XC;
        float* PART = (float*)(ws + OFF_PART);
        int kind;
        switch (s) {
            case 0: kind = K_N1; break;
            case 1: kind = K_GIN; break;
            case 2: kind = even ? K_PREP : K_GPREP; break;
            case 3: kind = even ? K_GQ : K_GA; break;
            case 4: kind = even ? K_GKV : K_GB; break;
            case 5: kind = even ? K_KMAX : K_GC; break;
            case 6: kind = even ? K_ATT : K_NONE; break;
            case 7: kind = K_GOUT; break;
            case 8: kind = K_N2; break;
            case 9: kind = K_GUP; break;
            default: kind = K_GDN; break;
        }
        if (s <= 7 && !en_mix) kind = (s == 0) ? K_NONE : ((i == 0 && s == 7) ? K_COPY : K_NONE);
        if (s >= 8 && !en_mlp) kind = K_NONE;
        if (s == 0) { PH(1) phase_weights(p, i, ldsg); }
        if (kind == K_NONE) { if (s == 0) xcd_barrier(xbar); continue; }
        bool gemmB = false, gemmR = false, nosync = false;
        pg8::EpiB EB; EB.O = PB; EB.ldo = 0; EB.rs = nullptr; EB.mode = 0;
        pg8::EpiR ER; ER.xin_l = xl; ER.xin_c = xc; ER.xout_l = p.out; ER.xout_c = XC; ER.gate = mod;
        const bf16_t* gA = H; const bf16_t* gB = (const bf16_t*)(ws + OFF_WIN); int lda = 1024, ldb = 1024, gN = 1024, gK = 1024, gM = R, nP = 0, Kp = 256;
        const int reps = ((p.flags >> (8 + kind)) & 1) ? 2 : 1;
        for (int rep = 0; rep < reps; ++rep) {
        if (rep) __syncthreads();
        switch (kind) {
            case K_N1: PH(2) phase_norm(xl, xc, p.in[6] + i * 1024, mod, 0, 1, H, R, i > 0 ? PART : nullptr, 8, mod - 3 * 6144 + 2 * 6144 + 5 * 1024, XC); break;
            case K_N2: PH(2) phase_norm(xl, xc, p.in[7] + i * 1024, mod, 3, 4, H, i < 3 ? R : RL, PART, 4, mod + 2 * 6144 + 2 * 1024, XC); break;
            case K_GIN: gemmB = true; gN = even ? 1792 : 3328; EB.ldo = gN; break;
            case K_PREP: PH(4) phase_even_prep(p, j, ldsg); break;
            case K_GQ: gemmB = true; nosync = true; gA = PB; lda = LDPE; gB = (const bf16_t*)(ws + OFF_WUQ); ldb = 384; gN = 768; gK = 384; EB.O = (bf16_t*)(ws + OFF_Q); EB.ldo = 768; EB.rs = (const float*)(ws + OFF_RSQ); break;
            case K_GKV: gemmB = true; gA = PB + 384; lda = LDPE; gB = (const bf16_t*)(ws + OFF_WUKV); ldb = 256; gN = 1024; gK = 256; EB.O = (bf16_t*)(ws + OFF_KV); EB.ldo = 1024; EB.rs = (const float*)(ws + OFF_RSKV); break;
            case K_KMAX: PH(4) phase_kmax(p, ldsg); break;
            case K_ATT: PH(5) phase_attn(p, ldsg); break;
            case K_GPREP: PH(6) phase_gla_prep(p, j, ldsg); break;
            case K_GA: PH(7) phase_gla_a(p, j, ldsg); break;
            case K_GB: PH(8) phase_gla_b(p); break;
            case K_GC: PH(9) phase_gla_c(p, j, ldsg); break;
            case K_GOUT: gemmR = true; gA = MIX; gB = (const bf16_t*)(ws + OFF_WOUT); ER.gate = mod + 2 * 1024; gM = RL; nP = i < 3 ? 4 : 0; Kp = 256; break;
            case K_GUP: gemmB = true; gB = (const bf16_t*)(ws + OFF_W1); gN = 4096; EB.ldo = 4096; EB.mode = 1; gM = i < 3 ? R : RL; break;
            case K_GDN: gemmR = true; gA = PB; lda = 4096; gB = (const bf16_t*)(ws + OFF_W2); ldb = 4096; gK = 4096; ER.gate = mod + 5 * 1024; gM = RL; nP = i < 3 ? 8 : 0; Kp = 512; break;
            case K_COPY:
                for (size_t e = (size_t)blockIdx.x * 512 + ltid(); e < (size_t)R * 256; e += (size_t)gridDim.x * 512) {
                    const size_t row = e >> 8, c4 = (e & 255) * 4;
                    if (row < RL) *(f32x4*)(p.out + row * DM + c4) = *(const f32x4*)(xl + row * DM + c4);
                    else *(f32x4*)(XC + (row - RL) * DM + c4) = *(const f32x4*)(xc + (row - RL) * DM + c4);
                }
                break;
            default: break;
        }
        if (gemmB) { PH(3) run_gemm(lds, gA, lda, gB, ldb, gM, gN, gK, EB, kind == K_GKV); }
        if (gemmR) { PH(10) { run_gemm(lds, gA, lda, gB, ldb, gM, gN, gK, ER); if (nP) run_pieces(lds, gA + (size_t)RL * lda, lda, gB, ldb, nP, Kp, PART); } }
        }
        if (!nosync) xcd_barrier(xbar);
    }
    PH(11) phase_final(p.in[26], p.out);
}

extern "C" void kernel_launch(void* const* d_in, const int* in_sizes, int n_in, void* d_out, int out_size, void* d_ws, size_t ws_size, hipStream_t stream) {
    static int grid = 0;
    if (grid == 0) {
        if (n_in != 27 || ws_size < WS_NEED) { fprintf(stderr, "kernel_launch: unexpected n_in %d / ws %zu\n", n_in, ws_size); grid = -1; return; }
        int dev = 0, cus = 0, per_cu = 0;
        hipGetDevice(&dev);
        hipDeviceGetAttribute(&cus, hipDeviceAttributeMultiprocessorCount, dev);
        hipFuncSetAttribute((const void*)mega, hipFuncAttributeMaxDynamicSharedMemorySize, LDS_BYTES);
        hipOccupancyMaxActiveBlocksPerMultiprocessor(&per_cu, (const void*)mega, 512, LDS_BYTES);
        (void)hipGetLastError();
        if (per_cu < 1) fprintf(stderr, "kernel_launch: occupancy query reports %d blocks per CU\n", per_cu);
        grid = cus > 0 ? cus : 256;
    }
    if (grid < 0) return;
    if (hipMemsetAsync((char*)d_ws + OFF_BAR, 0, 16384, stream) != hipSuccess) { fprintf(stderr, "kernel_launch: memset failed\n"); return; }
    Params p{};
    for (int i = 0; i < 27; ++i) p.in[i] = (const float*)d_in[i];
    p.out = (float*)d_out; p.ws = (unsigned char*)d_ws; p.flags = 7 | PROBE_REP;
    void* args[] = {&p};
    hipError_t e = hipLaunchCooperativeKernel((const void*)mega, dim3(grid), dim3(512), args, LDS_BYTES, stream);
    if (e != hipSuccess) fprintf(stderr, "cooperative launch failed: %s (grid %d)\n", hipGetErrorString(e), grid);
}
```

```cpp
#include <hip/hip_runtime.h>
#include <hip/hip_cooperative_groups.h>
#include <cstdio>
namespace cg = cooperative_groups;

#define LAS __attribute__((address_space(3)))
typedef unsigned short bf16_t;
typedef short bf16x8 __attribute__((ext_vector_type(8)));
typedef short bf16x4 __attribute__((ext_vector_type(4)));
typedef float f32x4 __attribute__((ext_vector_type(4)));
typedef float f32x16 __attribute__((ext_vector_type(16)));
typedef unsigned u32x4 __attribute__((ext_vector_type(4)));
typedef unsigned u32x2 __attribute__((ext_vector_type(2)));

constexpr int R = 33280, RL = 32768, DM = 1024;
constexpr int LDPE = 1792, LDPO = 3328;
constexpr size_t MiB = (size_t)1 << 20;
constexpr size_t OFF_WIN = 0, OFF_WOUT = 8 * MiB, OFF_WUQ = 10 * MiB, OFF_WUKV = 11 * MiB, OFF_WCM = 12 * MiB, OFF_W1 = 13 * MiB, OFF_W2 = 21 * MiB;
constexpr size_t OFF_MOD = 30 * MiB, OFF_XC = 31 * MiB, OFF_RSQ = 33 * MiB, OFF_RSKV = 33 * MiB + 256 * 1024, OFF_GD = 36 * MiB + 640 * 1024;
constexpr size_t OFF_BAR = 33 * MiB + 768 * 1024;
constexpr size_t OFF_KMS = 33 * MiB + 800 * 1024;
constexpr size_t OFF_DECF = 34 * MiB, OFF_DECB = 35 * MiB + 512 * 1024;
constexpr size_t OFF_H = 37 * MiB, OFF_MIX = 102 * MiB, OFF_BIG = 167 * MiB, OFF_G = 427 * MiB;
constexpr size_t OFF_Q = OFF_BIG + 114 * MiB, OFF_KV = OFF_BIG + 163 * MiB, OFF_KR = OFF_BIG + 228 * MiB;
constexpr size_t OFF_QTF = OFF_H, OFF_KTF = OFF_H + 34078720, OFF_QTB = OFF_BIG + 212 * MiB, OFF_SLOC = OFF_G, OFF_KTB = OFF_G + 34 * MiB;
constexpr size_t OFF_PART = 494 * MiB;
constexpr size_t WS_NEED = 510 * MiB;
constexpr int LDS_BYTES = 144 * 1024;

struct Params {
    const float* in[27];
    float* out;
    unsigned char* ws;
    long long flags;
};

__device__ __forceinline__ float bf2f(bf16_t b) { return __uint_as_float(((unsigned)b) << 16); }
__device__ __forceinline__ float bflo(unsigned u) { return __uint_as_float(u << 16); }
__device__ __forceinline__ float bfhi(unsigned u) { return __uint_as_float(u & 0xffff0000u); }
__device__ __forceinline__ bf16_t f2bf(float f) { unsigned u = __float_as_uint(f); u += 0x7FFFu + ((u >> 16) & 1u); return (bf16_t)(u >> 16); }
typedef __bf16 hwbf2_t __attribute__((ext_vector_type(2)));
typedef float f32x2v_t __attribute__((ext_vector_type(2)));
__device__ __forceinline__ unsigned pk2(float lo, float hi) { const f32x2v_t v = {lo, hi}; const hwbf2_t b = __builtin_convertvector(v, hwbf2_t); return __builtin_bit_cast(unsigned, b); }
__device__ __forceinline__ bf16x8 pack8(float a0, float a1, float a2, float a3, float a4, float a5, float a6, float a7) {
    u32x4 u = {pk2(a0, a1), pk2(a2, a3), pk2(a4, a5), pk2(a6, a7)};
    return __builtin_bit_cast(bf16x8, u);
}
__device__ __forceinline__ float wsum(float v) {
#pragma unroll
    for (int o = 32; o >= 1; o >>= 1) v += __shfl_xor(v, o);
    return v;
}
__device__ __forceinline__ float gelu_t(float x) { const float u = 0.7978845608f * (x + 0.044715f * x * x * x); return x / (1.f + __expf(-2.f * u)); }
__device__ __forceinline__ float silu_f(float x) { return x / (1.f + __expf(-x)); }
__device__ __forceinline__ void sincos_red(float ang, float& s, float& c) {
    const float k = rintf(ang * 0.15915494309f);
    float r = fmaf(-k, 6.2831854820251465f, ang);
    r = fmaf(-k, -1.7484555e-7f, r);
    s = __sinf(r); c = __cosf(r);
}
__device__ __forceinline__ float rope_inv(int jj) { return exp2f(-(float)jj * 1.6609640474f); }

__device__ __forceinline__ bf16x4 tr16(LAS unsigned char* a) { return __builtin_amdgcn_ds_read_tr16_b64_v4i16((LAS bf16x4*)a); }
__device__ __forceinline__ bf16x8 tr_nat(LAS unsigned char* base, int stride, int k0, int n0, int lane) {
    const int i = lane & 15, q = i >> 2, pq = i & 3, hh = lane >> 5, g1 = (lane >> 4) & 1;
    LAS unsigned char* a0 = base + (k0 + 8 * hh + q) * stride + (n0 + 16 * g1 + 4 * pq) * 2;
    const bf16x4 x = tr16(a0), y = tr16(a0 + 4 * stride);
    return __builtin_shufflevector(x, y, 0, 1, 2, 3, 4, 5, 6, 7);
}
__device__ __forceinline__ bf16x8 tr_perm(LAS unsigned char* base, int stride, int k0, int n0, int lane) {
    const int i = lane & 15, q = i >> 2, pq = i & 3, hh = lane >> 5, g1 = (lane >> 4) & 1;
    LAS unsigned char* a0 = base + (k0 + 4 * hh + q) * stride + (n0 + 16 * g1 + 4 * pq) * 2;
    const bf16x4 x = tr16(a0), y = tr16(a0 + 8 * stride);
    return __builtin_shufflevector(x, y, 0, 1, 2, 3, 4, 5, 6, 7);
}
__device__ __forceinline__ int ltid() { int t = threadIdx.x; asm volatile("" : "+v"(t)); return t; }
#define MFMA32(a, b, c) __builtin_amdgcn_mfma_f32_32x32x16_bf16((a), (b), (c), 0, 0, 0)

namespace pg8 {
constexpr int BM = 256, BK = 64, HALF = 128, HTB = HALF * BK * 2, STAGE_BYTES = 8 * HTB, NXCD = 8, WGM = 8;
__device__ __forceinline__ int lds_byte(int r, int c) { const int st = (r >> 4) * 2 + (c >> 5), rr = r & 15, cc = c & 31, ob = rr * 64 + cc * 2; return st * 1024 + (ob ^ (((ob >> 9) & 1) << 5)); }
__device__ __forceinline__ void stage_rc(int b, int& Rr, int& C) { const int st = b / 1024, sb = b % 1024, swz = sb ^ (((sb >> 9) & 1) << 5); Rr = (st >> 1) * 16 + swz / 64; C = (st & 1) * 32 + (swz % 64) / 2; }
__device__ __forceinline__ int perm32(int rho) { const int n = rho >> 4, i = rho & 15; return 8 * (i >> 2) + 4 * n + (i & 3); }
struct Unit { int pm, pn, ko; };
struct Gemm { const bf16_t* A; const bf16_t* Bt; int lda, ldb, M, N, K; };
struct StaticOrder {
    int nM, nN, nwg, G, c;
    __device__ void init(int M, int N, int G_, int c_) { nM = M / BM; nN = N / BM; nwg = nM * nN; G = G_; c = c_; }
    __device__ bool next(int i, Unit& u) const {
        const long L = (long)i * G + c; if (L >= nwg) return false;
        int wgid = (int)L; { const int q = nwg / NXCD, r = nwg % NXCD, xcd = wgid % NXCD, off = wgid / NXCD; wgid = (xcd < r ? xcd * (q + 1) : r * (q + 1) + (xcd - r) * q) + off; }
        const int nig = WGM * nN, gid = wgid / nig, fm = gid * WGM, gsz = (nM - fm) < WGM ? (nM - fm) : WGM;
        u.pm = fm + ((wgid % nig) % gsz); u.pn = (wgid % nig) / gsz; u.ko = 0; return true;
    }
};
struct PieceOrder {
    int nP, Kp, G, c;
    __device__ bool next(int i, Unit& u) const {
        const long L = (long)i * G + c; if (L >= 8 * nP) return false;
        const int kp = (int)L >> 3, r = (int)L & 7; u.pm = r >> 2; u.pn = r & 3; u.ko = kp * Kp; return true;
    }
};

template <class Epi, class Sched>
__device__ __forceinline__ void gemm_phase(LAS unsigned char* lds, const Gemm g, const Sched& S, const Epi& E) {
    const int tid = ltid(), wid = __builtin_amdgcn_readfirstlane(tid >> 6), lane = tid & 63, wr = wid >> 2, wc = wid & 3, fr = lane & 15, fq = lane >> 4;
    const int K = g.K, nt = K / BK;
    unsigned voffA[2], voffB[2];
#pragma unroll
    for (int i = 0; i < 2; ++i) { int Rr, C; stage_rc(tid * 16 + i * 8192, Rr, C); const int Rb = Epi::PERM ? ((Rr & ~31) + perm32(Rr & 31)) : Rr;
        voffA[i] = (unsigned)(Rr * g.lda + C) * 2u; voffB[i] = (unsigned)(Rb * g.ldb + C) * 2u; }
    const size_t kstep = (size_t)(BK * 2);
    const size_t hA = (size_t)HALF * g.lda * 2, hB = (size_t)HALF * g.ldb * 2;
    const size_t tA = 2 * hA, tB = 2 * hB;
    const unsigned ldsw = (unsigned)wid * 1024u;
    const int aoff = lds_byte(wr * 64 + fr, fq * 8), boff = lds_byte(wc * 32 + fr, fq * 8);
#define PG8_SA(b, h) (((b) * 2 + (h)) * HTB)
#define PG8_SB(b, h) ((4 + (b) * 2 + (h)) * HTB)
#define PG8_STAGE(bufoff, gbase, voff) do { _Pragma("unroll") for (int _i = 0; _i < 2; ++_i) \
        __builtin_amdgcn_global_load_lds((const unsigned*)((const char*)(gbase) + (voff)[_i]), (LAS unsigned*)(lds + (bufoff) + ldsw + _i * 8192), 16, 0, 0); } while (0)
#define PG8_LDA(dst, b, h) do { _Pragma("unroll") for (int m = 0; m < 4; ++m) _Pragma("unroll") for (int k = 0; k < 2; ++k) dst[m][k] = *(const LAS bf16x8*)(lds + PG8_SA(b, h) + aoff + m * 2048 + k * 1024); } while (0)
#define PG8_LDB(dst, b, h) do { _Pragma("unroll") for (int n = 0; n < 2; ++n) _Pragma("unroll") for (int k = 0; k < 2; ++k) dst[n][k] = *(const LAS bf16x8*)(lds + PG8_SB(b, h) + boff + n * 2048 + k * 1024); } while (0)
#define PG8_MMA(ai, bj, At, Bt) do { __builtin_amdgcn_s_setprio(1); _Pragma("unroll") for (int m = 0; m < 4; ++m) _Pragma("unroll") for (int n = 0; n < 2; ++n) _Pragma("unroll") for (int k = 0; k < 2; ++k) \
        acc[ai][bj][m][n] = __builtin_amdgcn_mfma_f32_16x16x32_bf16(Bt[n][k], At[m][k], acc[ai][bj][m][n], 0, 0, 0); __builtin_amdgcn_s_setprio(0); } while (0)
#define PG8_WAIT_V(n) asm volatile("s_waitcnt vmcnt(" #n ")" ::: "memory")
#define PG8_WAIT_L(n) asm volatile("s_waitcnt lgkmcnt(" #n ")" ::: "memory")
#define PG8_BAR __builtin_amdgcn_s_barrier()
#define PG8_SCHED __builtin_amdgcn_sched_barrier(0)
    Unit cur, nxt; int ui = 0;
    if (!S.next(0, cur)) return;
    f32x4 acc[2][2][4][2];
#pragma unroll
    for (int a = 0; a < 2; ++a)
#pragma unroll
        for (int b = 0; b < 2; ++b)
#pragma unroll
            for (int m = 0; m < 4; ++m)
#pragma unroll
                for (int n = 0; n < 2; ++n) acc[a][b][m][n] = (f32x4){0.f, 0.f, 0.f, 0.f};
    bf16x8 At[4][2], B0[2][2], B1[2][2];
    const char* cA = (const char*)g.A + (size_t)cur.pm * tA + (size_t)cur.ko * 2; const char* cB = (const char*)g.Bt + (size_t)cur.pn * tB + (size_t)cur.ko * 2;
    PG8_STAGE(PG8_SB(0, 0), cB, voffB); PG8_STAGE(PG8_SA(0, 0), cA, voffA); PG8_STAGE(PG8_SB(0, 1), cB + hB, voffB); PG8_STAGE(PG8_SA(0, 1), cA + hA, voffA);
    if (wr == 1) PG8_BAR;
    PG8_WAIT_V(4); PG8_BAR;
    PG8_STAGE(PG8_SB(1, 0), cB + kstep, voffB); PG8_STAGE(PG8_SA(1, 0), cA + kstep, voffA); PG8_STAGE(PG8_SB(1, 1), cB + hB + kstep, voffB);
    PG8_WAIT_V(6); PG8_BAR;
    for (;;) {
        const bool has_next = S.next(ui + 1, nxt);
        const char* nA = has_next ? (const char*)g.A + (size_t)nxt.pm * tA + (size_t)nxt.ko * 2 : cA; const char* nB = has_next ? (const char*)g.Bt + (size_t)nxt.pn * tB + (size_t)nxt.ko * 2 : cB;
        for (int t = 0; t < nt; t += 2) {
            const bool last = (t == nt - 2);
            const char* a1 = cA + (size_t)(t + 1) * kstep;
            const char* a2 = last ? nA : cA + (size_t)(t + 2) * kstep; const char* b2 = last ? nB : cB + (size_t)(t + 2) * kstep;
            const char* a3 = a2 + kstep; const char* b3 = b2 + kstep;
            PG8_LDB(B0, 0, 0); PG8_SCHED; PG8_LDA(At, 0, 0); PG8_STAGE(PG8_SA(1, 1), a1 + hA, voffA);
            PG8_WAIT_L(8); PG8_BAR; PG8_WAIT_L(0); PG8_MMA(0, 0, At, B0); PG8_BAR; PG8_SCHED;
            PG8_LDB(B1, 0, 1); PG8_STAGE(PG8_SB(0, 0), b2, voffB);
            PG8_BAR; PG8_WAIT_L(0); PG8_MMA(0, 1, At, B1); PG8_BAR;
            PG8_LDA(At, 0, 1); PG8_STAGE(PG8_SA(0, 0), a2, voffA);
            PG8_BAR; PG8_WAIT_L(0); PG8_MMA(1, 0, At, B0); PG8_BAR; PG8_SCHED;
            PG8_STAGE(PG8_SB(0, 1), b2 + hB, voffB);
            PG8_WAIT_V(6); PG8_BAR; PG8_MMA(1, 1, At, B1); PG8_BAR;
            PG8_LDB(B0, 1, 0); PG8_SCHED; PG8_LDA(At, 1, 0); PG8_STAGE(PG8_SA(0, 1), a2 + hA, voffA);
            PG8_WAIT_L(8); PG8_BAR; PG8_WAIT_L(0); PG8_MMA(0, 0, At, B0); PG8_BAR; PG8_SCHED;
            PG8_LDB(B1, 1, 1); PG8_STAGE(PG8_SB(1, 0), b3, voffB);
            PG8_BAR; PG8_WAIT_L(0); PG8_MMA(0, 1, At, B1); PG8_BAR;
            PG8_LDA(At, 1, 1); PG8_STAGE(PG8_SA(1, 0), a3, voffA);
            PG8_BAR; PG8_WAIT_L(0); PG8_MMA(1, 0, At, B0); PG8_BAR; PG8_SCHED;
            PG8_STAGE(PG8_SB(1, 1), b3 + hB, voffB);
            PG8_WAIT_V(6); PG8_BAR; PG8_MMA(1, 1, At, B1); PG8_BAR;
        }
        E(acc, cur, wr, wc, fr, fq);
        if (!has_next) break;
#pragma unroll
        for (int a = 0; a < 2; ++a)
#pragma unroll
            for (int b = 0; b < 2; ++b)
#pragma unroll
                for (int m = 0; m < 4; ++m)
#pragma unroll
                    for (int n = 0; n < 2; ++n) acc[a][b][m][n] = (f32x4){0.f, 0.f, 0.f, 0.f};
        cur = nxt; cA = nA; cB = nB; ++ui;
    }
    PG8_WAIT_V(0);
    if (wr == 0) PG8_BAR;
    PG8_BAR;
#undef PG8_SA
#undef PG8_SB
#undef PG8_STAGE
#undef PG8_LDA
#undef PG8_LDB
#undef PG8_MMA
#undef PG8_WAIT_V
#undef PG8_WAIT_L
#undef PG8_BAR
#undef PG8_SCHED
}

struct EpiB {
    static constexpr bool PERM = true;
    bf16_t* O; int ldo; const float* rs; int mode;
    __device__ __forceinline__ void operator()(const f32x4 (&acc)[2][2][4][2], const Unit& u, int wr, int wc, int fr, int fq) const {
        const int row0 = u.pm * BM + wr * 64 + fr, col0 = u.pn * BM + wc * 32 + 8 * fq;
#pragma unroll
        for (int ai = 0; ai < 2; ++ai)
#pragma unroll
            for (int m = 0; m < 4; ++m) {
                const int row = row0 + ai * HALF + m * 16;
                const float s = rs ? rs[row] : 1.f;
                bf16_t* rowp = O + (size_t)row * ldo + col0;
#pragma unroll
                for (int bj = 0; bj < 2; ++bj) {
                    f32x4 v0 = acc[ai][bj][m][0] * s, v1 = acc[ai][bj][m][1] * s;
                    if (mode == 1) {
#pragma unroll
                        for (int e = 0; e < 4; ++e) { const float a = fmaxf(v0[e], 0.f), b = fmaxf(v1[e], 0.f); v0[e] = a * a; v1[e] = b * b; }
                    }
                    const u32x4 o = {pk2(v0[0], v0[1]), pk2(v0[2], v0[3]), pk2(v1[0], v1[1]), pk2(v1[2], v1[3])};
                    *(u32x4*)(rowp + bj * HALF) = o;
                }
            }
    }
};
struct EpiR {
    static constexpr bool PERM = false;
    const float* xin_l; const float* xin_c; float* xout_l; float* xout_c; const float* gate;
    __device__ __forceinline__ void operator()(const f32x4 (&acc)[2][2][4][2], const Unit& u, int wr, int wc, int fr, int fq) const {
        const int var = u.pm < 64 ? 0 : (u.pm < 128 ? 1 : 2);
        const float* gp = gate + var * 6144;
        const int rowt = (u.pm < 128 ? u.pm : u.pm - 128) * BM + wr * 64 + fr;
        const float* xi = u.pm < 128 ? xin_l : xin_c; float* xo = u.pm < 128 ? xout_l : xout_c;
        const int col0 = u.pn * BM + wc * 32 + 4 * fq;
        f32x4 gv[2][2];
#pragma unroll
        for (int bj = 0; bj < 2; ++bj)
#pragma unroll
            for (int n = 0; n < 2; ++n) gv[bj][n] = *(const f32x4*)(gp + col0 + bj * HALF + n * 16);
#pragma unroll
        for (int ai = 0; ai < 2; ++ai)
#pragma unroll
            for (int m = 0; m < 4; ++m) {
                const size_t ro = (size_t)(rowt + ai * HALF + m * 16) * DM + col0;
#pragma unroll
                for (int bj = 0; bj < 2; ++bj)
#pragma unroll
                    for (int n = 0; n < 2; ++n) {
                        const f32x4 x = *(const f32x4*)(xi + ro + bj * HALF + n * 16);
                        *(f32x4*)(xo + ro + bj * HALF + n * 16) = x + gv[bj][n] * acc[ai][bj][m][n];
                    }
            }
    }
};
struct EpiP {
    static constexpr bool PERM = false;
    float* part; int kpiece;
    __device__ __forceinline__ void operator()(const f32x4 (&acc)[2][2][4][2], const Unit& u, int wr, int wc, int fr, int fq) const {
        const int kp = u.ko / kpiece;
        const int rowt = u.pm * BM + wr * 64 + fr, col0 = u.pn * BM + wc * 32 + 4 * fq;
        float* base = part + (size_t)kp * 512 * DM;
#pragma unroll
        for (int ai = 0; ai < 2; ++ai)
#pragma unroll
            for (int m = 0; m < 4; ++m) {
                const size_t ro = (size_t)(rowt + ai * HALF + m * 16) * DM + col0;
#pragma unroll
                for (int bj = 0; bj < 2; ++bj)
#pragma unroll
                    for (int n = 0; n < 2; ++n) *(f32x4*)(base + ro + bj * HALF + n * 16) = acc[ai][bj][m][n];
            }
    }
};
}

template <class Epi>
__device__ __forceinline__ void run_gemm(LAS unsigned char* lds, const bf16_t* A, int lda, const bf16_t* Bt, int ldb, int M, int N, int K, const Epi& E, bool rev = false) {
    pg8::Gemm g; g.A = A; g.Bt = Bt; g.lda = lda; g.ldb = ldb; g.M = M; g.N = N; g.K = K;
    pg8::StaticOrder S; S.init(M, N, (int)gridDim.x, rev ? (int)(gridDim.x - 1 - blockIdx.x) : (int)blockIdx.x);
    pg8::gemm_phase<Epi, pg8::StaticOrder>(lds, g, S, E);
}
__device__ __forceinline__ void run_pieces(LAS unsigned char* lds, const bf16_t* A, int lda, const bf16_t* Bt, int ldb, int nP, int Kp, float* part) {
    pg8::Gemm g; g.A = A; g.Bt = Bt; g.lda = lda; g.ldb = ldb; g.M = 512; g.N = 1024; g.K = Kp;
    pg8::PieceOrder S; S.nP = nP; S.Kp = Kp; S.G = (int)gridDim.x; S.c = (int)blockIdx.x;
    pg8::EpiP E; E.part = part; E.kpiece = Kp;
    pg8::gemm_phase<pg8::EpiP, pg8::PieceOrder>(lds, g, S, E);
}

__device__ void phase_ada(const Params& p, unsigned char* ldsg) {
    float* sl = (float*)ldsg;
    float* red = sl + 3072;
    const int tid = ltid();
    float* MOD = (float*)(p.ws + OFF_MOD);
    for (int idx = tid; idx < 3072; idx += 512) { const int var = idx >> 10, k = idx & 1023; const float v = var < 2 ? p.in[1][var * 1024 + k] : p.in[3][k]; sl[idx] = silu_f(v); }
    __syncthreads();
    for (int item = blockIdx.x; item < 192; item += gridDim.x) {
        const int i = item / 48, cb = item % 48, cc = tid & 127, kq = tid >> 7, col = cb * 128 + cc;
        const float* w = p.in[4] + ((size_t)i * 1024 + kq * 256) * 6144 + col;
        const float* s0 = sl + kq * 256;
        float a0 = 0.f, a1 = 0.f, a2 = 0.f;
#pragma unroll 8
        for (int k = 0; k < 256; ++k) { const float wv = w[(size_t)k * 6144]; a0 = fmaf(s0[k], wv, a0); a1 = fmaf(s0[1024 + k], wv, a1); a2 = fmaf(s0[2048 + k], wv, a2); }
        red[(kq * 3 + 0) * 128 + cc] = a0; red[(kq * 3 + 1) * 128 + cc] = a1; red[(kq * 3 + 2) * 128 + cc] = a2;
        __syncthreads();
        if (tid < 384) { const int var = tid >> 7, c2 = tid & 127; float s = p.in[5][i * 6144 + cb * 128 + c2];
#pragma unroll
            for (int q = 0; q < 4; ++q) s += red[(q * 3 + var) * 128 + c2];
            MOD[(size_t)(i * 3 + var) * 6144 + cb * 128 + c2] = s; }
        __syncthreads();
    }
}

__device__ void tjob(const float* src, int K, int N, int Npad, bf16_t* dst, const float* rs, float mult, unsigned char* ldsg) {
    float* tile = (float*)ldsg;
    const int tid = ltid(), ntk = K / 64, ntn = Npad / 64;
    for (int t = blockIdx.x; t < ntk * ntn; t += gridDim.x) {
        const int tk = t % ntk, tn = t / ntk;
        const int nl = tid & 63, kl0 = tid >> 6;
#pragma unroll
        for (int j = 0; j < 8; ++j) { const int kl = kl0 + 8 * j, k = tk * 64 + kl, n = tn * 64 + nl;
            float v = n < N ? src[(size_t)k * N + n] : 0.f; if (rs) v *= rs[k]; tile[kl * 65 + nl] = v * mult; }
        __syncthreads();
        const int nl2 = tid >> 3, kc = tid & 7;
        u32x4 o;
#pragma unroll
        for (int e = 0; e < 4; ++e) o[e] = pk2(tile[(kc * 8 + 2 * e) * 65 + nl2], tile[(kc * 8 + 2 * e + 1) * 65 + nl2]);
        *(u32x4*)(dst + (size_t)(tn * 64 + nl2) * K + tk * 64 + kc * 8) = o;
        __syncthreads();
    }
}
__device__ void phase_weights(const Params& p, int i, unsigned char* ldsg) {
    unsigned char* ws = p.ws; const int j = i >> 1;
    if (!(i & 1)) {
        tjob(p.in[10] + (size_t)j * 1024 * 1696, 1024, 1696, 1792, (bf16_t*)(ws + OFF_WIN), nullptr, 1.f, ldsg);
        tjob(p.in[12] + (size_t)j * 384 * 768, 384, 768, 768, (bf16_t*)(ws + OFF_WUQ), p.in[11] + j * 384, 0.10206207262f * 1.44269504089f, ldsg);
        tjob(p.in[14] + (size_t)j * 256 * 1024, 256, 1024, 1024, (bf16_t*)(ws + OFF_WUKV), p.in[13] + j * 256, 1.f, ldsg);
        tjob(p.in[18] + (size_t)j * 1024 * 1024, 1024, 1024, 1024, (bf16_t*)(ws + OFF_WOUT), nullptr, 1.f, ldsg);
        bf16_t* wcm = (bf16_t*)(ws + OFF_WCM); const float* src = p.in[16] + (size_t)j * 65536;
        for (int e = blockIdx.x * 512 + ltid(); e < 65536; e += gridDim.x * 512) wcm[e] = f2bf(src[e]);
    } else {
        tjob(p.in[19] + (size_t)j * 1024 * 3104, 1024, 3104, 3328, (bf16_t*)(ws + OFF_WIN), nullptr, 1.f, ldsg);
        tjob(p.in[25] + (size_t)j * 1024 * 1024, 1024, 1024, 1024, (bf16_t*)(ws + OFF_WOUT), nullptr, 1.f, ldsg);
    }
    tjob(p.in[8] + (size_t)i * 1024 * 4096, 1024, 4096, 4096, (bf16_t*)(ws + OFF_W1), nullptr, 1.f, ldsg);
    tjob(p.in[9] + (size_t)i * 4096 * 1024, 4096, 1024, 1024, (bf16_t*)(ws + OFF_W2), nullptr, 1.f, ldsg);
}

__device__ void phase_norm(const float* xl, const float* xc, const float* g, const float* mod  , int shift_i, int scale_i, bf16_t* H,
                           int nrows, const float* part, int npart, const float* pgate, float* xc_out) {
    const int lane = ltid() & 63, gw = blockIdx.x * 8 + (ltid() >> 6), nw = gridDim.x * 8;
    for (int row = gw; row < nrows; row += nw) {
        const float* src = row < RL ? xl + (size_t)row * DM : xc + (size_t)(row - RL) * DM;
        const int var = row < 16384 ? 0 : (row < RL ? 1 : 2);
        const float* sh = mod + var * 6144 + shift_i * 1024; const float* sc = mod + var * 6144 + scale_i * 1024;
        f32x4 x[4]; float ss = 0.f;
#pragma unroll
        for (int q = 0; q < 4; ++q) x[q] = *(const f32x4*)(src + q * 256 + lane * 4);
        if (row >= RL && part) {
#pragma unroll
            for (int q = 0; q < 4; ++q) { const int c = q * 256 + lane * 4;
                f32x4 acc = {0.f, 0.f, 0.f, 0.f};
                for (int kp = 0; kp < npart; ++kp) acc += *(const f32x4*)(part + ((size_t)kp * 512 + (row - RL)) * DM + c);
                x[q] += *(const f32x4*)(pgate + c) * acc;
                *(f32x4*)(xc_out + (size_t)(row - RL) * DM + c) = x[q]; }
        }
#pragma unroll
        for (int q = 0; q < 4; ++q) ss += x[q][0] * x[q][0] + x[q][1] * x[q][1] + x[q][2] * x[q][2] + x[q][3] * x[q][3];
        ss = wsum(ss);
        const float rstd = rsqrtf(ss * (1.f / 1024.f) + 1e-6f);
#pragma unroll
        for (int q = 0; q < 4; ++q) { const int c = q * 256 + lane * 4;
            const f32x4 gg = *(const f32x4*)(g + c), s1 = *(const f32x4*)(sc + c), s0 = *(const f32x4*)(sh + c);
            float o[4];
#pragma unroll
            for (int e = 0; e < 4; ++e) o[e] = x[q][e] * rstd * gg[e] * (1.f + s1[e]) + s0[e];
            const u32x2 pk = {pk2(o[0], o[1]), pk2(o[2], o[3])};
            *(u32x2*)(H + (size_t)row * DM + c) = pk; }
    }
}
__device__ void phase_final(const float* g, float* X) {
    const int lane = ltid() & 63, gw = blockIdx.x * 8 + (ltid() >> 6), nw = gridDim.x * 8;
    for (int row = gw; row < RL; row += nw) {
        float* src = X + (size_t)row * DM;
        f32x4 x[4]; float ss = 0.f;
#pragma unroll
        for (int q = 0; q < 4; ++q) { x[q] = *(const f32x4*)(src + q * 256 + lane * 4); ss += x[q][0] * x[q][0] + x[q][1] * x[q][1] + x[q][2] * x[q][2] + x[q][3] * x[q][3]; }
        ss = wsum(ss);
        const float rstd = rsqrtf(ss * (1.f / 1024.f) + 1e-6f);
#pragma unroll
        for (int q = 0; q < 4; ++q) { const int c = q * 256 + lane * 4; const f32x4 gg = *(const f32x4*)(g + c); *(f32x4*)(src + c) = x[q] * rstd * gg; }
    }
}

__device__ void phase_even_prep(const Params& p, int j, unsigned char* ldsg) {
    unsigned char* ws = p.ws;
    const bf16_t* P = (const bf16_t*)(ws + OFF_BIG);
    float* RSQ = (float*)(ws + OFF_RSQ); float* RSKV = (float*)(ws + OFF_RSKV);
    bf16_t* KR = (bf16_t*)(ws + OFF_KR); bf16_t* MIX = (bf16_t*)(ws + OFF_MIX);
    const int tid = ltid(), lane = tid & 63, w = tid >> 6, l32 = lane & 31, hh = lane >> 5;
    {
        const int gw = blockIdx.x * 8 + w, nw = gridDim.x * 8;
        for (int row = gw; row < R; row += nw) {
            const bf16_t* pr = P + (size_t)row * LDPE;
            float ss = 0.f;
#pragma unroll
            for (int q = 0; q < 3; ++q) { const unsigned u = *(const unsigned*)(pr + 2 * lane + 128 * q); const float a = bflo(u), b = bfhi(u); ss += a * a + b * b; }
            ss = wsum(ss);
            const u32x2 u2 = *(const u32x2*)(pr + 384 + 4 * lane);
            float s2 = bflo(u2[0]) * bflo(u2[0]) + bfhi(u2[0]) * bfhi(u2[0]) + bflo(u2[1]) * bflo(u2[1]) + bfhi(u2[1]) * bfhi(u2[1]);
            s2 = wsum(s2);
            if (lane == 0) { RSQ[row] = rsqrtf(ss * (1.f / 384.f) + 1e-6f); RSKV[row] = rsqrtf(s2 * (1.f / 256.f) + 1e-6f); }
            const float x = bf2f(pr[640 + l32]); const float y = __shfl_xor(x, 8);
            float o = x;
            if (row < RL) { const int l = row & 16383; const float pos = (float)(l32 < 16 ? (l >> 6) : (l & 63));
                float s, c; sincos_red(pos * rope_inv(l32 & 7), s, c);
                o = (l32 & 8) ? x * c + y * s : x * c - y * s; }
            if (lane < 32) KR[(size_t)row * 32 + lane] = f2bf(o);
        }
    }
    LAS unsigned char* lds = (LAS unsigned char*)ldsg;
    const bf16_t* WCM = (const bf16_t*)(ws + OFF_WCM);
    const float* cmn = p.in[15] + j * 128; const float* bs = p.in[17] + j * 512;
    for (int item = blockIdx.x; item < 1040; item += gridDim.x) {
        const int n = item >> 2, g = item & 3, r0 = n * 128;
        {
            const int s = tid >> 2, cq = tid & 3;
            const bf16_t* src = P + (size_t)(r0 + s) * LDPE + 1184 + g * 128 + cq * 32;
            float v[32]; float ss = 0.f;
#pragma unroll
            for (int q = 0; q < 4; ++q) { const u32x4 u = *(const u32x4*)(src + q * 8);
#pragma unroll
                for (int e = 0; e < 4; ++e) { const float a = gelu_t(bflo(u[e])), b = gelu_t(bfhi(u[e])); v[q * 8 + 2 * e] = a; v[q * 8 + 2 * e + 1] = b; ss += a * a + b * b; } }
            ss += __shfl_xor(ss, 1); ss += __shfl_xor(ss, 2);
            const float rstd = rsqrtf(ss * (1.f / 128.f) + 1e-6f);
#pragma unroll
            for (int q = 0; q < 4; ++q) { u32x4 o;
#pragma unroll
                for (int e = 0; e < 4; ++e) { const int c = cq * 32 + q * 8 + 2 * e; o[e] = pk2(v[q * 8 + 2 * e] * rstd * cmn[c], v[q * 8 + 2 * e + 1] * rstd * cmn[c + 1]); }
                *(LAS u32x4*)(lds + s * 272 + (cq * 32 + q * 8) * 2) = o; }
        }
        __syncthreads();
        const int tt = w >> 1, cp = (w & 1) * 2;
        f32x16 acc[2];
#pragma unroll
        for (int e = 0; e < 16; ++e) { acc[0][e] = 0.f; acc[1][e] = 0.f; }
#pragma unroll
        for (int ks = 0; ks < 8; ++ks) {
            const bf16x8 a = *(const bf16x8*)(WCM + g * 16384 + (32 * tt + l32) * 128 + 16 * ks + 8 * hh);
#pragma unroll
            for (int ct = 0; ct < 2; ++ct) { const bf16x8 b = tr_nat(lds, 272, 16 * ks, 32 * (cp + ct), lane); acc[ct] = MFMA32(a, b, acc[ct]); }
        }
#pragma unroll
        for (int ct = 0; ct < 2; ++ct)
#pragma unroll
            for (int i = 0; i < 16; ++i) {
                const int t = 32 * tt + (i >> 2) * 8 + 4 * hh + (i & 3), c = 32 * (cp + ct) + l32;
                const float val = acc[ct][i] + bs[g * 128 + t];
                const float u = gelu_t(bf2f(P[(size_t)(r0 + t) * LDPE + 672 + g * 128 + c]));
                MIX[(size_t)(r0 + t) * DM + 512 + g * 128 + c] = f2bf(u * val);
            }
        __syncthreads();
    }
}

__device__ void phase_kmax(const Params& p, unsigned char* ldsg) {
    unsigned char* ws = p.ws;
    const bf16_t* KV = (const bf16_t*)(ws + OFF_KV); const bf16_t* KR = (const bf16_t*)(ws + OFF_KR);
    float* KMS = (float*)(ws + OFF_KMS);
    float* red = (float*)ldsg;
    const int tid = ltid(), lane = tid & 63, w = tid >> 6, h = lane >> 3, jj = lane & 7;
    float mx0 = 0.f, mx1 = 0.f;
    for (int row = blockIdx.x * 8 + w; row < R; row += gridDim.x * 8) {
        const u32x4 a = *(const u32x4*)(KV + (size_t)row * 1024 + h * 128 + jj * 8);
        const u32x4 r = *(const u32x4*)(KR + (size_t)row * 32 + (jj & 3) * 8);
        float ss = 0.f, sr = 0.f;
#pragma unroll
        for (int e = 0; e < 4; ++e) { ss += bflo(a[e]) * bflo(a[e]) + bfhi(a[e]) * bfhi(a[e]); sr += bflo(r[e]) * bflo(r[e]) + bfhi(r[e]) * bfhi(r[e]); }
        ss += 0.5f * sr;
        ss += __shfl_xor(ss, 1); ss += __shfl_xor(ss, 2); ss += __shfl_xor(ss, 4);
        const int b = row < 16384 ? 0 : (row < RL ? 1 : ((row - RL) >> 8));
        if (b == 0) mx0 = fmaxf(mx0, ss); else mx1 = fmaxf(mx1, ss);
    }
    if (jj == 0) { red[w * 16 + h] = mx0; red[w * 16 + 8 + h] = mx1; }
    __syncthreads();
    if (tid < 16) { float m = red[tid];
#pragma unroll
        for (int q = 1; q < 8; ++q) m = fmaxf(m, red[q * 16 + tid]);
        KMS[blockIdx.x * 16 + tid] = m; }
    __syncthreads();
}

__device__ void phase_attn(const Params& p, unsigned char* ldsg) {
    unsigned char* ws = p.ws;
    const bf16_t* Q = (const bf16_t*)(ws + OFF_Q); const bf16_t* KV = (const bf16_t*)(ws + OFF_KV); const bf16_t* KR = (const bf16_t*)(ws + OFF_KR);
    bf16_t* MIX = (bf16_t*)(ws + OFF_MIX);
    LAS unsigned char* lds = (LAS unsigned char*)ldsg;
    const int tid = ltid(), lane = tid & 63, w = tid >> 6, l32 = lane & 31, hh = lane >> 5;
    constexpr int KROW = 208, VROW = 192, KBUF = 64 * KROW, VBUF = 64 * VROW, VBASE = 2 * KBUF;
    for (int it = blockIdx.x; it < 1040; it += gridDim.x) {
        int b, h, q0row, nkt; bool isctx;
        if (it < 1024) { h = it & 7; const int rest = it >> 3; b = rest >> 6; q0row = b * 16384 + (rest & 63) * 256; nkt = 260; isctx = false; }
        else { const int e = it - 1024; b = e >> 3; h = e & 7; q0row = RL + b * 256; nkt = 4; isctx = true; }
        const int qrow = q0row + w * 32 + l32;
        const bf16_t* qp = Q + (size_t)qrow * 768 + h * 96;
        bf16x8 qf[6];
#pragma unroll
        for (int s = 0; s < 4; ++s) qf[s] = *(const bf16x8*)(qp + 16 * s + 8 * hh);
#pragma unroll
        for (int s = 4; s < 6; ++s) {
            const bf16x8 own = *(const bf16x8*)(qp + 16 * s + 8 * hh);
            const bf16x8 oth = *(const bf16x8*)(qp + 16 * s + 8 * (1 - hh));
            if (!isctx) {
                const int l = qrow & 16383; const float pos = (float)(s == 4 ? (l >> 6) : (l & 63));
                float r[8];
#pragma unroll
                for (int jj = 0; jj < 8; ++jj) { float sn, cs; sincos_red(pos * rope_inv(jj), sn, cs);
                    const float x = bf2f((bf16_t)own[jj]), y = bf2f((bf16_t)oth[jj]); r[jj] = hh ? x * cs + y * sn : x * cs - y * sn; }
                qf[s] = pack8(r[0], r[1], r[2], r[3], r[4], r[5], r[6], r[7]);
            } else qf[s] = own;
        }
        float negm;
        {
            float qs = 0.f;
#pragma unroll
            for (int s = 0; s < 6; ++s)
#pragma unroll
                for (int e = 0; e < 8; ++e) { const float x = bf2f((bf16_t)qf[s][e]); qs += x * x; }
            qs += __shfl_xor(qs, 32);
            const float* KMS = (const float*)(ws + OFF_KMS) + b * 8 + h;
            float km = 0.f;
            for (int q = lane; q < (int)gridDim.x; q += 64) km = fmaxf(km, KMS[q * 16]);
#pragma unroll
            for (int o2 = 32; o2 >= 1; o2 >>= 1) km = fmaxf(km, __shfl_xor(km, o2));
            negm = -sqrtf(qs * km) * 1.0001f - 1e-3f;
        }
        const bf16_t* kp[2]; int kst[2]; int kdo[2]; bool kv_[2];
#pragma unroll
        for (int pp = 0; pp < 2; ++pp) {
            int c = tid + 512 * pp; if (c >= 768) c -= 512; kv_[pp] = true; const int key = c / 12, part = c % 12;
            if (part < 8) { kp[pp] = KV + (size_t)key * 1024 + h * 128 + part * 8; kst[pp] = 1024; }
            else { kp[pp] = KR + (size_t)key * 32 + (part - 8) * 8; kst[pp] = 32; }
            kdo[pp] = key * KROW + part * 16;
        }
        const bf16_t* vp = KV + (size_t)(tid >> 3) * 1024 + h * 128 + 64 + (tid & 7) * 8; const int vdo = (tid >> 3) * VROW + (tid & 7) * 16;
        auto rowbase = [&](int kt) -> int { return isctx ? (RL + b * 256 + kt * 64) : (kt < 256 ? b * 16384 + kt * 64 : RL + b * 256 + (kt - 256) * 64); };
        u32x4 prk[2], prv;
        auto loadK = [&](int kt) { const int rb = rowbase(kt);
#pragma unroll
            for (int pp = 0; pp < 2; ++pp) prk[pp] = *(const u32x4*)(kp[pp] + (size_t)rb * kst[pp]); };
        auto storeK = [&](int buf) {
#pragma unroll
            for (int pp = 0; pp < 2; ++pp) *(LAS u32x4*)(lds + buf * KBUF + kdo[pp]) = prk[pp]; };
        auto loadV = [&](int kt) { prv = *(const u32x4*)(vp + (size_t)rowbase(kt) * 1024); };
        auto storeV = [&](int buf) { *(LAS u32x4*)(lds + VBASE + buf * VBUF + vdo) = prv; };
        f32x16 pA[2], pB[2];
        f32x16 o[2];
#pragma unroll
        for (int e = 0; e < 16; ++e) { o[0][e] = 0.f; o[1][e] = 0.f; }
        float lsum = 0.f;
        auto qk = [&](int buf, f32x16 (&st)[2]) {
            LAS unsigned char* kb = lds + buf * KBUF;
#pragma unroll
            for (int e = 0; e < 16; ++e) { st[0][e] = negm; st[1][e] = negm; }
#pragma unroll
            for (int half = 0; half < 2; ++half) {
                bf16x8 kf[6];
#pragma unroll
                for (int s = 0; s < 3; ++s) {
                    kf[2 * s] = *(const LAS bf16x8*)(kb + l32 * KROW + (16 * (3 * half + s) + 8 * hh) * 2);
                    kf[2 * s + 1] = *(const LAS bf16x8*)(kb + (32 + l32) * KROW + (16 * (3 * half + s) + 8 * hh) * 2);
                }
                __builtin_amdgcn_sched_barrier(0);
#pragma unroll
                for (int s = 0; s < 3; ++s) { st[0] = MFMA32(kf[2 * s], qf[3 * half + s], st[0]); st[1] = MFMA32(kf[2 * s + 1], qf[3 * half + s], st[1]); }
            }
        };
        auto partialSM = [&](f32x16 (&pp)[2]) {
#pragma unroll
            for (int e = 0; e < 16; ++e) pp[0][e] = __builtin_amdgcn_exp2f(pp[0][e]);
        };
        bf16x8 pa[4];
        auto finishSM = [&](f32x16 (&pp)[2]) {
#pragma unroll
            for (int e = 0; e < 16; ++e) pp[1][e] = __builtin_amdgcn_exp2f(pp[1][e]);
            float ps = 0.f;
#pragma unroll
            for (int e = 0; e < 16; ++e) ps += pp[0][e] + pp[1][e];
            lsum += ps;
            pa[0] = pack8(pp[0][0], pp[0][1], pp[0][2], pp[0][3], pp[0][4], pp[0][5], pp[0][6], pp[0][7]);
            pa[1] = pack8(pp[0][8], pp[0][9], pp[0][10], pp[0][11], pp[0][12], pp[0][13], pp[0][14], pp[0][15]);
            pa[2] = pack8(pp[1][0], pp[1][1], pp[1][2], pp[1][3], pp[1][4], pp[1][5], pp[1][6], pp[1][7]);
            pa[3] = pack8(pp[1][8], pp[1][9], pp[1][10], pp[1][11], pp[1][12], pp[1][13], pp[1][14], pp[1][15]);
        };
        auto pv = [&](int buf) {
            LAS unsigned char* vb = lds + VBASE + buf * VBUF;
            bf16x8 vf[8];
#pragma unroll
            for (int vt = 0; vt < 2; ++vt)
#pragma unroll
                for (int q = 0; q < 4; ++q) vf[vt * 4 + q] = tr_perm(vb, VROW, 16 * q, 32 * vt, lane);
            __builtin_amdgcn_sched_barrier(0);
#pragma unroll
            for (int vt = 0; vt < 2; ++vt)
#pragma unroll
                for (int q = 0; q < 4; ++q) o[vt] = MFMA32(vf[vt * 4 + q], pa[q], o[vt]);
        };
        auto step = [&](int j, f32x16 (&pc)[2], f32x16 (&pn)[2]) {
            const int j2 = j + 2 < nkt ? j + 2 : nkt - 1;
            __builtin_amdgcn_sched_barrier(0);
            qk((j + 1) & 1, pn);
            finishSM(pc);
            __builtin_amdgcn_sched_barrier(0);
            loadK(j2); loadV(j + 1);
            __builtin_amdgcn_sched_barrier(0);
            pv(j & 1);
            partialSM(pn);
            __builtin_amdgcn_sched_barrier(0);
            storeK(j & 1); storeV((j + 1) & 1);
            __syncthreads();
        };
        loadK(0); loadV(0); storeK(0); storeV(0);
        loadK(1); storeK(1);
        __syncthreads();
        qk(0, pA); partialSM(pA);
        __syncthreads();
        for (int kt = 0; kt + 2 < nkt; kt += 2) {
            step(kt, pA, pB);
            step(kt + 1, pB, pA);
        }
        step(nkt - 2, pA, pB);
        finishSM(pB);
        pv((nkt - 1) & 1);
        __syncthreads();
        lsum += __shfl_xor(lsum, 32);
        const float inv = 1.f / lsum;
        bf16_t* op = MIX + (size_t)qrow * DM + h * 64;
#pragma unroll
        for (int vt = 0; vt < 2; ++vt)
#pragma unroll
            for (int g4 = 0; g4 < 4; ++g4) {
                const u32x2 pk = {pk2(o[vt][4 * g4] * inv, o[vt][4 * g4 + 1] * inv), pk2(o[vt][4 * g4 + 2] * inv, o[vt][4 * g4 + 3] * inv)};
                *(u32x2*)(op + 32 * vt + 8 * g4 + 4 * hh) = pk;
            }
    }
}

__device__ void phase_gla_prep(const Params& p, int j, unsigned char* ldsg) {
    unsigned char* ws = p.ws;
    const bf16_t* P = (const bf16_t*)(ws + OFF_BIG);
    bf16_t* QTF = (bf16_t*)(ws + OFF_QTF); bf16_t* KTF = (bf16_t*)(ws + OFF_KTF); bf16_t* QTB = (bf16_t*)(ws + OFF_QTB); bf16_t* KTB = (bf16_t*)(ws + OFF_KTB);
    float* DECF = (float*)(ws + OFF_DECF); float* DECB = (float*)(ws + OFF_DECB);
    float* zl = (float*)ldsg;
    float* seg = zl + 2048;
    const int tid = ltid();
    const float* wgf = p.in[20] + (size_t)j * 16 * 512; const float* wgb = p.in[22] + (size_t)j * 16 * 512;
    const float* bgf = p.in[21] + j * 512; const float* bgb = p.in[23] + j * 512;
    for (int item = blockIdx.x; item < 2080; item += gridDim.x) {
        const int ck = item >> 2, h = item & 3, r0 = ck * 64;
        { const int t = tid >> 3, j0 = (tid & 7) * 4; const u32x2 u = *(const u32x2*)(P + (size_t)(r0 + t) * LDPO + 1536 + j0);
          zl[t * 32 + j0] = bflo(u[0]); zl[t * 32 + j0 + 1] = bfhi(u[0]); zl[t * 32 + j0 + 2] = bflo(u[1]); zl[t * 32 + j0 + 3] = bfhi(u[1]); }
        __syncthreads();
        const int d = tid & 127, tq = tid >> 7, hd = h * 128 + d;
        float wf[16], wb[16];
#pragma unroll
        for (int q = 0; q < 16; ++q) { wf[q] = wgf[q * 512 + hd]; wb[q] = wgb[q * 512 + hd]; }
        const float bf_ = bgf[hd], bb_ = bgb[hd];
        float lf[16], lb[16];
#pragma unroll
        for (int i = 0; i < 16; ++i) {
            const float* zr = zl + (tq * 16 + i) * 32;
            float gf = bf_, gb = bb_;
#pragma unroll
            for (int q = 0; q < 16; ++q) { gf = fmaf(zr[q], wf[q], gf); gb = fmaf(zr[16 + q], wb[q], gb); }
            lf[i] = (fminf(gf, 0.f) - __logf(1.f + __expf(-fabsf(gf)))) * 0.0625f;
            lb[i] = (fminf(gb, 0.f) - __logf(1.f + __expf(-fabsf(gb)))) * 0.0625f;
        }
        float run = 0.f;
#pragma unroll
        for (int i = 0; i < 16; ++i) { run += lf[i]; lf[i] = run; }
        const float segF = run; run = 0.f;
#pragma unroll
        for (int i = 15; i >= 0; --i) { run += lb[i]; lb[i] = run; }
        const float segB = run;
        seg[tq * 128 + d] = segF; seg[512 + tq * 128 + d] = segB;
        __syncthreads();
        float offF = 0.f, totF = 0.f, offB = 0.f, totB = 0.f;
#pragma unroll
        for (int q = 0; q < 4; ++q) { const float a = seg[q * 128 + d], b2 = seg[512 + q * 128 + d]; totF += a; totB += b2; if (q < tq) offF += a; if (q > tq) offB += b2; }
#pragma unroll
        for (int i = 0; i < 16; ++i) {
            const size_t row = (size_t)(r0 + tq * 16 + i);
            const float q = bf2f(P[row * LDPO + 1568 + hd]) * 0.08838834764f, k = bf2f(P[row * LDPO + hd]);
            const float cf = lf[i] + offF, cb = lb[i] + offB;
            QTF[row * 512 + hd] = f2bf(q * __expf(cf)); KTF[row * 512 + hd] = f2bf(k * __expf(-cf));
            QTB[row * 512 + hd] = f2bf(q * __expf(cb)); KTB[row * 512 + hd] = f2bf(k * __expf(-cb));
        }
        if (tq == 0) { DECF[(size_t)(ck * 4 + h) * 128 + d] = __expf(totF); DECB[(size_t)(ck * 4 + h) * 128 + d] = __expf(totB); }
        __syncthreads();
    }
}

constexpr int NGRP = 32, NSLOT = NGRP + 1;
__device__ __forceinline__ int gstart(int g) { return g < 27 ? 8 * g : (g < 31 ? 216 + 9 * (g - 27) : 252); }
__device__ __forceinline__ int gsize(int g) { return g < 27 ? 8 : (g < 31 ? 9 : 4); }
constexpr int G_QOFF = 0, G_KOFF = 17408, G_VOFF = 34816, G_DOFF = 68608, G_BUF = 69120, G_SSQ = 2 * G_BUF;
template <bool OUT>
__device__ __forceinline__ void gla_seq(const Params& p, int j, LAS unsigned char* lds, int b, int h, int dir, bool ctx, int g, f32x16 (&S)[4], float* gdout) {
    unsigned char* ws = p.ws;
    const bf16_t* P = (const bf16_t*)(ws + OFF_BIG);
    const bf16_t* QT = (const bf16_t*)(ws + (dir ? OFF_QTB : OFF_QTF)); const bf16_t* KT = (const bf16_t*)(ws + (dir ? OFF_KTB : OFF_KTF));
    const float* DEC = (const float*)(ws + (dir ? OFF_DECB : OFF_DECF));
    bf16_t* MIX = (bf16_t*)(ws + OFF_MIX);
    const float* onorm = p.in[24] + j * 256;
    const int tid = ltid(), lane = tid & 63, w = tid >> 6, l32 = lane & 31, hh = lane >> 5;
    const int nsteps = ctx ? 4 : gsize(g), g0 = gstart(g);
    auto chunk_of = [&](int i) -> int { const int c = ctx ? (dir ? 3 - i : i) : (dir ? g0 + nsteps - 1 - i : g0 + i); return ctx ? 512 + b * 4 + c : b * 256 + c; };
    u32x4 pq[2], pk[2], pv[4], pd;
    auto gload = [&](int ck, int tid) {
        const size_t rb = (size_t)ck * 64;
#pragma unroll
        for (int pp = 0; pp < 2; ++pp) { const int c = tid + 512 * pp, row = c >> 4, cc = c & 15;
            if (OUT) pq[pp] = *(const u32x4*)(QT + (rb + row) * 512 + h * 128 + cc * 8);
            pk[pp] = *(const u32x4*)(KT + (rb + row) * 512 + h * 128 + cc * 8); }
#pragma unroll
        for (int pp = 0; pp < 4; ++pp) { const int c = tid + 512 * pp, row = c >> 5, cc = c & 31; pv[pp] = *(const u32x4*)(P + (rb + row) * LDPO + 512 + h * 256 + cc * 8); }
        if (tid < 32) pd = *(const u32x4*)(DEC + (size_t)(ck * 4 + h) * 128 + tid * 4);
    };
    auto lstore = [&](LAS unsigned char* bb, int tid) {
#pragma unroll
        for (int pp = 0; pp < 2; ++pp) { const int c = tid + 512 * pp, row = c >> 4, cc = c & 15;
            if (OUT) *(LAS u32x4*)(bb + G_QOFF + row * 272 + cc * 16) = pq[pp];
            *(LAS u32x4*)(bb + G_KOFF + row * 272 + cc * 16) = pk[pp]; }
#pragma unroll
        for (int pp = 0; pp < 4; ++pp) { const int c = tid + 512 * pp, row = c >> 5, cc = c & 31; *(LAS u32x4*)(bb + G_VOFF + row * 528 + cc * 16) = pv[pp]; }
        if (tid < 32) *(LAS u32x4*)(bb + G_DOFF + tid * 16) = pd;
    };
    float gd = 1.f;
    gload(chunk_of(0), tid); lstore(lds, tid);
    __syncthreads();
    for (int i = 0; i < nsteps; ++i) {
        const bool more = i + 1 < nsteps;
        const int ck = chunk_of(i);
        const int tid2 = ltid();
        if (more) gload(chunk_of(i + 1), tid2);
        LAS unsigned char* bb = lds + (i & 1) * G_BUF;
        LAS unsigned char* qb = bb + G_QOFF; LAS unsigned char* kb = bb + G_KOFF; LAS unsigned char* vb = bb + G_VOFF;
        const LAS float* dec = (const LAS float*)(bb + G_DOFF);
        if (!OUT) { if (tid < 128) gd *= dec[tid]; }
        if (OUT) {
            f32x16 o[2];
#pragma unroll
            for (int e = 0; e < 16; ++e) { o[0][e] = 0.f; o[1][e] = 0.f; }
#pragma unroll
            for (int st = 0; st < 2; ++st)
#pragma unroll
                for (int tt = 0; tt < 2; ++tt) {
                    if (dir ? (st == 0 && tt == 1) : (st == 1 && tt == 0)) continue;
                    f32x16 am;
#pragma unroll
                    for (int e = 0; e < 16; ++e) am[e] = 0.f;
#pragma unroll
                    for (int ks = 0; ks < 8; ++ks) {
                        const bf16x8 a = *(const LAS bf16x8*)(kb + (32 * st + l32) * 272 + (16 * ks + 8 * hh) * 2);
                        const bf16x8 bq = *(const LAS bf16x8*)(qb + (32 * tt + l32) * 272 + (16 * ks + 8 * hh) * 2);
                        am = MFMA32(a, bq, am);
                    }
                    const int t = 32 * tt + l32;
#pragma unroll
                    for (int e = 0; e < 16; ++e) { const int s = 32 * st + (e >> 2) * 8 + 4 * hh + (e & 3); const bool keep = dir ? (t <= s) : (t >= s); am[e] = keep ? am[e] : 0.f; }
                    const bf16x8 pm0 = pack8(am[0], am[1], am[2], am[3], am[4], am[5], am[6], am[7]);
                    const bf16x8 pm1 = pack8(am[8], am[9], am[10], am[11], am[12], am[13], am[14], am[15]);
                    const bf16x8 a0 = tr_perm(vb, 528, 32 * st, 32 * w, lane);
                    o[tt] = MFMA32(a0, pm0, o[tt]);
                    const bf16x8 a1 = tr_perm(vb, 528, 32 * st + 16, 32 * w, lane);
                    o[tt] = MFMA32(a1, pm1, o[tt]);
                    __builtin_amdgcn_sched_barrier(0);
                }
#pragma unroll
            for (int dt = 0; dt < 4; ++dt)
#pragma unroll
                for (int ks2 = 0; ks2 < 2; ++ks2) {
                    const bf16x8 a = pack8(S[dt][8 * ks2], S[dt][8 * ks2 + 1], S[dt][8 * ks2 + 2], S[dt][8 * ks2 + 3], S[dt][8 * ks2 + 4], S[dt][8 * ks2 + 5], S[dt][8 * ks2 + 6], S[dt][8 * ks2 + 7]);
#pragma unroll
                    for (int tt = 0; tt < 2; ++tt) {
                        LAS unsigned char* qa = qb + (32 * tt + l32) * 272 + (32 * dt + 16 * ks2 + 4 * hh) * 2;
                        const bf16x4 x = *(const LAS bf16x4*)qa, y = *(const LAS bf16x4*)(qa + 16);
                        const bf16x8 bq = __builtin_shufflevector(x, y, 0, 1, 2, 3, 4, 5, 6, 7);
                        o[tt] = MFMA32(a, bq, o[tt]);
                    }
                    __builtin_amdgcn_sched_barrier(0);
                }
            {
                LAS unsigned char* stg = lds + ((i + 1) & 1) * G_BUF + G_VOFF;
#pragma unroll
                for (int tt = 0; tt < 2; ++tt)
#pragma unroll
                    for (int g4 = 0; g4 < 4; ++g4) {
                        const u32x2 pkv = {pk2(o[tt][4 * g4], o[tt][4 * g4 + 1]), pk2(o[tt][4 * g4 + 2], o[tt][4 * g4 + 3])};
                        *(LAS u32x2*)(stg + (32 * tt + l32) * 528 + (32 * w + 8 * g4 + 4 * hh) * 2) = pkv;
                    }
                __syncthreads();
                const size_t rbase = (size_t)ck * 64;
                const int tq = tid2 >> 5, cc = tid2 & 31;
                if (dir == 0) {
#pragma unroll
                    for (int pp = 0; pp < 4; ++pp) {
                        const int t = tq + 16 * pp;
                        *(u32x4*)(MIX + (rbase + t) * DM + h * 256 + cc * 8) = *(const LAS u32x4*)(stg + t * 528 + cc * 16);
                    }
                } else {
                    u32x4 of[4], rg[4];
#pragma unroll
                    for (int pp = 0; pp < 4; ++pp) {
                        const int t = tq + 16 * pp;
                        of[pp] = *(const u32x4*)(MIX + (rbase + t) * DM + h * 256 + cc * 8);
                        rg[pp] = *(const u32x4*)(P + (rbase + t) * LDPO + 2080 + h * 256 + cc * 8);
                    }
                    const f32x4 gn0 = *(const f32x4*)(onorm + cc * 8), gn1 = *(const f32x4*)(onorm + cc * 8 + 4);
#pragma unroll
                    for (int pp = 0; pp < 4; ++pp) {
                        const int t = tq + 16 * pp;
                        const u32x4 ob = *(const LAS u32x4*)(stg + t * 528 + cc * 16);
                        float v[8]; float ss = 0.f;
#pragma unroll
                        for (int e = 0; e < 4; ++e) { v[2 * e] = bflo(ob[e]) + bflo(of[pp][e]); v[2 * e + 1] = bfhi(ob[e]) + bfhi(of[pp][e]); ss += v[2 * e] * v[2 * e] + v[2 * e + 1] * v[2 * e + 1]; }
#pragma unroll
                        for (int o2 = 16; o2 >= 1; o2 >>= 1) ss += __shfl_xor(ss, o2);
                        const float rstd = rsqrtf(ss * (1.f / 256.f) + 1e-6f);
                        u32x4 ov;
#pragma unroll
                        for (int e = 0; e < 4; ++e) {
                            const float g0 = e < 2 ? gn0[2 * e] : gn1[2 * e - 4], g1 = e < 2 ? gn0[2 * e + 1] : gn1[2 * e - 3];
                            ov[e] = pk2(v[2 * e] * rstd * g0 * silu_f(bflo(rg[pp][e])), v[2 * e + 1] * rstd * g1 * silu_f(bfhi(rg[pp][e])));
                        }
                        *(u32x4*)(MIX + (rbase + t) * DM + h * 256 + cc * 8) = ov;
                    }
                }
            }
        }
        if (OUT) { __builtin_amdgcn_sched_barrier(0); }
#pragma unroll
        for (int ks = 0; ks < 4; ++ks) {
            const bf16x8 bv = tr_nat(vb, 528, 16 * ks, 32 * w, lane);
#pragma unroll
            for (int dt = 0; dt < 4; ++dt) { const bf16x8 a = tr_nat(kb, 272, 16 * ks, 32 * dt, lane); S[dt] = MFMA32(a, bv, S[dt]); }
        }
#pragma unroll
        for (int dt = 0; dt < 4; ++dt)
#pragma unroll
            for (int g4 = 0; g4 < 4; ++g4) { const f32x4 dv = *(const LAS f32x4*)(dec + 32 * dt + 8 * g4 + 4 * hh);
#pragma unroll
                for (int e = 0; e < 4; ++e) S[dt][4 * g4 + e] *= dv[e]; }
        if (OUT) __syncthreads();
        if (more) lstore(lds + ((i + 1) & 1) * G_BUF, tid2);
        __syncthreads();
    }
    if (!OUT) { if (tid < 128) gdout[tid] = gd; }
}
__device__ __forceinline__ void s_zero(f32x16 (&S)[4]) {
#pragma unroll
    for (int dt = 0; dt < 4; ++dt)
#pragma unroll
        for (int e = 0; e < 16; ++e) S[dt][e] = 0.f;
}
__device__ __forceinline__ void s_store(const f32x16 (&S)[4], bf16_t* slot) {
    const int lane = ltid() & 63, w = ltid() >> 6, l32 = lane & 31, hh = lane >> 5;
#pragma unroll
    for (int dt = 0; dt < 4; ++dt)
#pragma unroll
        for (int e = 0; e < 16; ++e) slot[(32 * dt + (e >> 2) * 8 + 4 * hh + (e & 3)) * 256 + 32 * w + l32] = f2bf(S[dt][e]);
}
__device__ __forceinline__ void s_load(f32x16 (&S)[4], const bf16_t* slot) {
    const int lane = ltid() & 63, w = ltid() >> 6, l32 = lane & 31, hh = lane >> 5;
#pragma unroll
    for (int dt = 0; dt < 4; ++dt)
#pragma unroll
        for (int e = 0; e < 16; ++e) S[dt][e] = bf2f(slot[(32 * dt + (e >> 2) * 8 + 4 * hh + (e & 3)) * 256 + 32 * w + l32]);
}
__device__ void phase_gla_a(const Params& p, int j, unsigned char* ldsg) {
    bf16_t* SLOC = (bf16_t*)(p.ws + OFF_SLOC); float* GD = (float*)(p.ws + OFF_GD);
    for (int item = blockIdx.x; item < 16 * NSLOT; item += gridDim.x) {
        const int combo = item < 16 * NGRP ? item / NGRP : item - 16 * NGRP, g = item < 16 * NGRP ? item % NGRP : NGRP;
        const int dir = combo & 1, h = (combo >> 1) & 3, b = combo >> 3, slot = combo * NSLOT + g;
        f32x16 S[4]; s_zero(S);
        gla_seq<false>(p, j, (LAS unsigned char*)ldsg, b, h, dir, g == NGRP, g, S, GD + (size_t)slot * 128);
        s_store(S, SLOC + (size_t)slot * 32768);
    }
}
__device__ void phase_gla_b(const Params& p) {
    bf16_t* SLOC = (bf16_t*)(p.ws + OFF_SLOC); const float* GD = (const float*)(p.ws + OFF_GD);
    for (int e = blockIdx.x * 512 + ltid(); e < 16 * 32768; e += gridDim.x * 512) {
        const int combo = e >> 15, dv = e & 32767, d = dv >> 8, dir = combo & 1, base = combo * NSLOT;
        float S = bf2f(SLOC[(size_t)(base + NGRP) * 32768 + dv]);
        for (int q = 0; q < NGRP; ++q) {
            const int g = dir ? NGRP - 1 - q : q;
            const size_t o = (size_t)(base + g) * 32768 + dv;
            const float tmp = bf2f(SLOC[o]); SLOC[o] = f2bf(S); S = GD[(base + g) * 128 + d] * S + tmp;
        }
    }
}
__device__ void phase_gla_c(const Params& p, int j, unsigned char* ldsg) {
    const bf16_t* SLOC = (const bf16_t*)(p.ws + OFF_SLOC);
    for (int item = blockIdx.x; item < 8 * NSLOT; item += gridDim.x) {
        const int bh = item < 8 * NGRP ? (item & 7) : item - 8 * NGRP, g = item < 8 * NGRP ? NGRP - 1 - (item >> 3) : NGRP;
        const int h = bh & 3, b = bh >> 2;
        f32x16 S[4];
        for (int dir = 0; dir < 2; ++dir) {
            if (g == NGRP) s_zero(S); else s_load(S, SLOC + (size_t)((bh * 2 + dir) * NSLOT + g) * 32768);
            gla_seq<true>(p, j, (LAS unsigned char*)ldsg, b, h, dir, g == NGRP, g, S, nullptr);
        }
    }
}

#define XB_TMO      128
#define XB_XCNT(j)  (256  + 64 * (j))
#define XB_XSUB(j)  (1280 + 64 * (j))
#define XB_XGEN(j)  (2304 + 64 * (j))
#define XB_TOP      3328
#define XB_TOPGEN   3392
#define XCD_BAR_WORDS 3456
#define XB_SPIN_CAP (1u << 18)
__device__ __forceinline__ unsigned xb_ld(unsigned* p)              { return __hip_atomic_load(p, __ATOMIC_RELAXED, __HIP_MEMORY_SCOPE_AGENT); }
__device__ __forceinline__ unsigned xb_add(unsigned* p, unsigned v) { return __hip_atomic_fetch_add(p, v, __ATOMIC_RELAXED, __HIP_MEMORY_SCOPE_AGENT); }
__device__ __forceinline__ unsigned xb_xcc_id() { return (unsigned)__builtin_amdgcn_s_getreg((3 << 11) | 20) & 0xFu; }
#define XB_SPIN(cond, bar) do { unsigned _sp = 0; while (cond) { __builtin_amdgcn_s_sleep(1); \
    if ((++_sp & 255u) == 0u) { if (xb_ld(&(bar)[XB_TMO])) break; if (_sp > XB_SPIN_CAP) { atomicAdd(&(bar)[XB_TMO], 1u); break; } } } } while (0)
struct XcdBarrier { unsigned* bar; unsigned x; volatile LAS unsigned* st; };
__device__ __forceinline__ XcdBarrier xcd_barrier_post(unsigned* bar, volatile LAS unsigned* st) {
    XcdBarrier b; b.bar = bar; b.x = xb_xcc_id(); b.st = st;
    if (threadIdx.x == 0) (void)xb_add(&bar[XB_XCNT(b.x)], 1u);
    return b;
}
__device__ __forceinline__ void xcd_barrier_complete(unsigned* bar, unsigned x, unsigned& nloc, unsigned& nx) {
    const unsigned G = gridDim.x * gridDim.y * gridDim.z;
    unsigned sum, cnt, mine, sp = 0u;
    for (;;) {
        sum = 0u; cnt = 0u; mine = 0u;
#pragma unroll
        for (unsigned j = 0; j < 16; ++j) { const unsigned c = xb_ld(&bar[XB_XCNT(j)]); sum += c; cnt += (c > 0u) ? 1u : 0u; mine = (j == x) ? c : mine; }
        if (sum == G) break;
        __builtin_amdgcn_s_sleep(1);
        if ((++sp & 255u) == 0u) { if (xb_ld(&bar[XB_TMO])) break; if (sp > XB_SPIN_CAP) { atomicAdd(&bar[XB_TMO], 1u); break; } }
    }
    nloc = mine > 0u ? mine : 1u; nx = cnt > 0u ? cnt : 1u;
}
__device__ __forceinline__ void xcd_barrier(const XcdBarrier& b) {
    asm volatile("s_waitcnt vmcnt(0)" ::: "memory");
    __syncthreads();
    if (threadIdx.x == 0) {
        unsigned* bar = b.bar;
        __builtin_amdgcn_s_waitcnt(0);
        unsigned nloc = b.st[0], nx = b.st[1];
        if (nloc == 0u) { xcd_barrier_complete(bar, b.x, nloc, nx); b.st[0] = nloc; b.st[1] = nx; }
        const unsigned old = xb_add(&bar[XB_XSUB(b.x)], 1u);
        const unsigned gen = old / nloc;
        if (old + 1u == (gen + 1u) * nloc) {
            __builtin_amdgcn_fence(__ATOMIC_RELEASE, "agent");
            asm volatile("s_waitcnt vmcnt(0)" ::: "memory");
            const unsigned og = xb_add(&bar[XB_TOP], 1u);
            const unsigned tg = og / nx;
            if (og + 1u == (tg + 1u) * nx) xb_add(&bar[XB_TOPGEN], 1u);
            else XB_SPIN(xb_ld(&bar[XB_TOPGEN]) == tg, bar);
            __builtin_amdgcn_fence(__ATOMIC_ACQUIRE, "agent");
            xb_add(&bar[XB_XGEN(b.x)], 1u);
            asm volatile("s_waitcnt vmcnt(0)" ::: "memory");
        } else {
            XB_SPIN(xb_ld(&bar[XB_XGEN(b.x)]) == gen, bar);
            __builtin_amdgcn_fence(__ATOMIC_ACQUIRE, "agent");
            asm volatile("s_waitcnt vmcnt(0)" ::: "memory");
        }
    }
    __syncthreads();
}
#ifndef PROBE_REP
#define PROBE_REP 0
#endif
#ifndef PHM
#define PHM 0xFFFF
#endif
#define PH(b) if (PHM & (1 << (b)))
enum { K_N1 = 0, K_GIN, K_PREP, K_GQ, K_GKV, K_ATT, K_GPREP, K_GA, K_GB, K_GC, K_GOUT, K_N2, K_GUP, K_GDN, K_COPY, K_NONE, K_KMAX };
__global__ void __launch_bounds__(512, 2) mega(Params p) {
    extern __shared__ __attribute__((aligned(16))) unsigned char ldsg[];
    LAS unsigned char* lds = (LAS unsigned char*)ldsg;
    cg::grid_group grid = cg::this_grid();
    unsigned char* ws = p.ws;
    float* MOD = (float*)(ws + OFF_MOD);
    float* XC = (float*)(ws + OFF_XC);
    bf16_t* H = (bf16_t*)(ws + OFF_H); bf16_t* MIX = (bf16_t*)(ws + OFF_MIX);
    bf16_t* PB = (bf16_t*)(ws + OFF_BIG);
    const bool en_even = p.flags & 1, en_odd = p.flags & 2, en_mlp = p.flags & 4;

    volatile LAS unsigned* xst = (volatile LAS unsigned*)(lds + LDS_BYTES - 16);
    if (threadIdx.x == 0) { xst[0] = 0u; xst[1] = 0u; }
    __syncthreads();
    const XcdBarrier xbar = xcd_barrier_post((unsigned*)(ws + OFF_BAR), xst);
    PH(0) phase_ada(p, ldsg);
    grid.sync();
    for (int step = 0; step < 44; ++step) {
        const int i = step / 11, s = step % 11, j = i >> 1; const bool even = !(i & 1);
        const float* mod = MOD + (size_t)i * 3 * 6144;
        const bool en_mix = even ? en_even : en_odd;
        const bool first = (i == 0) && (s <= 7);
        const float* xl = first ? p.in[0] : p.out; const float* xc = ((i == 0) && (s <= 8)) ? p.in[2] : XC;
        float* PART = (float*)(ws + OFF_PART);
        int kind;
        switch (s) {
            case 0: kind = K_N1; break;
            case 1: kind = K_GIN; break;
            case 2: kind = even ? K_PREP : K_GPREP; break;
            case 3: kind = even ? K_GQ : K_GA; break;
            case 4: kind = even ? K_GKV : K_GB; break;
            case 5: kind = even ? K_KMAX : K_GC; break;
            case 6: kind = even ? K_ATT : K_NONE; break;
            case 7: kind = K_GOUT; break;
            case 8: kind = K_N2; break;
            case 9: kind = K_GUP; break;
            default: kind = K_GDN; break;
        }
        if (s <= 7 && !en_mix) kind = (s == 0) ? K_NONE : ((i == 0 && s == 7) ? K_COPY : K_NONE);
        if (s >= 8 && !en_mlp) kind = K_NONE;
        if (s == 0) { PH(1) phase_weights(p, i, ldsg); }
        if (kind == K_NONE) { if (s == 0) xcd_barrier(xbar); continue; }
        bool gemmB = false, gemmR = false, nosync = false;
        pg8::EpiB EB; EB.O = PB; EB.ldo = 0; EB.rs = nullptr; EB.mode = 0;
        pg8::EpiR ER; ER.xin_l = xl; ER.xin_c = xc; ER.xout_l = p.out; ER.xout_c = XC; ER.gate = mod;
        const bf16_t* gA = H; const bf16_t* gB = (const bf16_t*)(ws + OFF_WIN); int lda = 1024, ldb = 1024, gN = 1024, gK = 1024, gM = R, nP = 0, Kp = 256;
        const int reps = ((p.flags >> (8 + kind)) & 1) ? 2 : 1;
        for (int rep = 0; rep < reps; ++rep) {
        if (rep) __syncthreads();
        switch (kind) {
            case K_N1: PH(2) phase_norm(xl, xc, p.in[6] + i * 1024, mod, 0, 1, H, R, i > 0 ? PART : nullptr, 8, mod - 3 * 6144 + 2 * 6144 + 5 * 1024, XC); break;
            case K_N2: PH(2) phase_norm(xl, xc, p.in[7] + i * 1024, mod, 3, 4, H, i < 3 ? R : RL, PART, 4, mod + 2 * 6144 + 2 * 1024, XC); break;
            case K_GIN: gemmB = true; gN = even ? 1792 : 3328; EB.ldo = gN; break;
            case K_PREP: PH(4) phase_even_prep(p, j, ldsg); break;
            case K_GQ: gemmB = true; nosync = true; gA = PB; lda = LDPE; gB = (const bf16_t*)(ws + OFF_WUQ); ldb = 384; gN = 768; gK = 384; EB.O = (bf16_t*)(ws + OFF_Q); EB.ldo = 768; EB.rs = (const float*)(ws + OFF_RSQ); break;
            case K_GKV: gemmB = true; gA = PB + 384; lda = LDPE; gB = (const bf16_t*)(ws + OFF_WUKV); ldb = 256; gN = 1024; gK = 256; EB.O = (bf16_t*)(ws + OFF_KV); EB.ldo = 1024; EB.rs = (const float*)(ws + OFF_RSKV); break;
            case K_KMAX: PH(4) phase_kmax(p, ldsg); break;
            case K_ATT: PH(5) phase_attn(p, ldsg); break;
            case K_GPREP: PH(6) phase_gla_prep(p, j, ldsg); break;
            case K_GA: PH(7) phase_gla_a(p, j, ldsg); break;
            case K_GB: PH(8) phase_gla_b(p); break;
            case K_GC: PH(9) phase_gla_c(p, j, ldsg); break;
            case K_GOUT: gemmR = true; gA = MIX; gB = (const bf16_t*)(ws + OFF_WOUT); ER.gate = mod + 2 * 1024; gM = RL; nP = i < 3 ? 4 : 0; Kp = 256; break;
            case K_GUP: gemmB = true; gB = (const bf16_t*)(ws + OFF_W1); gN = 4096; EB.ldo = 4096; EB.mode = 1; gM = i < 3 ? R : RL; break;
            case K_GDN: gemmR = true; gA = PB; lda = 4096; gB = (const bf16_t*)(ws + OFF_W2); ldb = 4096; gK = 4096; ER.gate = mod + 5 * 1024; gM = RL; nP = i < 3 ? 8 : 0; Kp = 512; break;
            case K_COPY:
                for (size_t e = (size_t)blockIdx.x * 512 + ltid(); e < (size_t)R * 256; e += (size_t)gridDim.x * 512) {
                    const size_t row = e >> 8, c4 = (e & 255) * 4;
                    if (row < RL) *(f32x4*)(p.out + row * DM + c4) = *(const f32x4*)(xl + row * DM + c4);
                    else *(f32x4*)(XC + (row - RL) * DM + c4) = *(const f32x4*)(xc + (row - RL) * DM + c4);
                }
                break;
            default: break;
        }
        if (gemmB) { PH(3) run_gemm(lds, gA, lda, gB, ldb, gM, gN, gK, EB, kind == K_GKV); }
        if (gemmR) { PH(10) { run_gemm(lds, gA, lda, gB, ldb, gM, gN, gK, ER); if (nP) run_pieces(lds, gA + (size_t)RL * lda, lda, gB, ldb, nP, Kp, PART); } }
        }
        if (!nosync) xcd_barrier(xbar);
    }
    PH(11) phase_final(p.in[26], p.out);
}

extern "C" void kernel_launch(void* const* d_in, const int* in_sizes, int n_in, void* d_out, int out_size, void* d_ws, size_t ws_size, hipStream_t stream) {
    static int grid = 0;
    if (grid == 0) {
        if (n_in != 27 || ws_size < WS_NEED) { fprintf(stderr, "kernel_launch: unexpected n_in %d / ws %zu\n", n_in, ws_size); grid = -1; return; }
        int dev = 0, cus = 0, per_cu = 0;
        hipGetDevice(&dev);
        hipDeviceGetAttribute(&cus, hipDeviceAttributeMultiprocessorCount, dev);
        hipFuncSetAttribute((const void*)mega, hipFuncAttributeMaxDynamicSharedMemorySize, LDS_BYTES);
        hipOccupancyMaxActiveBlocksPerMultiprocessor(&per_cu, (const void*)mega, 512, LDS_BYTES);
        (void)hipGetLastError();
        if (per_cu < 1) fprintf(stderr, "kernel_launch: occupancy query reports %d blocks per CU\n", per_cu);
        grid = cus > 0 ? cus : 256;
    }
    if (grid < 0) return;
    if (hipMemsetAsync((char*)d_ws + OFF_BAR, 0, 16384, stream) != hipSuccess) { fprintf(stderr, "kernel_launch: memset failed\n"); return; }
    Params p{};
    for (int i = 0; i < 27; ++i) p.in[i] = (const float*)d_in[i];
    p.out = (float*)d_out; p.ws = (unsigned char*)d_ws; p.flags = 7 | PROBE_REP;
    void* args[] = {&p};
    hipError_t e = hipLaunchCooperativeKernel((const void*)mega, dim3(grid), dim3(512), args, LDS_BYTES, stream);
    if (e != hipSuccess) fprintf(stderr, "cooperative launch failed: %s (grid %d)\n", hipGetErrorString(e), grid);
}
```

```cpp
#include <hip/hip_runtime.h>
#include <hip/hip_cooperative_groups.h>
#include <cstdio>
namespace cg = cooperative_groups;

#define LAS __attribute__((address_space(3)))
typedef unsigned short bf16_t;
typedef short bf16x8 __attribute__((ext_vector_type(8)));
typedef short bf16x4 __attribute__((ext_vector_type(4)));
typedef float f32x4 __attribute__((ext_vector_type(4)));
typedef float f32x16 __attribute__((ext_vector_type(16)));
typedef unsigned u32x4 __attribute__((ext_vector_type(4)));
typedef unsigned u32x2 __attribute__((ext_vector_type(2)));

constexpr int R = 33280, RL = 32768, DM = 1024;
constexpr int LDPE = 1792, LDPO = 3328;
constexpr size_t MiB = (size_t)1 << 20;
constexpr size_t OFF_WIN = 0, OFF_WOUT = 8 * MiB, OFF_WUQ = 10 * MiB, OFF_WUKV = 11 * MiB, OFF_WCM = 12 * MiB, OFF_W1 = 13 * MiB, OFF_W2 = 21 * MiB;
constexpr size_t OFF_MOD = 30 * MiB, OFF_XC = 31 * MiB, OFF_RSQ = 33 * MiB, OFF_RSKV = 33 * MiB + 256 * 1024, OFF_GD = 36 * MiB + 640 * 1024;
constexpr size_t OFF_BAR = 33 * MiB + 768 * 1024;
constexpr size_t OFF_KMS = 33 * MiB + 800 * 1024;
constexpr size_t OFF_DECF = 34 * MiB, OFF_DECB = 35 * MiB + 512 * 1024;
constexpr size_t OFF_H = 37 * MiB, OFF_MIX = 102 * MiB, OFF_BIG = 167 * MiB, OFF_G = 427 * MiB;
constexpr size_t OFF_Q = OFF_BIG + 114 * MiB, OFF_KV = OFF_BIG + 163 * MiB, OFF_KR = OFF_BIG + 228 * MiB;
constexpr size_t OFF_QTF = OFF_H, OFF_KTF = OFF_H + 34078720, OFF_QTB = OFF_BIG + 212 * MiB, OFF_SLOC = OFF_G, OFF_KTB = OFF_G + 34 * MiB;
constexpr size_t OFF_PART = 494 * MiB;
constexpr size_t WS_NEED = 510 * MiB;
constexpr int LDS_BYTES = 144 * 1024;

struct Params {
    const float* in[27];
    float* out;
    unsigned char* ws;
    long long flags;
};

__device__ __forceinline__ float bf2f(bf16_t b) { return __uint_as_float(((unsigned)b) << 16); }
__device__ __forceinline__ float bflo(unsigned u) { return __uint_as_float(u << 16); }
__device__ __forceinline__ float bfhi(unsigned u) { return __uint_as_float(u & 0xffff0000u); }
__device__ __forceinline__ bf16_t f2bf(float f) { unsigned u = __float_as_uint(f); u += 0x7FFFu + ((u >> 16) & 1u); return (bf16_t)(u >> 16); }
typedef __bf16 hwbf2_t __attribute__((ext_vector_type(2)));
typedef float f32x2v_t __attribute__((ext_vector_type(2)));
__device__ __forceinline__ unsigned pk2(float lo, float hi) { const f32x2v_t v = {lo, hi}; const hwbf2_t b = __builtin_convertvector(v, hwbf2_t); return __builtin_bit_cast(unsigned, b); }
__device__ __forceinline__ bf16x8 pack8(float a0, float a1, float a2, float a3, float a4, float a5, float a6, float a7) {
    u32x4 u = {pk2(a0, a1), pk2(a2, a3), pk2(a4, a5), pk2(a6, a7)};
    return __builtin_bit_cast(bf16x8, u);
}
__device__ __forceinline__ float wsum(float v) {
#pragma unroll
    for (int o = 32; o >= 1; o >>= 1) v += __shfl_xor(v, o);
    return v;
}
__device__ __forceinline__ float gelu_t(float x) { const float u = 0.7978845608f * (x + 0.044715f * x * x * x); return x / (1.f + __expf(-2.f * u)); }
__device__ __forceinline__ float silu_f(float x) { return x / (1.f + __expf(-x)); }
__device__ __forceinline__ void sincos_red(float ang, float& s, float& c) {
    const float k = rintf(ang * 0.15915494309f);
    float r = fmaf(-k, 6.2831854820251465f, ang);
    r = fmaf(-k, -1.7484555e-7f, r);
    s = __sinf(r); c = __cosf(r);
}
__device__ __forceinline__ float rope_inv(int jj) { return exp2f(-(float)jj * 1.6609640474f); }

__device__ __forceinline__ bf16x4 tr16(LAS unsigned char* a) { return __builtin_amdgcn_ds_read_tr16_b64_v4i16((LAS bf16x4*)a); }
__device__ __forceinline__ bf16x8 tr_nat(LAS unsigned char* base, int stride, int k0, int n0, int lane) {
    const int i = lane & 15, q = i >> 2, pq = i & 3, hh = lane >> 5, g1 = (lane >> 4) & 1;
    LAS unsigned char* a0 = base + (k0 + 8 * hh + q) * stride + (n0 + 16 * g1 + 4 * pq) * 2;
    const bf16x4 x = tr16(a0), y = tr16(a0 + 4 * stride);
    return __builtin_shufflevector(x, y, 0, 1, 2, 3, 4, 5, 6, 7);
}
__device__ __forceinline__ bf16x8 tr_perm(LAS unsigned char* base, int stride, int k0, int n0, int lane) {
    const int i = lane & 15, q = i >> 2, pq = i & 3, hh = lane >> 5, g1 = (lane >> 4) & 1;
    LAS unsigned char* a0 = base + (k0 + 4 * hh + q) * stride + (n0 + 16 * g1 + 4 * pq) * 2;
    const bf16x4 x = tr16(a0), y = tr16(a0 + 8 * stride);
    return __builtin_shufflevector(x, y, 0, 1, 2, 3, 4, 5, 6, 7);
}
__device__ __forceinline__ int ltid() { int t = threadIdx.x; asm volatile("" : "+v"(t)); return t; }
#define MFMA32(a, b, c) __builtin_amdgcn_mfma_f32_32x32x16_bf16((a), (b), (c), 0, 0, 0)

namespace pg8 {
constexpr int BM = 256, BK = 64, HALF = 128, HTB = HALF * BK * 2, STAGE_BYTES = 8 * HTB, NXCD = 8, WGM = 8;
__device__ __forceinline__ int lds_byte(int r, int c) { const int st = (r >> 4) * 2 + (c >> 5), rr = r & 15, cc = c & 31, ob = rr * 64 + cc * 2; return st * 1024 + (ob ^ (((ob >> 9) & 1) << 5)); }
__device__ __forceinline__ void stage_rc(int b, int& Rr, int& C) { const int st = b / 1024, sb = b % 1024, swz = sb ^ (((sb >> 9) & 1) << 5); Rr = (st >> 1) * 16 + swz / 64; C = (st & 1) * 32 + (swz % 64) / 2; }
__device__ __forceinline__ int perm32(int rho) { const int n = rho >> 4, i = rho & 15; return 8 * (i >> 2) + 4 * n + (i & 3); }
struct Unit { int pm, pn, ko; };
struct Gemm { const bf16_t* A; const bf16_t* Bt; int lda, ldb, M, N, K; };
struct StaticOrder {
    int nM, nN, nwg, G, c;
    __device__ void init(int M, int N, int G_, int c_) { nM = M / BM; nN = N / BM; nwg = nM * nN; G = G_; c = c_; }
    __device__ bool next(int i, Unit& u) const {
        const long L = (long)i * G + c; if (L >= nwg) return false;
        int wgid = (int)L; { const int q = nwg / NXCD, r = nwg % NXCD, xcd = wgid % NXCD, off = wgid / NXCD; wgid = (xcd < r ? xcd * (q + 1) : r * (q + 1) + (xcd - r) * q) + off; }
        const int nig = WGM * nN, gid = wgid / nig, fm = gid * WGM, gsz = (nM - fm) < WGM ? (nM - fm) : WGM;
        u.pm = fm + ((wgid % nig) % gsz); u.pn = (wgid % nig) / gsz; u.ko = 0; return true;
    }
};
struct PieceOrder {
    int nP, Kp, G, c;
    __device__ bool next(int i, Unit& u) const {
        const long L = (long)i * G + c; if (L >= 8 * nP) return false;
        const int kp = (int)L >> 3, r = (int)L & 7; u.pm = r >> 2; u.pn = r & 3; u.ko = kp * Kp; return true;
    }
};

template <class Epi, class Sched>
__device__ __forceinline__ void gemm_phase(LAS unsigned char* lds, const Gemm g, const Sched& S, const Epi& E) {
    const int tid = ltid(), wid = __builtin_amdgcn_readfirstlane(tid >> 6), lane = tid & 63, wr = wid >> 2, wc = wid & 3, fr = lane & 15, fq = lane >> 4;
    const int K = g.K, nt = K / BK;
    unsigned voffA[2], voffB[2];
#pragma unroll
    for (int i = 0; i < 2; ++i) { int Rr, C; stage_rc(tid * 16 + i * 8192, Rr, C); const int Rb = Epi::PERM ? ((Rr & ~31) + perm32(Rr & 31)) : Rr;
        voffA[i] = (unsigned)(Rr * g.lda + C) * 2u; voffB[i] = (unsigned)(Rb * g.ldb + C) * 2u; }
    const size_t kstep = (size_t)(BK * 2);
    const size_t hA = (size_t)HALF * g.lda * 2, hB = (size_t)HALF * g.ldb * 2;
    const size_t tA = 2 * hA, tB = 2 * hB;
    const unsigned ldsw = (unsigned)wid * 1024u;
    const int aoff = lds_byte(wr * 64 + fr, fq * 8), boff = lds_byte(wc * 32 + fr, fq * 8);
#define PG8_SA(b, h) (((b) * 2 + (h)) * HTB)
#define PG8_SB(b, h) ((4 + (b) * 2 + (h)) * HTB)
#define PG8_STAGE(bufoff, gbase, voff) do { _Pragma("unroll") for (int _i = 0; _i < 2; ++_i) \
        __builtin_amdgcn_global_load_lds((const unsigned*)((const char*)(gbase) + (voff)[_i]), (LAS unsigned*)(lds + (bufoff) + ldsw + _i * 8192), 16, 0, 0); } while (0)
#define PG8_LDA(dst, b, h) do { _Pragma("unroll") for (int m = 0; m < 4; ++m) _Pragma("unroll") for (int k = 0; k < 2; ++k) dst[m][k] = *(const LAS bf16x8*)(lds + PG8_SA(b, h) + aoff + m * 2048 + k * 1024); } while (0)
#define PG8_LDB(dst, b, h) do { _Pragma("unroll") for (int n = 0; n < 2; ++n) _Pragma("unroll") for (int k = 0; k < 2; ++k) dst[n][k] = *(const LAS bf16x8*)(lds + PG8_SB(b, h) + boff + n * 2048 + k * 1024); } while (0)
#define PG8_MMA(ai, bj, At, Bt) do { __builtin_amdgcn_s_setprio(1); _Pragma("unroll") for (int m = 0; m < 4; ++m) _Pragma("unroll") for (int n = 0; n < 2; ++n) _Pragma("unroll") for (int k = 0; k < 2; ++k) \
        acc[ai][bj][m][n] = __builtin_amdgcn_mfma_f32_16x16x32_bf16(Bt[n][k], At[m][k], acc[ai][bj][m][n], 0, 0, 0); __builtin_amdgcn_s_setprio(0); } while (0)
#define PG8_WAIT_V(n) asm volatile("s_waitcnt vmcnt(" #n ")" ::: "memory")
#define PG8_WAIT_L(n) asm volatile("s_waitcnt lgkmcnt(" #n ")" ::: "memory")
#define PG8_BAR __builtin_amdgcn_s_barrier()
#define PG8_SCHED __builtin_amdgcn_sched_barrier(0)
    Unit cur, nxt; int ui = 0;
    if (!S.next(0, cur)) return;
    f32x4 acc[2][2][4][2];
#pragma unroll
    for (int a = 0; a < 2; ++a)
#pragma unroll
        for (int b = 0; b < 2; ++b)
#pragma unroll
            for (int m = 0; m < 4; ++m)
#pragma unroll
                for (int n = 0; n < 2; ++n) acc[a][b][m][n] = (f32x4){0.f, 0.f, 0.f, 0.f};
    bf16x8 At[4][2], B0[2][2], B1[2][2];
    const char* cA = (const char*)g.A + (size_t)cur.pm * tA + (size_t)cur.ko * 2; const char* cB = (const char*)g.Bt + (size_t)cur.pn * tB + (size_t)cur.ko * 2;
    PG8_STAGE(PG8_SB(0, 0), cB, voffB); PG8_STAGE(PG8_SA(0, 0), cA, voffA); PG8_STAGE(PG8_SB(0, 1), cB + hB, voffB); PG8_STAGE(PG8_SA(0, 1), cA + hA, voffA);
    if (wr == 1) PG8_BAR;
    PG8_WAIT_V(4); PG8_BAR;
    PG8_STAGE(PG8_SB(1, 0), cB + kstep, voffB); PG8_STAGE(PG8_SA(1, 0), cA + kstep, voffA); PG8_STAGE(PG8_SB(1, 1), cB + hB + kstep, voffB);
    PG8_WAIT_V(6); PG8_BAR;
    for (;;) {
        const bool has_next = S.next(ui + 1, nxt);
        const char* nA = has_next ? (const char*)g.A + (size_t)nxt.pm * tA + (size_t)nxt.ko * 2 : cA; const char* nB = has_next ? (const char*)g.Bt + (size_t)nxt.pn * tB + (size_t)nxt.ko * 2 : cB;
        for (int t = 0; t < nt; t += 2) {
            const bool last = (t == nt - 2);
            const char* a1 = cA + (size_t)(t + 1) * kstep;
            const char* a2 = last ? nA : cA + (size_t)(t + 2) * kstep; const char* b2 = last ? nB : cB + (size_t)(t + 2) * kstep;
            const char* a3 = a2 + kstep; const char* b3 = b2 + kstep;
            PG8_LDB(B0, 0, 0); PG8_SCHED; PG8_LDA(At, 0, 0); PG8_STAGE(PG8_SA(1, 1), a1 + hA, voffA);
            PG8_WAIT_L(8); PG8_BAR; PG8_WAIT_L(0); PG8_MMA(0, 0, At, B0); PG8_BAR; PG8_SCHED;
            PG8_LDB(B1, 0, 1); PG8_STAGE(PG8_SB(0, 0), b2, voffB);
            PG8_BAR; PG8_WAIT_L(0); PG8_MMA(0, 1, At, B1); PG8_BAR;
            PG8_LDA(At, 0, 1); PG8_STAGE(PG8_SA(0, 0), a2, voffA);
            PG8_BAR; PG8_WAIT_L(0); PG8_MMA(1, 0, At, B0); PG8_BAR; PG8_SCHED;
            PG8_STAGE(PG8_SB(0, 1), b2 + hB, voffB);
            PG8_WAIT_V(6); PG8_BAR; PG8_MMA(1, 1, At, B1); PG8_BAR;
            PG8_LDB(B0, 1, 0); PG8_SCHED; PG8_LDA(At, 1, 0); PG8_STAGE(PG8_SA(0, 1), a2 + hA, voffA);
            PG8_WAIT_L(8); PG8_BAR; PG8_WAIT_L(0); PG8_MMA(0, 0, At, B0); PG8_BAR; PG8_SCHED;
            PG8_LDB(B1, 1, 1); PG8_STAGE(PG8_SB(1, 0), b3, voffB);
            PG8_BAR; PG8_WAIT_L(0); PG8_MMA(0, 1, At, B1); PG8_BAR;
            PG8_LDA(At, 1, 1); PG8_STAGE(PG8_SA(1, 0), a3, voffA);
            PG8_BAR; PG8_WAIT_L(0); PG8_MMA(1, 0, At, B0); PG8_BAR; PG8_SCHED;
            PG8_STAGE(PG8_SB(1, 1), b3 + hB, voffB);
            PG8_WAIT_V(6); PG8_BAR; PG8_MMA(1, 1, At, B1); PG8_BAR;
        }
        E(acc, cur, wr, wc, fr, fq);
        if (!has_next) break;
#pragma unroll
        for (int a = 0; a < 2; ++a)
#pragma unroll
            for (int b = 0; b < 2; ++b)
#pragma unroll
                for (int m = 0; m < 4; ++m)
#pragma unroll
                    for (int n = 0; n < 2; ++n) acc[a][b][m][n] = (f32x4){0.f, 0.f, 0.f, 0.f};
        cur = nxt; cA = nA; cB = nB; ++ui;
    }
    PG8_WAIT_V(0);
    if (wr == 0) PG8_BAR;
    PG8_BAR;
#undef PG8_SA
#undef PG8_SB
#undef PG8_STAGE
#undef PG8_LDA
#undef PG8_LDB
#undef PG8_MMA
#undef PG8_WAIT_V
#undef PG8_WAIT_L
#undef PG8_BAR
#undef PG8_SCHED
}

struct EpiB {
    static constexpr bool PERM = true;
    bf16_t* O; int ldo; const float* rs; int mode;
    __device__ __forceinline__ void operator()(const f32x4 (&acc)[2][2][4][2], const Unit& u, int wr, int wc, int fr, int fq) const {
        const int row0 = u.pm * BM + wr * 64 + fr, col0 = u.pn * BM + wc * 32 + 8 * fq;
#pragma unroll
        for (int ai = 0; ai < 2; ++ai)
#pragma unroll
            for (int m = 0; m < 4; ++m) {
                const int row = row0 + ai * HALF + m * 16;
                const float s = rs ? rs[row] : 1.f;
                bf16_t* rowp = O + (size_t)row * ldo + col0;
#pragma unroll
                for (int bj = 0; bj < 2; ++bj) {
                    f32x4 v0 = acc[ai][bj][m][0] * s, v1 = acc[ai][bj][m][1] * s;
                    if (mode == 1) {
#pragma unroll
                        for (int e = 0; e < 4; ++e) { const float a = fmaxf(v0[e], 0.f), b = fmaxf(v1[e], 0.f); v0[e] = a * a; v1[e] = b * b; }
                    }
                    const u32x4 o = {pk2(v0[0], v0[1]), pk2(v0[2], v0[3]), pk2(v1[0], v1[1]), pk2(v1[2], v1[3])};
                    *(u32x4*)(rowp + bj * HALF) = o;
                }
            }
    }
};
struct EpiR {
    static constexpr bool PERM = false;
    const float* xin_l; const float* xin_c; float* xout_l; float* xout_c; const float* gate;
    __device__ __forceinline__ void operator()(const f32x4 (&acc)[2][2][4][2], const Unit& u, int wr, int wc, int fr, int fq) const {
        const int var = u.pm < 64 ? 0 : (u.pm < 128 ? 1 : 2);
        const float* gp = gate + var * 6144;
        const int rowt = (u.pm < 128 ? u.pm : u.pm - 128) * BM + wr * 64 + fr;
        const float* xi = u.pm < 128 ? xin_l : xin_c; float* xo = u.pm < 128 ? xout_l : xout_c;
        const int col0 = u.pn * BM + wc * 32 + 4 * fq;
        f32x4 gv[2][2];
#pragma unroll
        for (int bj = 0; bj < 2; ++bj)
#pragma unroll
            for (int n = 0; n < 2; ++n) gv[bj][n] = *(const f32x4*)(gp + col0 + bj * HALF + n * 16);
#pragma unroll
        for (int ai = 0; ai < 2; ++ai)
#pragma unroll
            for (int m = 0; m < 4; ++m) {
                const size_t ro = (size_t)(rowt + ai * HALF + m * 16) * DM + col0;
#pragma unroll
                for (int bj = 0; bj < 2; ++bj)
#pragma unroll
                    for (int n = 0; n < 2; ++n) {
                        const f32x4 x = *(const f32x4*)(xi + ro + bj * HALF + n * 16);
                        *(f32x4*)(xo + ro + bj * HALF + n * 16) = x + gv[bj][n] * acc[ai][bj][m][n];
                    }
            }
    }
};
struct EpiP {
    static constexpr bool PERM = false;
    float* part; int kpiece;
    __device__ __forceinline__ void operator()(const f32x4 (&acc)[2][2][4][2], const Unit& u, int wr, int wc, int fr, int fq) const {
        const int kp = u.ko / kpiece;
        const int rowt = u.pm * BM + wr * 64 + fr, col0 = u.pn * BM + wc * 32 + 4 * fq;
        float* base = part + (size_t)kp * 512 * DM;
#pragma unroll
        for (int ai = 0; ai < 2; ++ai)
#pragma unroll
            for (int m = 0; m < 4; ++m) {
                const size_t ro = (size_t)(rowt + ai * HALF + m * 16) * DM + col0;
#pragma unroll
                for (int bj = 0; bj < 2; ++bj)
#pragma unroll
                    for (int n = 0; n < 2; ++n) *(f32x4*)(base + ro + bj * HALF + n * 16) = acc[ai][bj][m][n];
            }
    }
};
}

template <class Epi>
__device__ __forceinline__ void run_gemm(LAS unsigned char* lds, const bf16_t* A, int lda, const bf16_t* Bt, int ldb, int M, int N, int K, const Epi& E, bool rev = false) {
    pg8::Gemm g; g.A = A; g.Bt = Bt; g.lda = lda; g.ldb = ldb; g.M = M; g.N = N; g.K = K;
    pg8::StaticOrder S; S.init(M, N, (int)gridDim.x, rev ? (int)(gridDim.x - 1 - blockIdx.x) : (int)blockIdx.x);
    pg8::gemm_phase<Epi, pg8::StaticOrder>(lds, g, S, E);
}
__device__ __forceinline__ void run_pieces(LAS unsigned char* lds, const bf16_t* A, int lda, const bf16_t* Bt, int ldb, int nP, int Kp, float* part) {
    pg8::Gemm g; g.A = A; g.Bt = Bt; g.lda = lda; g.ldb = ldb; g.M = 512; g.N = 1024; g.K = Kp;
    pg8::PieceOrder S; S.nP = nP; S.Kp = Kp; S.G = (int)gridDim.x; S.c = (int)blockIdx.x;
    pg8::EpiP E; E.part = part; E.kpiece = Kp;
    pg8::gemm_phase<pg8::EpiP, pg8::PieceOrder>(lds, g, S, E);
}

__device__ void phase_ada(const Params& p, unsigned char* ldsg) {
    float* sl = (float*)ldsg;
    float* red = sl + 3072;
    const int tid = ltid();
    float* MOD = (float*)(p.ws + OFF_MOD);
    for (int idx = tid; idx < 3072; idx += 512) { const int var = idx >> 10, k = idx & 1023; const float v = var < 2 ? p.in[1][var * 1024 + k] : p.in[3][k]; sl[idx] = silu_f(v); }
    __syncthreads();
    for (int item = blockIdx.x; item < 192; item += gridDim.x) {
        const int i = item / 48, cb = item % 48, cc = tid & 127, kq = tid >> 7, col = cb * 128 + cc;
        const float* w = p.in[4] + ((size_t)i * 1024 + kq * 256) * 6144 + col;
        const float* s0 = sl + kq * 256;
        float a0 = 0.f, a1 = 0.f, a2 = 0.f;
#pragma unroll 8
        for (int k = 0; k < 256; ++k) { const float wv = w[(size_t)k * 6144]; a0 = fmaf(s0[k], wv, a0); a1 = fmaf(s0[1024 + k], wv, a1); a2 = fmaf(s0[2048 + k], wv, a2); }
        red[(kq * 3 + 0) * 128 + cc] = a0; red[(kq * 3 + 1) * 128 + cc] = a1; red[(kq * 3 + 2) * 128 + cc] = a2;
        __syncthreads();
        if (tid < 384) { const int var = tid >> 7, c2 = tid & 127; float s = p.in[5][i * 6144 + cb * 128 + c2];
#pragma unroll
            for (int q = 0; q < 4; ++q) s += red[(q * 3 + var) * 128 + c2];
            MOD[(size_t)(i * 3 + var) * 6144 + cb * 128 + c2] = s; }
        __syncthreads();
    }
}

__device__ void tjob(const float* src, int K, int N, int Npad, bf16_t* dst, const float* rs, float mult, unsigned char* ldsg) {
    float* tile = (float*)ldsg;
    const int tid = ltid(), ntk = K / 64, ntn = Npad / 64;
    for (int t = blockIdx.x; t < ntk * ntn; t += gridDim.x) {
        const int tk = t % ntk, tn = t / ntk;
        const int nl = tid & 63, kl0 = tid >> 6;
#pragma unroll
        for (int j = 0; j < 8; ++j) { const int kl = kl0 + 8 * j, k = tk * 64 + kl, n = tn * 64 + nl;
            float v = n < N ? src[(size_t)k * N + n] : 0.f; if (rs) v *= rs[k]; tile[kl * 65 + nl] = v * mult; }
        __syncthreads();
        const int nl2 = tid >> 3, kc = tid & 7;
        u32x4 o;
#pragma unroll
        for (int e = 0; e < 4; ++e) o[e] = pk2(tile[(kc * 8 + 2 * e) * 65 + nl2], tile[(kc * 8 + 2 * e + 1) * 65 + nl2]);
        *(u32x4*)(dst + (size_t)(tn * 64 + nl2) * K + tk * 64 + kc * 8) = o;
        __syncthreads();
    }
}
__device__ void phase_weights(const Params& p, int i, unsigned char* ldsg) {
    unsigned char* ws = p.ws; const int j = i >> 1;
    if (!(i & 1)) {
        tjob(p.in[10] + (size_t)j * 1024 * 1696, 1024, 1696, 1792, (bf16_t*)(ws + OFF_WIN), nullptr, 1.f, ldsg);
        tjob(p.in[12] + (size_t)j * 384 * 768, 384, 768, 768, (bf16_t*)(ws + OFF_WUQ), p.in[11] + j * 384, 0.10206207262f * 1.44269504089f, ldsg);
        tjob(p.in[14] + (size_t)j * 256 * 1024, 256, 1024, 1024, (bf16_t*)(ws + OFF_WUKV), p.in[13] + j * 256, 1.f, ldsg);
        tjob(p.in[18] + (size_t)j * 1024 * 1024, 1024, 1024, 1024, (bf16_t*)(ws + OFF_WOUT), nullptr, 1.f, ldsg);
        bf16_t* wcm = (bf16_t*)(ws + OFF_WCM); const float* src = p.in[16] + (size_t)j * 65536;
        for (int e = blockIdx.x * 512 + ltid(); e < 65536; e += gridDim.x * 512) wcm[e] = f2bf(src[e]);
    } else {
        tjob(p.in[19] + (size_t)j * 1024 * 3104, 1024, 3104, 3328, (bf16_t*)(ws + OFF_WIN), nullptr, 1.f, ldsg);
        tjob(p.in[25] + (size_t)j * 1024 * 1024, 1024, 1024, 1024, (bf16_t*)(ws + OFF_WOUT), nullptr, 1.f, ldsg);
    }
    tjob(p.in[8] + (size_t)i * 1024 * 4096, 1024, 4096, 4096, (bf16_t*)(ws + OFF_W1), nullptr, 1.f, ldsg);
    tjob(p.in[9] + (size_t)i * 4096 * 1024, 4096, 1024, 1024, (bf16_t*)(ws + OFF_W2), nullptr, 1.f, ldsg);
}

__device__ void phase_norm(const float* xl, const float* xc, const float* g, const float* mod  , int shift_i, int scale_i, bf16_t* H,
                           int nrows, const float* part, int npart, const float* pgate, float* xc_out) {
    const int lane = ltid() & 63, gw = blockIdx.x * 8 + (ltid() >> 6), nw = gridDim.x * 8;
    for (int row = gw; row < nrows; row += nw) {
        const float* src = row < RL ? xl + (size_t)row * DM : xc + (size_t)(row - RL) * DM;
        const int var = row < 16384 ? 0 : (row < RL ? 1 : 2);
        const float* sh = mod + var * 6144 + shift_i * 1024; const float* sc = mod + var * 6144 + scale_i * 1024;
        f32x4 x[4]; float ss = 0.f;
#pragma unroll
        for (int q = 0; q < 4; ++q) x[q] = *(const f32x4*)(src + q * 256 + lane * 4);
        if (row >= RL && part) {
#pragma unroll
            for (int q = 0; q < 4; ++q) { const int c = q * 256 + lane * 4;
                f32x4 acc = {0.f, 0.f, 0.f, 0.f};
                for (int kp = 0; kp < npart; ++kp) acc += *(const f32x4*)(part + ((size_t)kp * 512 + (row - RL)) * DM + c);
                x[q] += *(const f32x4*)(pgate + c) * acc;
                *(f32x4*)(xc_out + (size_t)(row - RL) * DM + c) = x[q]; }
        }
#pragma unroll
        for (int q = 0; q < 4; ++q) ss += x[q][0] * x[q][0] + x[q][1] * x[q][1] + x[q][2] * x[q][2] + x[q][3] * x[q][3];
        ss = wsum(ss);
        const float rstd = rsqrtf(ss * (1.f / 1024.f) + 1e-6f);
#pragma unroll
        for (int q = 0; q < 4; ++q) { const int c = q * 256 + lane * 4;
            const f32x4 gg = *(const f32x4*)(g + c), s1 = *(const f32x4*)(sc + c), s0 = *(const f32x4*)(sh + c);
            float o[4];
#pragma unroll
            for (int e = 0; e < 4; ++e) o[e] = x[q][e] * rstd * gg[e] * (1.f + s1[e]) + s0[e];
            const u32x2 pk = {pk2(o[0], o[1]), pk2(o[2], o[3])};
            *(u32x2*)(H + (size_t)row * DM + c) = pk; }
    }
}
__device__ void phase_final(const float* g, float* X) {
    const int lane = ltid() & 63, gw = blockIdx.x * 8 + (ltid() >> 6), nw = gridDim.x * 8;
    for (int row = gw; row < RL; row += nw) {
        float* src = X + (size_t)row * DM;
        f32x4 x[4]; float ss = 0.f;
#pragma unroll
        for (int q = 0; q < 4; ++q) { x[q] = *(const f32x4*)(src + q * 256 + lane * 4); ss += x[q][0] * x[q][0] + x[q][1] * x[q][1] + x[q][2] * x[q][2] + x[q][3] * x[q][3]; }
        ss = wsum(ss);
        const float rstd = rsqrtf(ss * (1.f / 1024.f) + 1e-6f);
#pragma unroll
        for (int q = 0; q < 4; ++q) { const int c = q * 256 + lane * 4; const f32x4 gg = *(const f32x4*)(g + c); *(f32x4*)(src + c) = x[q] * rstd * gg; }
    }
}

__device__ void phase_even_prep(const Params& p, int j, unsigned char* ldsg) {
    unsigned char* ws = p.ws;
    const bf16_t* P = (const bf16_t*)(ws + OFF_BIG);
    float* RSQ = (float*)(ws + OFF_RSQ); float* RSKV = (float*)(ws + OFF_RSKV);
    bf16_t* KR = (bf16_t*)(ws + OFF_KR); bf16_t* MIX = (bf16_t*)(ws + OFF_MIX);
    const int tid = ltid(), lane = tid & 63, w = tid >> 6, l32 = lane & 31, hh = lane >> 5;
    {
        const int gw = blockIdx.x * 8 + w, nw = gridDim.x * 8;
        for (int row = gw; row < R; row += nw) {
            const bf16_t* pr = P + (size_t)row * LDPE;
            float ss = 0.f;
#pragma unroll
            for (int q = 0; q < 3; ++q) { const unsigned u = *(const unsigned*)(pr + 2 * lane + 128 * q); const float a = bflo(u), b = bfhi(u); ss += a * a + b * b; }
            ss = wsum(ss);
            const u32x2 u2 = *(const u32x2*)(pr + 384 + 4 * lane);
            float s2 = bflo(u2[0]) * bflo(u2[0]) + bfhi(u2[0]) * bfhi(u2[0]) + bflo(u2[1]) * bflo(u2[1]) + bfhi(u2[1]) * bfhi(u2[1]);
            s2 = wsum(s2);
            if (lane == 0) { RSQ[row] = rsqrtf(ss * (1.f / 384.f) + 1e-6f); RSKV[row] = rsqrtf(s2 * (1.f / 256.f) + 1e-6f); }
            const float x = bf2f(pr[640 + l32]); const float y = __shfl_xor(x, 8);
            float o = x;
            if (row < RL) { const int l = row & 16383; const float pos = (float)(l32 < 16 ? (l >> 6) : (l & 63));
                float s, c; sincos_red(pos * rope_inv(l32 & 7), s, c);
                o = (l32 & 8) ? x * c + y * s : x * c - y * s; }
            if (lane < 32) KR[(size_t)row * 32 + lane] = f2bf(o);
        }
    }
    LAS unsigned char* lds = (LAS unsigned char*)ldsg;
    const bf16_t* WCM = (const bf16_t*)(ws + OFF_WCM);
    const float* cmn = p.in[15] + j * 128; const float* bs = p.in[17] + j * 512;
    for (int item = blockIdx.x; item < 1040; item += gridDim.x) {
        const int n = item >> 2, g = item & 3, r0 = n * 128;
        {
            const int s = tid >> 2, cq = tid & 3;
            const bf16_t* src = P + (size_t)(r0 + s) * LDPE + 1184 + g * 128 + cq * 32;
            float v[32]; float ss = 0.f;
#pragma unroll
            for (int q = 0; q < 4; ++q) { const u32x4 u = *(const u32x4*)(src + q * 8);
#pragma unroll
                for (int e = 0; e < 4; ++e) { const float a = gelu_t(bflo(u[e])), b = gelu_t(bfhi(u[e])); v[q * 8 + 2 * e] = a; v[q * 8 + 2 * e + 1] = b; ss += a * a + b * b; } }
            ss += __shfl_xor(ss, 1); ss += __shfl_xor(ss, 2);
            const float rstd = rsqrtf(ss * (1.f / 128.f) + 1e-6f);
#pragma unroll
            for (int q = 0; q < 4; ++q) { u32x4 o;
#pragma unroll
                for (int e = 0; e < 4; ++e) { const int c = cq * 32 + q * 8 + 2 * e; o[e] = pk2(v[q * 8 + 2 * e] * rstd * cmn[c], v[q * 8 + 2 * e + 1] * rstd * cmn[c + 1]); }
                *(LAS u32x4*)(lds + s * 272 + (cq * 32 + q * 8) * 2) = o; }
        }
        __syncthreads();
        const int tt = w >> 1, cp = (w & 1) * 2;
        f32x16 acc[2];
#pragma unroll
        for (int e = 0; e < 16; ++e) { acc[0][e] = 0.f; acc[1][e] = 0.f; }
#pragma unroll
        for (int ks = 0; ks < 8; ++ks) {
            const bf16x8 a = *(const bf16x8*)(WCM + g * 16384 + (32 * tt + l32) * 128 + 16 * ks + 8 * hh);
#pragma unroll
            for (int ct = 0; ct < 2; ++ct) { const bf16x8 b = tr_nat(lds, 272, 16 * ks, 32 * (cp + ct), lane); acc[ct] = MFMA32(a, b, acc[ct]); }
        }
#pragma unroll
        for (int ct = 0; ct < 2; ++ct)
#pragma unroll
            for (int i = 0; i < 16; ++i) {
                const int t = 32 * tt + (i >> 2) * 8 + 4 * hh + (i & 3), c = 32 * (cp + ct) + l32;
                const float val = acc[ct][i] + bs[g * 128 + t];
                const float u = gelu_t(bf2f(P[(size_t)(r0 + t) * LDPE + 672 + g * 128 + c]));
                MIX[(size_t)(r0 + t) * DM + 512 + g * 128 + c] = f2bf(u * val);
            }
        __syncthreads();
    }
}

__device__ void phase_kmax(const Params& p, unsigned char* ldsg) {
    unsigned char* ws = p.ws;
    const bf16_t* KV = (const bf16_t*)(ws + OFF_KV); const bf16_t* KR = (const bf16_t*)(ws + OFF_KR);
    float* KMS = (float*)(ws + OFF_KMS);
    float* red = (float*)ldsg;
    const int tid = ltid(), lane = tid & 63, w = tid >> 6, h = lane >> 3, jj = lane & 7;
    float mx0 = 0.f, mx1 = 0.f;
    for (int row = blockIdx.x * 8 + w; row < R; row += gridDim.x * 8) {
        const u32x4 a = *(const u32x4*)(KV + (size_t)row * 1024 + h * 128 + jj * 8);
        const u32x4 r = *(const u32x4*)(KR + (size_t)row * 32 + (jj & 3) * 8);
        float ss = 0.f, sr = 0.f;
#pragma unroll
        for (int e = 0; e < 4; ++e) { ss += bflo(a[e]) * bflo(a[e]) + bfhi(a[e]) * bfhi(a[e]); sr += bflo(r[e]) * bflo(r[e]) + bfhi(r[e]) * bfhi(r[e]); }
        ss += 0.5f * sr;
        ss += __shfl_xor(ss, 1); ss += __shfl_xor(ss, 2); ss += __shfl_xor(ss, 4);
        const int b = row < 16384 ? 0 : (row < RL ? 1 : ((row - RL) >> 8));
        if (b == 0) mx0 = fmaxf(mx0, ss); else mx1 = fmaxf(mx1, ss);
    }
    if (jj == 0) { red[w * 16 + h] = mx0; red[w * 16 + 8 + h] = mx1; }
    __syncthreads();
    if (tid < 16) { float m = red[tid];
#pragma unroll
        for (int q = 1; q < 8; ++q) m = fmaxf(m, red[q * 16 + tid]);
        KMS[blockIdx.x * 16 + tid] = m; }
    __syncthreads();
}

__device__ void phase_attn(const Params& p, unsigned char* ldsg) {
    unsigned char* ws = p.ws;
    const bf16_t* Q = (const bf16_t*)(ws + OFF_Q); const bf16_t* KV = (const bf16_t*)(ws + OFF_KV); const bf16_t* KR = (const bf16_t*)(ws + OFF_KR);
    bf16_t* MIX = (bf16_t*)(ws + OFF_MIX);
    LAS unsigned char* lds = (LAS unsigned char*)ldsg;
    const int tid = ltid(), lane = tid & 63, w = tid >> 6, l32 = lane & 31, hh = lane >> 5;
    constexpr int KROW = 208, VROW = 192, KBUF = 64 * KROW, VBUF = 64 * VROW, VBASE = 4 * KBUF;
    for (int it = blockIdx.x; it < 1040; it += gridDim.x) {
        int b, h, q0row, nkt; bool isctx;
        if (it < 1024) { h = it & 7; const int rest = it >> 3; b = rest >> 6; q0row = b * 16384 + (rest & 63) * 256; nkt = 260; isctx = false; }
        else { const int e = it - 1024; b = e >> 3; h = e & 7; q0row = RL + b * 256; nkt = 4; isctx = true; }
        const int qrow = q0row + w * 32 + l32;
        const bf16_t* qp = Q + (size_t)qrow * 768 + h * 96;
        bf16x8 qf[6];
#pragma unroll
        for (int s = 0; s < 4; ++s) qf[s] = *(const bf16x8*)(qp + 16 * s + 8 * hh);
#pragma unroll
        for (int s = 4; s < 6; ++s) {
            const bf16x8 own = *(const bf16x8*)(qp + 16 * s + 8 * hh);
            const bf16x8 oth = *(const bf16x8*)(qp + 16 * s + 8 * (1 - hh));
            if (!isctx) {
                const int l = qrow & 16383; const float pos = (float)(s == 4 ? (l >> 6) : (l & 63));
                float r[8];
#pragma unroll
                for (int jj = 0; jj < 8; ++jj) { float sn, cs; sincos_red(pos * rope_inv(jj), sn, cs);
                    const float x = bf2f((bf16_t)own[jj]), y = bf2f((bf16_t)oth[jj]); r[jj] = hh ? x * cs + y * sn : x * cs - y * sn; }
                qf[s] = pack8(r[0], r[1], r[2], r[3], r[4], r[5], r[6], r[7]);
            } else qf[s] = own;
        }
        float negm;
        {
            float qs = 0.f;
#pragma unroll
            for (int s = 0; s < 6; ++s)
#pragma unroll
                for (int e = 0; e < 8; ++e) { const float x = bf2f((bf16_t)qf[s][e]); qs += x * x; }
            qs += __shfl_xor(qs, 32);
            const float* KMS = (const float*)(ws + OFF_KMS) + b * 8 + h;
            float km = 0.f;
            for (int q = lane; q < (int)gridDim.x; q += 64) km = fmaxf(km, KMS[q * 16]);
#pragma unroll
            for (int o2 = 32; o2 >= 1; o2 >>= 1) km = fmaxf(km, __shfl_xor(km, o2));
            negm = -sqrtf(qs * km) * 1.0001f - 1e-3f;
        }
        const bf16_t* kp[2]; int kst[2]; int kdo[2]; bool kv_[2];
#pragma unroll
        for (int pp = 0; pp < 2; ++pp) {
            int c = tid + 512 * pp; if (c >= 768) c -= 512; kv_[pp] = true; const int key = c / 12, part = c % 12;
            if (part < 8) { kp[pp] = KV + (size_t)key * 1024 + h * 128 + part * 8; kst[pp] = 1024; }
            else { kp[pp] = KR + (size_t)key * 32 + (part - 8) * 8; kst[pp] = 32; }
            kdo[pp] = key * KROW + part * 16;
        }
        const bf16_t* vp = KV + (size_t)(tid >> 3) * 1024 + h * 128 + 64 + (tid & 7) * 8; const int vdo = (tid >> 3) * VROW + (tid & 7) * 16;
        auto rowbase = [&](int kt) -> int { return isctx ? (RL + b * 256 + kt * 64) : (kt < 256 ? b * 16384 + kt * 64 : RL + b * 256 + (kt - 256) * 64); };
        u32x4 prk[2], prv;
        auto loadK = [&](int kt) { const int rb = rowbase(kt);
#pragma unroll
            for (int pp = 0; pp < 2; ++pp) prk[pp] = *(const u32x4*)(kp[pp] + (size_t)rb * kst[pp]); };
        auto storeK = [&](int buf) {
#pragma unroll
            for (int pp = 0; pp < 2; ++pp) *(LAS u32x4*)(lds + buf * KBUF + kdo[pp]) = prk[pp]; };
        auto loadV = [&](int kt) { prv = *(const u32x4*)(vp + (size_t)rowbase(kt) * 1024); };
        auto storeV = [&](int buf) { *(LAS u32x4*)(lds + VBASE + buf * VBUF + vdo) = prv; };
        f32x16 pA[2], pB[2];
        f32x16 o[2];
#pragma unroll
        for (int e = 0; e < 16; ++e) { o[0][e] = 0.f; o[1][e] = 0.f; }
        float lsum = 0.f;
        auto qk = [&](int buf, f32x16 (&st)[2]) {
            LAS unsigned char* kb = lds + buf * KBUF;
#pragma unroll
            for (int e = 0; e < 16; ++e) { st[0][e] = negm; st[1][e] = negm; }
#pragma unroll
            for (int half = 0; half < 2; ++half) {
                bf16x8 kf[6];
#pragma unroll
                for (int s = 0; s < 3; ++s) {
                    kf[2 * s] = *(const LAS bf16x8*)(kb + l32 * KROW + (16 * (3 * half + s) + 8 * hh) * 2);
                    kf[2 * s + 1] = *(const LAS bf16x8*)(kb + (32 + l32) * KROW + (16 * (3 * half + s) + 8 * hh) * 2);
                }
                __builtin_amdgcn_sched_barrier(0);
#pragma unroll
                for (int s = 0; s < 3; ++s) { st[0] = MFMA32(kf[2 * s], qf[3 * half + s], st[0]); st[1] = MFMA32(kf[2 * s + 1], qf[3 * half + s], st[1]); }
            }
        };
        auto partialSM = [&](f32x16 (&pp)[2]) {
#pragma unroll
            for (int e = 0; e < 16; ++e) pp[0][e] = __builtin_amdgcn_exp2f(pp[0][e]);
        };
        bf16x8 pa[4];
        auto finishSM = [&](f32x16 (&pp)[2]) {
#pragma unroll
            for (int e = 0; e < 16; ++e) pp[1][e] = __builtin_amdgcn_exp2f(pp[1][e]);
            float ps = 0.f;
#pragma unroll
            for (int e = 0; e < 16; ++e) ps += pp[0][e] + pp[1][e];
            lsum += ps;
            pa[0] = pack8(pp[0][0], pp[0][1], pp[0][2], pp[0][3], pp[0][4], pp[0][5], pp[0][6], pp[0][7]);
            pa[1] = pack8(pp[0][8], pp[0][9], pp[0][10], pp[0][11], pp[0][12], pp[0][13], pp[0][14], pp[0][15]);
            pa[2] = pack8(pp[1][0], pp[1][1], pp[1][2], pp[1][3], pp[1][4], pp[1][5], pp[1][6], pp[1][7]);
            pa[3] = pack8(pp[1][8], pp[1][9], pp[1][10], pp[1][11], pp[1][12], pp[1][13], pp[1][14], pp[1][15]);
        };
        auto pv = [&](int buf) {
            LAS unsigned char* vb = lds + VBASE + buf * VBUF;
#pragma unroll
            for (int vt = 0; vt < 2; ++vt) {
                bf16x8 vf[4];
#pragma unroll
                for (int q = 0; q < 4; ++q) vf[q] = tr_perm(vb, VROW, 16 * q, 32 * vt, lane);
                __builtin_amdgcn_sched_barrier(0);
#pragma unroll
                for (int q = 0; q < 4; ++q) o[vt] = MFMA32(vf[q], pa[q], o[vt]);
            }
        };
        auto step = [&](int j, f32x16 (&pc)[2], f32x16 (&pn)[2], bool bar) {
            const int jk = j + 3 < nkt ? j + 3 : nkt - 1, jv = j + 2 < nkt ? j + 2 : nkt - 1;
            __builtin_amdgcn_sched_barrier(0);
            qk((j + 1) & 3, pn);
            finishSM(pc);
            __builtin_amdgcn_sched_barrier(0);
            loadK(jk); loadV(jv);
            __builtin_amdgcn_sched_barrier(0);
            pv(j & 3);
            partialSM(pn);
            __builtin_amdgcn_sched_barrier(0);
            storeK((j + 3) & 3); storeV((j + 2) & 3);
            if (bar) __syncthreads();
        };
        loadK(0); loadV(0); storeK(0); storeV(0);
        loadK(1); loadV(1); storeK(1); storeV(1);
        loadK(2); storeK(2);
        __syncthreads();
        qk(0, pA); partialSM(pA);
        __syncthreads();
        for (int kt = 0; kt + 2 < nkt; kt += 2) {
            step(kt, pA, pB, false);
            step(kt + 1, pB, pA, true);
        }
        step(nkt - 2, pA, pB, true);
        finishSM(pB);
        pv((nkt - 1) & 3);
        __syncthreads();
        lsum += __shfl_xor(lsum, 32);
        const float inv = 1.f / lsum;
        bf16_t* op = MIX + (size_t)qrow * DM + h * 64;
#pragma unroll
        for (int vt = 0; vt < 2; ++vt)
#pragma unroll
            for (int g4 = 0; g4 < 4; ++g4) {
                const u32x2 pk = {pk2(o[vt][4 * g4] * inv, o[vt][4 * g4 + 1] * inv), pk2(o[vt][4 * g4 + 2] * inv, o[vt][4 * g4 + 3] * inv)};
                *(u32x2*)(op + 32 * vt + 8 * g4 + 4 * hh) = pk;
            }
    }
}

__device__ void phase_gla_prep(const Params& p, int j, unsigned char* ldsg) {
    unsigned char* ws = p.ws;
    const bf16_t* P = (const bf16_t*)(ws + OFF_BIG);
    bf16_t* QTF = (bf16_t*)(ws + OFF_QTF); bf16_t* KTF = (bf16_t*)(ws + OFF_KTF); bf16_t* QTB = (bf16_t*)(ws + OFF_QTB); bf16_t* KTB = (bf16_t*)(ws + OFF_KTB);
    float* DECF = (float*)(ws + OFF_DECF); float* DECB = (float*)(ws + OFF_DECB);
    float* zl = (float*)ldsg;
    float* seg = zl + 2048;
    const int tid = ltid();
    const float* wgf = p.in[20] + (size_t)j * 16 * 512; const float* wgb = p.in[22] + (size_t)j * 16 * 512;
    const float* bgf = p.in[21] + j * 512; const float* bgb = p.in[23] + j * 512;
    for (int item = blockIdx.x; item < 2080; item += gridDim.x) {
        const int ck = item >> 2, h = item & 3, r0 = ck * 64;
        { const int t = tid >> 3, j0 = (tid & 7) * 4; const u32x2 u = *(const u32x2*)(P + (size_t)(r0 + t) * LDPO + 1536 + j0);
          zl[t * 32 + j0] = bflo(u[0]); zl[t * 32 + j0 + 1] = bfhi(u[0]); zl[t * 32 + j0 + 2] = bflo(u[1]); zl[t * 32 + j0 + 3] = bfhi(u[1]); }
        __syncthreads();
        const int d = tid & 127, tq = tid >> 7, hd = h * 128 + d;
        float wf[16], wb[16];
#pragma unroll
        for (int q = 0; q < 16; ++q) { wf[q] = wgf[q * 512 + hd]; wb[q] = wgb[q * 512 + hd]; }
        const float bf_ = bgf[hd], bb_ = bgb[hd];
        float lf[16], lb[16];
#pragma unroll
        for (int i = 0; i < 16; ++i) {
            const float* zr = zl + (tq * 16 + i) * 32;
            float gf = bf_, gb = bb_;
#pragma unroll
            for (int q = 0; q < 16; ++q) { gf = fmaf(zr[q], wf[q], gf); gb = fmaf(zr[16 + q], wb[q], gb); }
            lf[i] = (fminf(gf, 0.f) - __logf(1.f + __expf(-fabsf(gf)))) * 0.0625f;
            lb[i] = (fminf(gb, 0.f) - __logf(1.f + __expf(-fabsf(gb)))) * 0.0625f;
        }
        float run = 0.f;
#pragma unroll
        for (int i = 0; i < 16; ++i) { run += lf[i]; lf[i] = run; }
        const float segF = run; run = 0.f;
#pragma unroll
        for (int i = 15; i >= 0; --i) { run += lb[i]; lb[i] = run; }
        const float segB = run;
        seg[tq * 128 + d] = segF; seg[512 + tq * 128 + d] = segB;
        __syncthreads();
        float offF = 0.f, totF = 0.f, offB = 0.f, totB = 0.f;
#pragma unroll
        for (int q = 0; q < 4; ++q) { const float a = seg[q * 128 + d], b2 = seg[512 + q * 128 + d]; totF += a; totB += b2; if (q < tq) offF += a; if (q > tq) offB += b2; }
#pragma unroll
        for (int i = 0; i < 16; ++i) {
            const size_t row = (size_t)(r0 + tq * 16 + i);
            const float q = bf2f(P[row * LDPO + 1568 + hd]) * 0.08838834764f, k = bf2f(P[row * LDPO + hd]);
            const float cf = lf[i] + offF, cb = lb[i] + offB;
            QTF[row * 512 + hd] = f2bf(q * __expf(cf)); KTF[row * 512 + hd] = f2bf(k * __expf(-cf));
            QTB[row * 512 + hd] = f2bf(q * __expf(cb)); KTB[row * 512 + hd] = f2bf(k * __expf(-cb));
        }
        if (tq == 0) { DECF[(size_t)(ck * 4 + h) * 128 + d] = __expf(totF); DECB[(size_t)(ck * 4 + h) * 128 + d] = __expf(totB); }
        __syncthreads();
    }
}

constexpr int NGRP = 32, NSLOT = NGRP + 1;
__device__ __forceinline__ int gstart(int g) { return g < 27 ? 8 * g : (g < 31 ? 216 + 9 * (g - 27) : 252); }
__device__ __forceinline__ int gsize(int g) { return g < 27 ? 8 : (g < 31 ? 9 : 4); }
constexpr int G_QOFF = 0, G_KOFF = 17408, G_VOFF = 34816, G_DOFF = 68608, G_BUF = 69120, G_SSQ = 2 * G_BUF;
template <bool OUT>
__device__ __forceinline__ void gla_seq(const Params& p, int j, LAS unsigned char* lds, int b, int h, int dir, bool ctx, int g, f32x16 (&S)[4], float* gdout) {
    unsigned char* ws = p.ws;
    const bf16_t* P = (const bf16_t*)(ws + OFF_BIG);
    const bf16_t* QT = (const bf16_t*)(ws + (dir ? OFF_QTB : OFF_QTF)); const bf16_t* KT = (const bf16_t*)(ws + (dir ? OFF_KTB : OFF_KTF));
    const float* DEC = (const float*)(ws + (dir ? OFF_DECB : OFF_DECF));
    bf16_t* MIX = (bf16_t*)(ws + OFF_MIX);
    const float* onorm = p.in[24] + j * 256;
    const int tid = ltid(), lane = tid & 63, w = tid >> 6, l32 = lane & 31, hh = lane >> 5;
    const int nsteps = ctx ? 4 : gsize(g), g0 = gstart(g);
    auto chunk_of = [&](int i) -> int { const int c = ctx ? (dir ? 3 - i : i) : (dir ? g0 + nsteps - 1 - i : g0 + i); return ctx ? 512 + b * 4 + c : b * 256 + c; };
    u32x4 pq[2], pk[2], pv[4], pd;
    auto gload = [&](int ck, int tid) {
        const size_t rb = (size_t)ck * 64;
#pragma unroll
        for (int pp = 0; pp < 2; ++pp) { const int c = tid + 512 * pp, row = c >> 4, cc = c & 15;
            if (OUT) pq[pp] = *(const u32x4*)(QT + (rb + row) * 512 + h * 128 + cc * 8);
            pk[pp] = *(const u32x4*)(KT + (rb + row) * 512 + h * 128 + cc * 8); }
#pragma unroll
        for (int pp = 0; pp < 4; ++pp) { const int c = tid + 512 * pp, row = c >> 5, cc = c & 31; pv[pp] = *(const u32x4*)(P + (rb + row) * LDPO + 512 + h * 256 + cc * 8); }
        if (tid < 32) pd = *(const u32x4*)(DEC + (size_t)(ck * 4 + h) * 128 + tid * 4);
    };
    auto lstore = [&](LAS unsigned char* bb, int tid) {
#pragma unroll
        for (int pp = 0; pp < 2; ++pp) { const int c = tid + 512 * pp, row = c >> 4, cc = c & 15;
            if (OUT) *(LAS u32x4*)(bb + G_QOFF + row * 272 + cc * 16) = pq[pp];
            *(LAS u32x4*)(bb + G_KOFF + row * 272 + cc * 16) = pk[pp]; }
#pragma unroll
        for (int pp = 0; pp < 4; ++pp) { const int c = tid + 512 * pp, row = c >> 5, cc = c & 31; *(LAS u32x4*)(bb + G_VOFF + row * 528 + cc * 16) = pv[pp]; }
        if (tid < 32) *(LAS u32x4*)(bb + G_DOFF + tid * 16) = pd;
    };
    float gd = 1.f;
    gload(chunk_of(0), tid); lstore(lds, tid);
    __syncthreads();
    for (int i = 0; i < nsteps; ++i) {
        const bool more = i + 1 < nsteps;
        const int ck = chunk_of(i);
        const int tid2 = ltid();
        if (more) gload(chunk_of(i + 1), tid2);
        LAS unsigned char* bb = lds + (i & 1) * G_BUF;
        LAS unsigned char* qb = bb + G_QOFF; LAS unsigned char* kb = bb + G_KOFF; LAS unsigned char* vb = bb + G_VOFF;
        const LAS float* dec = (const LAS float*)(bb + G_DOFF);
        if (!OUT) { if (tid < 128) gd *= dec[tid]; }
        if (OUT) {
            f32x16 o[2];
#pragma unroll
            for (int e = 0; e < 16; ++e) { o[0][e] = 0.f; o[1][e] = 0.f; }
#pragma unroll
            for (int st = 0; st < 2; ++st)
#pragma unroll
                for (int tt = 0; tt < 2; ++tt) {
                    if (dir ? (st == 0 && tt == 1) : (st == 1 && tt == 0)) continue;
                    f32x16 am;
#pragma unroll
                    for (int e = 0; e < 16; ++e) am[e] = 0.f;
#pragma unroll
                    for (int ks = 0; ks < 8; ++ks) {
                        const bf16x8 a = *(const LAS bf16x8*)(kb + (32 * st + l32) * 272 + (16 * ks + 8 * hh) * 2);
                        const bf16x8 bq = *(const LAS bf16x8*)(qb + (32 * tt + l32) * 272 + (16 * ks + 8 * hh) * 2);
                        am = MFMA32(a, bq, am);
                    }
                    const int t = 32 * tt + l32;
#pragma unroll
                    for (int e = 0; e < 16; ++e) { const int s = 32 * st + (e >> 2) * 8 + 4 * hh + (e & 3); const bool keep = dir ? (t <= s) : (t >= s); am[e] = keep ? am[e] : 0.f; }
                    const bf16x8 pm0 = pack8(am[0], am[1], am[2], am[3], am[4], am[5], am[6], am[7]);
                    const bf16x8 pm1 = pack8(am[8], am[9], am[10], am[11], am[12], am[13], am[14], am[15]);
                    const bf16x8 a0 = tr_perm(vb, 528, 32 * st, 32 * w, lane);
                    o[tt] = MFMA32(a0, pm0, o[tt]);
                    const bf16x8 a1 = tr_perm(vb, 528, 32 * st + 16, 32 * w, lane);
                    o[tt] = MFMA32(a1, pm1, o[tt]);
                    __builtin_amdgcn_sched_barrier(0);
                }
#pragma unroll
            for (int dt = 0; dt < 4; ++dt)
#pragma unroll
                for (int ks2 = 0; ks2 < 2; ++ks2) {
                    const bf16x8 a = pack8(S[dt][8 * ks2], S[dt][8 * ks2 + 1], S[dt][8 * ks2 + 2], S[dt][8 * ks2 + 3], S[dt][8 * ks2 + 4], S[dt][8 * ks2 + 5], S[dt][8 * ks2 + 6], S[dt][8 * ks2 + 7]);
#pragma unroll
                    for (int tt = 0; tt < 2; ++tt) {
                        LAS unsigned char* qa = qb + (32 * tt + l32) * 272 + (32 * dt + 16 * ks2 + 4 * hh) * 2;
                        const bf16x4 x = *(const LAS bf16x4*)qa, y = *(const LAS bf16x4*)(qa + 16);
                        const bf16x8 bq = __builtin_shufflevector(x, y, 0, 1, 2, 3, 4, 5, 6, 7);
                        o[tt] = MFMA32(a, bq, o[tt]);
                    }
                    __builtin_amdgcn_sched_barrier(0);
                }
            {
                LAS unsigned char* stg = lds + ((i + 1) & 1) * G_BUF + G_VOFF;
#pragma unroll
                for (int tt = 0; tt < 2; ++tt)
#pragma unroll
                    for (int g4 = 0; g4 < 4; ++g4) {
                        const u32x2 pkv = {pk2(o[tt][4 * g4], o[tt][4 * g4 + 1]), pk2(o[tt][4 * g4 + 2], o[tt][4 * g4 + 3])};
                        *(LAS u32x2*)(stg + (32 * tt + l32) * 528 + (32 * w + 8 * g4 + 4 * hh) * 2) = pkv;
                    }
                __syncthreads();
                const size_t rbase = (size_t)ck * 64;
                const int tq = tid2 >> 5, cc = tid2 & 31;
                if (dir == 0) {
#pragma unroll
                    for (int pp = 0; pp < 4; ++pp) {
                        const int t = tq + 16 * pp;
                        *(u32x4*)(MIX + (rbase + t) * DM + h * 256 + cc * 8) = *(const LAS u32x4*)(stg + t * 528 + cc * 16);
                    }
                } else {
                    u32x4 of[4], rg[4];
#pragma unroll
                    for (int pp = 0; pp < 4; ++pp) {
                        const int t = tq + 16 * pp;
                        of[pp] = *(const u32x4*)(MIX + (rbase + t) * DM + h * 256 + cc * 8);
                        rg[pp] = *(const u32x4*)(P + (rbase + t) * LDPO + 2080 + h * 256 + cc * 8);
                    }
                    const f32x4 gn0 = *(const f32x4*)(onorm + cc * 8), gn1 = *(const f32x4*)(onorm + cc * 8 + 4);
#pragma unroll
                    for (int pp = 0; pp < 4; ++pp) {
                        const int t = tq + 16 * pp;
                        const u32x4 ob = *(const LAS u32x4*)(stg + t * 528 + cc * 16);
                        float v[8]; float ss = 0.f;
#pragma unroll
                        for (int e = 0; e < 4; ++e) { v[2 * e] = bflo(ob[e]) + bflo(of[pp][e]); v[2 * e + 1] = bfhi(ob[e]) + bfhi(of[pp][e]); ss += v[2 * e] * v[2 * e] + v[2 * e + 1] * v[2 * e + 1]; }
#pragma unroll
                        for (int o2 = 16; o2 >= 1; o2 >>= 1) ss += __shfl_xor(ss, o2);
                        const float rstd = rsqrtf(ss * (1.f / 256.f) + 1e-6f);
                        u32x4 ov;
#pragma unroll
                        for (int e = 0; e < 4; ++e) {
                            const float g0 = e < 2 ? gn0[2 * e] : gn1[2 * e - 4], g1 = e < 2 ? gn0[2 * e + 1] : gn1[2 * e - 3];
                            ov[e] = pk2(v[2 * e] * rstd * g0 * silu_f(bflo(rg[pp][e])), v[2 * e + 1] * rstd * g1 * silu_f(bfhi(rg[pp][e])));
                        }
                        *(u32x4*)(MIX + (rbase + t) * DM + h * 256 + cc * 8) = ov;
                    }
                }
            }
        }
        if (OUT) { __builtin_amdgcn_sched_barrier(0); }
#pragma unroll
        for (int ks = 0; ks < 4; ++ks) {
            const bf16x8 bv = tr_nat(vb, 528, 16 * ks, 32 * w, lane);
#pragma unroll
            for (int dt = 0; dt < 4; ++dt) { const bf16x8 a = tr_nat(kb, 272, 16 * ks, 32 * dt, lane); S[dt] = MFMA32(a, bv, S[dt]); }
        }
#pragma unroll
        for (int dt = 0; dt < 4; ++dt)
#pragma unroll
            for (int g4 = 0; g4 < 4; ++g4) { const f32x4 dv = *(const LAS f32x4*)(dec + 32 * dt + 8 * g4 + 4 * hh);
#pragma unroll
                for (int e = 0; e < 4; ++e) S[dt][4 * g4 + e] *= dv[e]; }
        if (OUT) __syncthreads();
        if (more) lstore(lds + ((i + 1) & 1) * G_BUF, tid2);
        __syncthreads();
    }
    if (!OUT) { if (tid < 128) gdout[tid] = gd; }
}
__device__ __forceinline__ void s_zero(f32x16 (&S)[4]) {
#pragma unroll
    for (int dt = 0; dt < 4; ++dt)
#pragma unroll
        for (int e = 0; e < 16; ++e) S[dt][e] = 0.f;
}
__device__ __forceinline__ void s_store(const f32x16 (&S)[4], bf16_t* slot) {
    const int lane = ltid() & 63, w = ltid() >> 6, l32 = lane & 31, hh = lane >> 5;
#pragma unroll
    for (int dt = 0; dt < 4; ++dt)
#pragma unroll
        for (int e = 0; e < 16; ++e) slot[(32 * dt + (e >> 2) * 8 + 4 * hh + (e & 3)) * 256 + 32 * w + l32] = f2bf(S[dt][e]);
}
__device__ __forceinline__ void s_load(f32x16 (&S)[4], const bf16_t* slot) {
    const int lane = ltid() & 63, w = ltid() >> 6, l32 = lane & 31, hh = lane >> 5;
#pragma unroll
    for (int dt = 0; dt < 4; ++dt)
#pragma unroll
        for (int e = 0; e < 16; ++e) S[dt][e] = bf2f(slot[(32 * dt + (e >> 2) * 8 + 4 * hh + (e & 3)) * 256 + 32 * w + l32]);
}
__device__ void phase_gla_a(const Params& p, int j, unsigned char* ldsg) {
    bf16_t* SLOC = (bf16_t*)(p.ws + OFF_SLOC); float* GD = (float*)(p.ws + OFF_GD);
    for (int item = blockIdx.x; item < 16 * NSLOT; item += gridDim.x) {
        const int combo = item < 16 * NGRP ? item / NGRP : item - 16 * NGRP, g = item < 16 * NGRP ? item % NGRP : NGRP;
        const int dir = combo & 1, h = (combo >> 1) & 3, b = combo >> 3, slot = combo * NSLOT + g;
        f32x16 S[4]; s_zero(S);
        gla_seq<false>(p, j, (LAS unsigned char*)ldsg, b, h, dir, g == NGRP, g, S, GD + (size_t)slot * 128);
        s_store(S, SLOC + (size_t)slot * 32768);
    }
}
__device__ void phase_gla_b(const Params& p) {
    bf16_t* SLOC = (bf16_t*)(p.ws + OFF_SLOC); const float* GD = (const float*)(p.ws + OFF_GD);
    for (int e = blockIdx.x * 512 + ltid(); e < 16 * 32768; e += gridDim.x * 512) {
        const int combo = e >> 15, dv = e & 32767, d = dv >> 8, dir = combo & 1, base = combo * NSLOT;
        float S = bf2f(SLOC[(size_t)(base + NGRP) * 32768 + dv]);
        for (int q = 0; q < NGRP; ++q) {
            const int g = dir ? NGRP - 1 - q : q;
            const size_t o = (size_t)(base + g) * 32768 + dv;
            const float tmp = bf2f(SLOC[o]); SLOC[o] = f2bf(S); S = GD[(base + g) * 128 + d] * S + tmp;
        }
    }
}
__device__ void phase_gla_c(const Params& p, int j, unsigned char* ldsg) {
    const bf16_t* SLOC = (const bf16_t*)(p.ws + OFF_SLOC);
    for (int item = blockIdx.x; item < 8 * NSLOT; item += gridDim.x) {
        const int bh = item < 8 * NGRP ? (item & 7) : item - 8 * NGRP, g = item < 8 * NGRP ? NGRP - 1 - (item >> 3) : NGRP;
        const int h = bh & 3, b = bh >> 2;
        f32x16 S[4];
        for (int dir = 0; dir < 2; ++dir) {
            if (g == NGRP) s_zero(S); else s_load(S, SLOC + (size_t)((bh * 2 + dir) * NSLOT + g) * 32768);
            gla_seq<true>(p, j, (LAS unsigned char*)ldsg, b, h, dir, g == NGRP, g, S, nullptr);
        }
    }
}

#define XB_TMO      128
#define XB_XCNT(j)  (256  + 64 * (j))
#define XB_XSUB(j)  (1280 + 64 * (j))
#define XB_XGEN(j)  (2304 + 64 * (j))
#define XB_TOP      3328
#define XB_TOPGEN   3392
#define XCD_BAR_WORDS 3456
#define XB_SPIN_CAP (1u << 18)
__device__ __forceinline__ unsigned xb_ld(unsigned* p)              { return __hip_atomic_load(p, __ATOMIC_RELAXED, __HIP_MEMORY_SCOPE_AGENT); }
__device__ __forceinline__ unsigned xb_add(unsigned* p, unsigned v) { return __hip_atomic_fetch_add(p, v, __ATOMIC_RELAXED, __HIP_MEMORY_SCOPE_AGENT); }
__device__ __forceinline__ unsigned xb_xcc_id() { return (unsigned)__builtin_amdgcn_s_getreg((3 << 11) | 20) & 0xFu; }
#define XB_SPIN(cond, bar) do { unsigned _sp = 0; while (cond) { __builtin_amdgcn_s_sleep(1); \
    if ((++_sp & 255u) == 0u) { if (xb_ld(&(bar)[XB_TMO])) break; if (_sp > XB_SPIN_CAP) { atomicAdd(&(bar)[XB_TMO], 1u); break; } } } } while (0)
struct XcdBarrier { unsigned* bar; unsigned x; volatile LAS unsigned* st; };
__device__ __forceinline__ XcdBarrier xcd_barrier_post(unsigned* bar, volatile LAS unsigned* st) {
    XcdBarrier b; b.bar = bar; b.x = xb_xcc_id(); b.st = st;
    if (threadIdx.x == 0) (void)xb_add(&bar[XB_XCNT(b.x)], 1u);
    return b;
}
__device__ __forceinline__ void xcd_barrier_complete(unsigned* bar, unsigned x, unsigned& nloc, unsigned& nx) {
    const unsigned G = gridDim.x * gridDim.y * gridDim.z;
    unsigned sum, cnt, mine, sp = 0u;
    for (;;) {
        sum = 0u; cnt = 0u; mine = 0u;
#pragma unroll
        for (unsigned j = 0; j < 16; ++j) { const unsigned c = xb_ld(&bar[XB_XCNT(j)]); sum += c; cnt += (c > 0u) ? 1u : 0u; mine = (j == x) ? c : mine; }
        if (sum == G) break;
        __builtin_amdgcn_s_sleep(1);
        if ((++sp & 255u) == 0u) { if (xb_ld(&bar[XB_TMO])) break; if (sp > XB_SPIN_CAP) { atomicAdd(&bar[XB_TMO], 1u); break; } }
    }
    nloc = mine > 0u ? mine : 1u; nx = cnt > 0u ? cnt : 1u;
}
__device__ __forceinline__ void xcd_barrier(const XcdBarrier& b) {
    asm volatile("s_waitcnt vmcnt(0)" ::: "memory");
    __syncthreads();
    if (threadIdx.x == 0) {
        unsigned* bar = b.bar;
        __builtin_amdgcn_s_waitcnt(0);
        unsigned nloc = b.st[0], nx = b.st[1];
        if (nloc == 0u) { xcd_barrier_complete(bar, b.x, nloc, nx); b.st[0] = nloc; b.st[1] = nx; }
        const unsigned old = xb_add(&bar[XB_XSUB(b.x)], 1u);
        const unsigned gen = old / nloc;
        if (old + 1u == (gen + 1u) * nloc) {
            __builtin_amdgcn_fence(__ATOMIC_RELEASE, "agent");
            asm volatile("s_waitcnt vmcnt(0)" ::: "memory");
            const unsigned og = xb_add(&bar[XB_TOP], 1u);
            const unsigned tg = og / nx;
            if (og + 1u == (tg + 1u) * nx) xb_add(&bar[XB_TOPGEN], 1u);
            else XB_SPIN(xb_ld(&bar[XB_TOPGEN]) == tg, bar);
            __builtin_amdgcn_fence(__ATOMIC_ACQUIRE, "agent");
            xb_add(&bar[XB_XGEN(b.x)], 1u);
            asm volatile("s_waitcnt vmcnt(0)" ::: "memory");
        } else {
            XB_SPIN(xb_ld(&bar[XB_XGEN(b.x)]) == gen, bar);
            __builtin_amdgcn_fence(__ATOMIC_ACQUIRE, "agent");
            asm volatile("s_waitcnt vmcnt(0)" ::: "memory");
        }
    }
    __syncthreads();
}
#ifndef PROBE_REP
#define PROBE_REP 0
#endif
#ifndef PHM
#define PHM 0xFFFF
#endif
#define PH(b) if (PHM & (1 << (b)))
enum { K_N1 = 0, K_GIN, K_PREP, K_GQ, K_GKV, K_ATT, K_GPREP, K_GA, K_GB, K_GC, K_GOUT, K_N2, K_GUP, K_GDN, K_COPY, K_NONE, K_KMAX };
__global__ void __launch_bounds__(512, 2) mega(Params p) {
    extern __shared__ __attribute__((aligned(16))) unsigned char ldsg[];
    LAS unsigned char* lds = (LAS unsigned char*)ldsg;
    cg::grid_group grid = cg::this_grid();
    unsigned char* ws = p.ws;
    float* MOD = (float*)(ws + OFF_MOD);
    float* XC = (float*)(ws + OFF_XC);
    bf16_t* H = (bf16_t*)(ws + OFF_H); bf16_t* MIX = (bf16_t*)(ws + OFF_MIX);
    bf16_t* PB = (bf16_t*)(ws + OFF_BIG);
    const bool en_even = p.flags & 1, en_odd = p.flags & 2, en_mlp = p.flags & 4;

    volatile LAS unsigned* xst = (volatile LAS unsigned*)(lds + LDS_BYTES - 16);
    if (threadIdx.x == 0) { xst[0] = 0u; xst[1] = 0u; }
    __syncthreads();
    const XcdBarrier xbar = xcd_barrier_post((unsigned*)(ws + OFF_BAR), xst);
    PH(0) phase_ada(p, ldsg);
    grid.sync();
    for (int step = 0; step < 44; ++step) {
        const int i = step / 11, s = step % 11, j = i >> 1; const bool even = !(i & 1);
        const float* mod = MOD + (size_t)i * 3 * 6144;
        const bool en_mix = even ? en_even : en_odd;
        const bool first = (i == 0) && (s <= 7);
        const float* xl = first ? p.in[0] : p.out; const float* xc = ((i == 0) && (s <= 8)) ? p.in[2] : XC;
        float* PART = (float*)(ws + OFF_PART);
        int kind;
        switch (s) {
            case 0: kind = K_N1; break;
            case 1: kind = K_GIN; break;
            case 2: kind = even ? K_PREP : K_GPREP; break;
            case 3: kind = even ? K_GQ : K_GA; break;
            case 4: kind = even ? K_GKV : K_GB; break;
            case 5: kind = even ? K_KMAX : K_GC; break;
            case 6: kind = even ? K_ATT : K_NONE; break;
            case 7: kind = K_GOUT; break;
            case 8: kind = K_N2; break;
            case 9: kind = K_GUP; break;
            default: kind = K_GDN; break;
        }
        if (s <= 7 && !en_mix) kind = (s == 0) ? K_NONE : ((i == 0 && s == 7) ? K_COPY : K_NONE);
        if (s >= 8 && !en_mlp) kind = K_NONE;
        if (s == 0) { PH(1) phase_weights(p, i, ldsg); }
        if (kind == K_NONE) { if (s == 0) xcd_barrier(xbar); continue; }
        bool gemmB = false, gemmR = false, nosync = false;
        pg8::EpiB EB; EB.O = PB; EB.ldo = 0; EB.rs = nullptr; EB.mode = 0;
        pg8::EpiR ER; ER.xin_l = xl; ER.xin_c = xc; ER.xout_l = p.out; ER.xout_c = XC; ER.gate = mod;
        const bf16_t* gA = H; const bf16_t* gB = (const bf16_t*)(ws + OFF_WIN); int lda = 1024, ldb = 1024, gN = 1024, gK = 1024, gM = R, nP = 0, Kp = 256;
        const int reps = ((p.flags >> (8 + kind)) & 1) ? 2 : 1;
        for (int rep = 0; rep < reps; ++rep) {
        if (rep) __syncthreads();
        switch (kind) {
            case K_N1: PH(2) phase_norm(xl, xc, p.in[6] + i * 1024, mod, 0, 1, H, R, i > 0 ? PART : nullptr, 8, mod - 3 * 6144 + 2 * 6144 + 5 * 1024, XC); break;
            case K_N2: PH(2) phase_norm(xl, xc, p.in[7] + i * 1024, mod, 3, 4, H, i < 3 ? R : RL, PART, 4, mod + 2 * 6144 + 2 * 1024, XC); break;
            case K_GIN: gemmB = true; gN = even ? 1792 : 3328; EB.ldo = gN; break;
            case K_PREP: PH(4) phase_even_prep(p, j, ldsg); break;
            case K_GQ: gemmB = true; nosync = true; gA = PB; lda = LDPE; gB = (const bf16_t*)(ws + OFF_WUQ); ldb = 384; gN = 768; gK = 384; EB.O = (bf16_t*)(ws + OFF_Q); EB.ldo = 768; EB.rs = (const float*)(ws + OFF_RSQ); break;
            case K_GKV: gemmB = true; gA = PB + 384; lda = LDPE; gB = (const bf16_t*)(ws + OFF_WUKV); ldb = 256; gN = 1024; gK = 256; EB.O = (bf16_t*)(ws + OFF_KV); EB.ldo = 1024; EB.rs = (const float*)(ws + OFF_RSKV); break;
            case K_KMAX: PH(4) phase_kmax(p, ldsg); break;
            case K_ATT: PH(5) phase_attn(p, ldsg); break;
            case K_GPREP: PH(6) phase_gla_prep(p, j, ldsg); break;
            case K_GA: PH(7) phase_gla_a(p, j, ldsg); break;
            case K_GB: PH(8) phase_gla_b(p); break;
            case K_GC: PH(9) phase_gla_c(p, j, ldsg); break;
            case K_GOUT: gemmR = true; gA = MIX; gB = (const bf16_t*)(ws + OFF_WOUT); ER.gate = mod + 2 * 1024; gM = RL; nP = i < 3 ? 4 : 0; Kp = 256; break;
            case K_GUP: gemmB = true; gB = (const bf16_t*)(ws + OFF_W1); gN = 4096; EB.ldo = 4096; EB.mode = 1; gM = i < 3 ? R : RL; break;
            case K_GDN: gemmR = true; gA = PB; lda = 4096; gB = (const bf16_t*)(ws + OFF_W2); ldb = 4096; gK = 4096; ER.gate = mod + 5 * 1024; gM = RL; nP = i < 3 ? 8 : 0; Kp = 512; break;
            case K_COPY:
                for (size_t e = (size_t)blockIdx.x * 512 + ltid(); e < (size_t)R * 256; e += (size_t)gridDim.x * 512) {
                    const size_t row = e >> 8, c4 = (e & 255) * 4;
                    if (row < RL) *(f32x4*)(p.out + row * DM + c4) = *(const f32x4*)(xl + row * DM + c4);
                    else *(f32x4*)(XC + (row - RL) * DM + c4) = *(const f32x4*)(xc + (row - RL) * DM + c4);
                }
                break;
            default: break;
        }
        if (gemmB) { PH(3) run_gemm(lds, gA, lda, gB, ldb, gM, gN, gK, EB, kind == K_GKV); }
        if (gemmR) { PH(10) { run_gemm(lds, gA, lda, gB, ldb, gM, gN, gK, ER); if (nP) run_pieces(lds, gA + (size_t)RL * lda, lda, gB, ldb, nP, Kp, PART); } }
        }
        if (!nosync) xcd_barrier(xbar);
    }
    PH(11) phase_final(p.in[26], p.out);
}

extern "C" void kernel_launch(void* const* d_in, const int* in_sizes, int n_in, void* d_out, int out_size, void* d_ws, size_t ws_size, hipStream_t stream) {
    static int grid = 0;
    if (grid == 0) {
        if (n_in != 27 || ws_size < WS_NEED) { fprintf(stderr, "kernel_launch: unexpected n_in %d / ws %zu\n", n_in, ws_size); grid = -1; return; }
        int dev = 0, cus = 0, per_cu = 0;
        hipGetDevice(&dev);
        hipDeviceGetAttribute(&cus, hipDeviceAttributeMultiprocessorCount, dev);
        hipFuncSetAttribute((const void*)mega, hipFuncAttributeMaxDynamicSharedMemorySize, LDS_BYTES);
        hipOccupancyMaxActiveBlocksPerMultiprocessor(&per_cu, (const void*)mega, 512, LDS_BYTES);
        (void)hipGetLastError();
        if (per_cu < 1) fprintf(stderr, "kernel_launch: occupancy query reports %d blocks per CU\n", per_cu);
        grid = cus > 0 ? cus : 256;
    }
    if (grid < 0) return;
    if (hipMemsetAsync((char*)d_ws + OFF_BAR, 0, 16384, stream) != hipSuccess) { fprintf(stderr, "kernel_launch: memset failed\n"); return; }
    Params p{};
    for (int i = 0; i < 27; ++i) p.in[i] = (const float*)d_in[i];
    p.out = (float*)d_out; p.ws = (unsigned char*)d_ws; p.flags = 7 | PROBE_REP;
    void* args[] = {&p};
    hipError_t e = hipLaunchCooperativeKernel((const void*)mega, dim3(grid), dim3(512), args, LDS_BYTES, stream);
    if (e != hipSuccess) fprintf(stderr, "cooperative launch failed: %s (grid %d)\n", hipGetErrorString(e), grid);
}
```

```cpp
#include <hip/hip_runtime.h>
#include <hip/hip_cooperative_groups.h>
#include <cstdio>
namespace cg = cooperative_groups;

#define LAS __attribute__((address_space(3)))
typedef unsigned short bf16_t;
typedef short bf16x8 __attribute__((ext_vector_type(8)));
typedef short bf16x4 __attribute__((ext_vector_type(4)));
typedef float f32x4 __attribute__((ext_vector_type(4)));
typedef float f32x16 __attribute__((ext_vector_type(16)));
typedef unsigned u32x4 __attribute__((ext_vector_type(4)));
typedef unsigned u32x2 __attribute__((ext_vector_type(2)));

constexpr int R = 33280, RL = 32768, DM = 1024;
constexpr int LDPE = 1792, LDPO = 3328;
constexpr size_t MiB = (size_t)1 << 20;
constexpr size_t OFF_WIN = 0, OFF_WOUT = 8 * MiB, OFF_WUQ = 10 * MiB, OFF_WUKV = 11 * MiB, OFF_WCM = 12 * MiB, OFF_W1 = 13 * MiB, OFF_W2 = 21 * MiB;
constexpr size_t OFF_MOD = 30 * MiB, OFF_XC = 31 * MiB, OFF_RSQ = 33 * MiB, OFF_RSKV = 33 * MiB + 256 * 1024, OFF_GD = 36 * MiB + 640 * 1024;
constexpr size_t OFF_BAR = 33 * MiB + 768 * 1024;
constexpr size_t OFF_KMS = 33 * MiB + 800 * 1024;
constexpr size_t OFF_DECF = 34 * MiB, OFF_DECB = 35 * MiB + 512 * 1024;
constexpr size_t OFF_H = 37 * MiB, OFF_MIX = 102 * MiB, OFF_BIG = 167 * MiB, OFF_G = 427 * MiB;
constexpr size_t OFF_Q = OFF_BIG + 114 * MiB, OFF_KV = OFF_BIG + 163 * MiB, OFF_KR = OFF_BIG + 228 * MiB;
constexpr size_t OFF_QTF = OFF_H, OFF_KTF = OFF_H + 34078720, OFF_QTB = OFF_BIG + 212 * MiB, OFF_SLOC = OFF_G, OFF_KTB = OFF_G + 34 * MiB;
constexpr size_t OFF_PART = 494 * MiB;
constexpr size_t WS_NEED = 510 * MiB;
constexpr int LDS_BYTES = 144 * 1024;

struct Params {
    const float* in[27];
    float* out;
    unsigned char* ws;
    long long flags;
};

__device__ __forceinline__ float bf2f(bf16_t b) { return __uint_as_float(((unsigned)b) << 16); }
__device__ __forceinline__ float bflo(unsigned u) { return __uint_as_float(u << 16); }
__device__ __forceinline__ float bfhi(unsigned u) { return __uint_as_float(u & 0xffff0000u); }
__device__ __forceinline__ bf16_t f2bf(float f) { unsigned u = __float_as_uint(f); u += 0x7FFFu + ((u >> 16) & 1u); return (bf16_t)(u >> 16); }
typedef __bf16 hwbf2_t __attribute__((ext_vector_type(2)));
typedef float f32x2v_t __attribute__((ext_vector_type(2)));
__device__ __forceinline__ unsigned pk2(float lo, float hi) { const f32x2v_t v = {lo, hi}; const hwbf2_t b = __builtin_convertvector(v, hwbf2_t); return __builtin_bit_cast(unsigned, b); }
__device__ __forceinline__ bf16x8 pack8(float a0, float a1, float a2, float a3, float a4, float a5, float a6, float a7) {
    u32x4 u = {pk2(a0, a1), pk2(a2, a3), pk2(a4, a5), pk2(a6, a7)};
    return __builtin_bit_cast(bf16x8, u);
}
__device__ __forceinline__ float wsum(float v) {
#pragma unroll
    for (int o = 32; o >= 1; o >>= 1) v += __shfl_xor(v, o);
    return v;
}
__device__ __forceinline__ float gelu_t(float x) { const float u = 0.7978845608f * (x + 0.044715f * x * x * x); return x / (1.f + __expf(-2.f * u)); }
__device__ __forceinline__ float silu_f(float x) { return x / (1.f + __expf(-x)); }
__device__ __forceinline__ void sincos_red(float ang, float& s, float& c) {
    const float k = rintf(ang * 0.15915494309f);
    float r = fmaf(-k, 6.2831854820251465f, ang);
    r = fmaf(-k, -1.7484555e-7f, r);
    s = __sinf(r); c = __cosf(r);
}
__device__ __forceinline__ float rope_inv(int jj) { return exp2f(-(float)jj * 1.6609640474f); }

__device__ __forceinline__ bf16x4 tr16(LAS unsigned char* a) { return __builtin_amdgcn_ds_read_tr16_b64_v4i16((LAS bf16x4*)a); }
__device__ __forceinline__ bf16x8 tr_nat(LAS unsigned char* base, int stride, int k0, int n0, int lane) {
    const int i = lane & 15, q = i >> 2, pq = i & 3, hh = lane >> 5, g1 = (lane >> 4) & 1;
    LAS unsigned char* a0 = base + (k0 + 8 * hh + q) * stride + (n0 + 16 * g1 + 4 * pq) * 2;
    const bf16x4 x = tr16(a0), y = tr16(a0 + 4 * stride);
    return __builtin_shufflevector(x, y, 0, 1, 2, 3, 4, 5, 6, 7);
}
__device__ __forceinline__ bf16x8 tr_perm(LAS unsigned char* base, int stride, int k0, int n0, int lane) {
    const int i = lane & 15, q = i >> 2, pq = i & 3, hh = lane >> 5, g1 = (lane >> 4) & 1;
    LAS unsigned char* a0 = base + (k0 + 4 * hh + q) * stride + (n0 + 16 * g1 + 4 * pq) * 2;
    const bf16x4 x = tr16(a0), y = tr16(a0 + 8 * stride);
    return __builtin_shufflevector(x, y, 0, 1, 2, 3, 4, 5, 6, 7);
}
__device__ __forceinline__ int ltid() { int t = threadIdx.x; asm volatile("" : "+v"(t)); return t; }
#define MFMA32(a, b, c) __builtin_amdgcn_mfma_f32_32x32x16_bf16((a), (b), (c), 0, 0, 0)

namespace pg8 {
constexpr int BM = 256, BK = 64, HALF = 128, HTB = HALF * BK * 2, STAGE_BYTES = 8 * HTB, NXCD = 8, WGM = 8;
__device__ __forceinline__ int lds_byte(int r, int c) { const int st = (r >> 4) * 2 + (c >> 5), rr = r & 15, cc = c & 31, ob = rr * 64 + cc * 2; return st * 1024 + (ob ^ (((ob >> 9) & 1) << 5)); }
__device__ __forceinline__ void stage_rc(int b, int& Rr, int& C) { const int st = b / 1024, sb = b % 1024, swz = sb ^ (((sb >> 9) & 1) << 5); Rr = (st >> 1) * 16 + swz / 64; C = (st & 1) * 32 + (swz % 64) / 2; }
__device__ __forceinline__ int perm32(int rho) { const int n = rho >> 4, i = rho & 15; return 8 * (i >> 2) + 4 * n + (i & 3); }
struct Unit { int pm, pn, ko; };
struct Gemm { const bf16_t* A; const bf16_t* Bt; int lda, ldb, M, N, K; };
struct StaticOrder {
    int nM, nN, nwg, G, c;
    __device__ void init(int M, int N, int G_, int c_) { nM = M / BM; nN = N / BM; nwg = nM * nN; G = G_; c = c_; }
    __device__ bool next(int i, Unit& u) const {
        const long L = (long)i * G + c; if (L >= nwg) return false;
        int wgid = (int)L; { const int q = nwg / NXCD, r = nwg % NXCD, xcd = wgid % NXCD, off = wgid / NXCD; wgid = (xcd < r ? xcd * (q + 1) : r * (q + 1) + (xcd - r) * q) + off; }
        const int nig = WGM * nN, gid = wgid / nig, fm = gid * WGM, gsz = (nM - fm) < WGM ? (nM - fm) : WGM;
        u.pm = fm + ((wgid % nig) % gsz); u.pn = (wgid % nig) / gsz; u.ko = 0; return true;
    }
};
struct PieceOrder {
    int nP, Kp, G, c;
    __device__ bool next(int i, Unit& u) const {
        const long L = (long)i * G + c; if (L >= 8 * nP) return false;
        const int kp = (int)L >> 3, r = (int)L & 7; u.pm = r >> 2; u.pn = r & 3; u.ko = kp * Kp; return true;
    }
};

template <class Epi, class Sched>
__device__ __forceinline__ void gemm_phase(LAS unsigned char* lds, const Gemm g, const Sched& S, const Epi& E) {
    const int tid = ltid(), wid = __builtin_amdgcn_readfirstlane(tid >> 6), lane = tid & 63, wr = wid >> 2, wc = wid & 3, fr = lane & 15, fq = lane >> 4;
    const int K = g.K, nt = K / BK;
    unsigned voffA[2], voffB[2];
#pragma unroll
    for (int i = 0; i < 2; ++i) { int Rr, C; stage_rc(tid * 16 + i * 8192, Rr, C); const int Rb = Epi::PERM ? ((Rr & ~31) + perm32(Rr & 31)) : Rr;
        voffA[i] = (unsigned)(Rr * g.lda + C) * 2u; voffB[i] = (unsigned)(Rb * g.ldb + C) * 2u; }
    const size_t kstep = (size_t)(BK * 2);
    const size_t hA = (size_t)HALF * g.lda * 2, hB = (size_t)HALF * g.ldb * 2;
    const size_t tA = 2 * hA, tB = 2 * hB;
    const unsigned ldsw = (unsigned)wid * 1024u;
    const int aoff = lds_byte(wr * 64 + fr, fq * 8), boff = lds_byte(wc * 32 + fr, fq * 8);
#define PG8_SA(b, h) (((b) * 2 + (h)) * HTB)
#define PG8_SB(b, h) ((4 + (b) * 2 + (h)) * HTB)
#define PG8_STAGE(bufoff, gbase, voff) do { _Pragma("unroll") for (int _i = 0; _i < 2; ++_i) \
        __builtin_amdgcn_global_load_lds((const unsigned*)((const char*)(gbase) + (voff)[_i]), (LAS unsigned*)(lds + (bufoff) + ldsw + _i * 8192), 16, 0, 0); } while (0)
#define PG8_LDA(dst, b, h) do { _Pragma("unroll") for (int m = 0; m < 4; ++m) _Pragma("unroll") for (int k = 0; k < 2; ++k) dst[m][k] = *(const LAS bf16x8*)(lds + PG8_SA(b, h) + aoff + m * 2048 + k * 1024); } while (0)
#define PG8_LDB(dst, b, h) do { _Pragma("unroll") for (int n = 0; n < 2; ++n) _Pragma("unroll") for (int k = 0; k < 2; ++k) dst[n][k] = *(const LAS bf16x8*)(lds + PG8_SB(b, h) + boff + n * 2048 + k * 1024); } while (0)
#define PG8_MMA(ai, bj, At, Bt) do { __builtin_amdgcn_s_setprio(1); _Pragma("unroll") for (int m = 0; m < 4; ++m) _Pragma("unroll") for (int n = 0; n < 2; ++n) _Pragma("unroll") for (int k = 0; k < 2; ++k) \
        acc[ai][bj][m][n] = __builtin_amdgcn_mfma_f32_16x16x32_bf16(Bt[n][k], At[m][k], acc[ai][bj][m][n], 0, 0, 0); __builtin_amdgcn_s_setprio(0); } while (0)
#define PG8_WAIT_V(n) asm volatile("s_waitcnt vmcnt(" #n ")" ::: "memory")
#define PG8_WAIT_L(n) asm volatile("s_waitcnt lgkmcnt(" #n ")" ::: "memory")
#define PG8_BAR __builtin_amdgcn_s_barrier()
#define PG8_SCHED __builtin_amdgcn_sched_barrier(0)
    Unit cur, nxt; int ui = 0;
    if (!S.next(0, cur)) return;
    f32x4 acc[2][2][4][2];
#pragma unroll
    for (int a = 0; a < 2; ++a)
#pragma unroll
        for (int b = 0; b < 2; ++b)
#pragma unroll
            for (int m = 0; m < 4; ++m)
#pragma unroll
                for (int n = 0; n < 2; ++n) acc[a][b][m][n] = (f32x4){0.f, 0.f, 0.f, 0.f};
    bf16x8 At[4][2], B0[2][2], B1[2][2];
    const char* cA = (const char*)g.A + (size_t)cur.pm * tA + (size_t)cur.ko * 2; const char* cB = (const char*)g.Bt + (size_t)cur.pn * tB + (size_t)cur.ko * 2;
    PG8_STAGE(PG8_SB(0, 0), cB, voffB); PG8_STAGE(PG8_SA(0, 0), cA, voffA); PG8_STAGE(PG8_SB(0, 1), cB + hB, voffB); PG8_STAGE(PG8_SA(0, 1), cA + hA, voffA);
    if (wr == 1) PG8_BAR;
    PG8_WAIT_V(4); PG8_BAR;
    PG8_STAGE(PG8_SB(1, 0), cB + kstep, voffB); PG8_STAGE(PG8_SA(1, 0), cA + kstep, voffA); PG8_STAGE(PG8_SB(1, 1), cB + hB + kstep, voffB);
    PG8_WAIT_V(6); PG8_BAR;
    for (;;) {
        const bool has_next = S.next(ui + 1, nxt);
        const char* nA = has_next ? (const char*)g.A + (size_t)nxt.pm * tA + (size_t)nxt.ko * 2 : cA; const char* nB = has_next ? (const char*)g.Bt + (size_t)nxt.pn * tB + (size_t)nxt.ko * 2 : cB;
        for (int t = 0; t < nt; t += 2) {
            const bool last = (t == nt - 2);
            const char* a1 = cA + (size_t)(t + 1) * kstep;
            const char* a2 = last ? nA : cA + (size_t)(t + 2) * kstep; const char* b2 = last ? nB : cB + (size_t)(t + 2) * kstep;
            const char* a3 = a2 + kstep; const char* b3 = b2 + kstep;
            PG8_LDB(B0, 0, 0); PG8_SCHED; PG8_LDA(At, 0, 0); PG8_STAGE(PG8_SA(1, 1), a1 + hA, voffA);
            PG8_WAIT_L(8); PG8_BAR; PG8_WAIT_L(0); PG8_MMA(0, 0, At, B0); PG8_BAR; PG8_SCHED;
            PG8_LDB(B1, 0, 1); PG8_STAGE(PG8_SB(0, 0), b2, voffB);
            PG8_BAR; PG8_WAIT_L(0); PG8_MMA(0, 1, At, B1); PG8_BAR;
            PG8_LDA(At, 0, 1); PG8_STAGE(PG8_SA(0, 0), a2, voffA);
            PG8_BAR; PG8_WAIT_L(0); PG8_MMA(1, 0, At, B0); PG8_BAR; PG8_SCHED;
            PG8_STAGE(PG8_SB(0, 1), b2 + hB, voffB);
            PG8_WAIT_V(6); PG8_BAR; PG8_MMA(1, 1, At, B1); PG8_BAR;
            PG8_LDB(B0, 1, 0); PG8_SCHED; PG8_LDA(At, 1, 0); PG8_STAGE(PG8_SA(0, 1), a2 + hA, voffA);
            PG8_WAIT_L(8); PG8_BAR; PG8_WAIT_L(0); PG8_MMA(0, 0, At, B0); PG8_BAR; PG8_SCHED;
            PG8_LDB(B1, 1, 1); PG8_STAGE(PG8_SB(1, 0), b3, voffB);
            PG8_BAR; PG8_WAIT_L(0); PG8_MMA(0, 1, At, B1); PG8_BAR;
            PG8_LDA(At, 1, 1); PG8_STAGE(PG8_SA(1, 0), a3, voffA);
            PG8_BAR; PG8_WAIT_L(0); PG8_MMA(1, 0, At, B0); PG8_BAR; PG8_SCHED;
            PG8_STAGE(PG8_SB(1, 1), b3 + hB, voffB);
            PG8_WAIT_V(6); PG8_BAR; PG8_MMA(1, 1, At, B1); PG8_BAR;
        }
        E(acc, cur, wr, wc, fr, fq);
        if (!has_next) break;
#pragma unroll
        for (int a = 0; a < 2; ++a)
#pragma unroll
            for (int b = 0; b < 2; ++b)
#pragma unroll
                for (int m = 0; m < 4; ++m)
#pragma unroll
                    for (int n = 0; n < 2; ++n) acc[a][b][m][n] = (f32x4){0.f, 0.f, 0.f, 0.f};
        cur = nxt; cA = nA; cB = nB; ++ui;
    }
    PG8_WAIT_V(0);
    if (wr == 0) PG8_BAR;
    PG8_BAR;
#undef PG8_SA
#undef PG8_SB
#undef PG8_STAGE
#undef PG8_LDA
#undef PG8_LDB
#undef PG8_MMA
#undef PG8_WAIT_V
#undef PG8_WAIT_L
#undef PG8_BAR
#undef PG8_SCHED
}

struct EpiB {
    static constexpr bool PERM = true;
    bf16_t* O; int ldo; const float* rs; int mode;
    __device__ __forceinline__ void operator()(const f32x4 (&acc)[2][2][4][2], const Unit& u, int wr, int wc, int fr, int fq) const {
        const int row0 = u.pm * BM + wr * 64 + fr, col0 = u.pn * BM + wc * 32 + 8 * fq;
#pragma unroll
        for (int ai = 0; ai < 2; ++ai)
#pragma unroll
            for (int m = 0; m < 4; ++m) {
                const int row = row0 + ai * HALF + m * 16;
                const float s = rs ? rs[row] : 1.f;
                bf16_t* rowp = O + (size_t)row * ldo + col0;
#pragma unroll
                for (int bj = 0; bj < 2; ++bj) {
                    f32x4 v0 = acc[ai][bj][m][0] * s, v1 = acc[ai][bj][m][1] * s;
                    if (mode == 1) {
#pragma unroll
                        for (int e = 0; e < 4; ++e) { const float a = fmaxf(v0[e], 0.f), b = fmaxf(v1[e], 0.f); v0[e] = a * a; v1[e] = b * b; }
                    }
                    const u32x4 o = {pk2(v0[0], v0[1]), pk2(v0[2], v0[3]), pk2(v1[0], v1[1]), pk2(v1[2], v1[3])};
                    *(u32x4*)(rowp + bj * HALF) = o;
                }
            }
    }
};
struct EpiR {
    static constexpr bool PERM = false;
    const float* xin_l; const float* xin_c; float* xout_l; float* xout_c; const float* gate;
    __device__ __forceinline__ void operator()(const f32x4 (&acc)[2][2][4][2], const Unit& u, int wr, int wc, int fr, int fq) const {
        const int var = u.pm < 64 ? 0 : (u.pm < 128 ? 1 : 2);
        const float* gp = gate + var * 6144;
        const int rowt = (u.pm < 128 ? u.pm : u.pm - 128) * BM + wr * 64 + fr;
        const float* xi = u.pm < 128 ? xin_l : xin_c; float* xo = u.pm < 128 ? xout_l : xout_c;
        const int col0 = u.pn * BM + wc * 32 + 4 * fq;
        f32x4 gv[2][2];
#pragma unroll
        for (int bj = 0; bj < 2; ++bj)
#pragma unroll
            for (int n = 0; n < 2; ++n) gv[bj][n] = *(const f32x4*)(gp + col0 + bj * HALF + n * 16);
#pragma unroll
        for (int ai = 0; ai < 2; ++ai)
#pragma unroll
            for (int m = 0; m < 4; ++m) {
                const size_t ro = (size_t)(rowt + ai * HALF + m * 16) * DM + col0;
#pragma unroll
                for (int bj = 0; bj < 2; ++bj)
#pragma unroll
                    for (int n = 0; n < 2; ++n) {
                        const f32x4 x = *(const f32x4*)(xi + ro + bj * HALF + n * 16);
                        *(f32x4*)(xo + ro + bj * HALF + n * 16) = x + gv[bj][n] * acc[ai][bj][m][n];
                    }
            }
    }
};
struct EpiP {
    static constexpr bool PERM = false;
    float* part; int kpiece;
    __device__ __forceinline__ void operator()(const f32x4 (&acc)[2][2][4][2], const Unit& u, int wr, int wc, int fr, int fq) const {
        const int kp = u.ko / kpiece;
        const int rowt = u.pm * BM + wr * 64 + fr, col0 = u.pn * BM + wc * 32 + 4 * fq;
        float* base = part + (size_t)kp * 512 * DM;
#pragma unroll
        for (int ai = 0; ai < 2; ++ai)
#pragma unroll
            for (int m = 0; m < 4; ++m) {
                const size_t ro = (size_t)(rowt + ai * HALF + m * 16) * DM + col0;
#pragma unroll
                for (int bj = 0; bj < 2; ++bj)
#pragma unroll
                    for (int n = 0; n < 2; ++n) *(f32x4*)(base + ro + bj * HALF + n * 16) = acc[ai][bj][m][n];
            }
    }
};
}

template <class Epi>
__device__ __forceinline__ void run_gemm(LAS unsigned char* lds, const bf16_t* A, int lda, const bf16_t* Bt, int ldb, int M, int N, int K, const Epi& E, bool rev = false) {
    pg8::Gemm g; g.A = A; g.Bt = Bt; g.lda = lda; g.ldb = ldb; g.M = M; g.N = N; g.K = K;
    pg8::StaticOrder S; S.init(M, N, (int)gridDim.x, rev ? (int)(gridDim.x - 1 - blockIdx.x) : (int)blockIdx.x);
    pg8::gemm_phase<Epi, pg8::StaticOrder>(lds, g, S, E);
}
__device__ __forceinline__ void run_pieces(LAS unsigned char* lds, const bf16_t* A, int lda, const bf16_t* Bt, int ldb, int nP, int Kp, float* part) {
    pg8::Gemm g; g.A = A; g.Bt = Bt; g.lda = lda; g.ldb = ldb; g.M = 512; g.N = 1024; g.K = Kp;
    pg8::PieceOrder S; S.nP = nP; S.Kp = Kp; S.G = (int)gridDim.x; S.c = (int)blockIdx.x;
    pg8::EpiP E; E.part = part; E.kpiece = Kp;
    pg8::gemm_phase<pg8::EpiP, pg8::PieceOrder>(lds, g, S, E);
}

__device__ void phase_ada(const Params& p, unsigned char* ldsg) {
    float* sl = (float*)ldsg;
    float* red = sl + 3072;
    const int tid = ltid();
    float* MOD = (float*)(p.ws + OFF_MOD);
    for (int idx = tid; idx < 3072; idx += 512) { const int var = idx >> 10, k = idx & 1023; const float v = var < 2 ? p.in[1][var * 1024 + k] : p.in[3][k]; sl[idx] = silu_f(v); }
    __syncthreads();
    for (int item = blockIdx.x; item < 192; item += gridDim.x) {
        const int i = item / 48, cb = item % 48, cc = tid & 127, kq = tid >> 7, col = cb * 128 + cc;
        const float* w = p.in[4] + ((size_t)i * 1024 + kq * 256) * 6144 + col;
        const float* s0 = sl + kq * 256;
        float a0 = 0.f, a1 = 0.f, a2 = 0.f;
#pragma unroll 8
        for (int k = 0; k < 256; ++k) { const float wv = w[(size_t)k * 6144]; a0 = fmaf(s0[k], wv, a0); a1 = fmaf(s0[1024 + k], wv, a1); a2 = fmaf(s0[2048 + k], wv, a2); }
        red[(kq * 3 + 0) * 128 + cc] = a0; red[(kq * 3 + 1) * 128 + cc] = a1; red[(kq * 3 + 2) * 128 + cc] = a2;
        __syncthreads();
        if (tid < 384) { const int var = tid >> 7, c2 = tid & 127; float s = p.in[5][i * 6144 + cb * 128 + c2];
#pragma unroll
            for (int q = 0; q < 4; ++q) s += red[(q * 3 + var) * 128 + c2];
            MOD[(size_t)(i * 3 + var) * 6144 + cb * 128 + c2] = s; }
        __syncthreads();
    }
}

__device__ void tjob(const float* src, int K, int N, int Npad, bf16_t* dst, const float* rs, float mult, unsigned char* ldsg) {
    float* tile = (float*)ldsg;
    const int tid = ltid(), ntk = K / 64, ntn = Npad / 64;
    for (int t = blockIdx.x; t < ntk * ntn; t += gridDim.x) {
        const int tk = t % ntk, tn = t / ntk;
        const int nl = tid & 63, kl0 = tid >> 6;
#pragma unroll
        for (int j = 0; j < 8; ++j) { const int kl = kl0 + 8 * j, k = tk * 64 + kl, n = tn * 64 + nl;
            float v = n < N ? src[(size_t)k * N + n] : 0.f; if (rs) v *= rs[k]; tile[kl * 65 + nl] = v * mult; }
        __syncthreads();
        const int nl2 = tid >> 3, kc = tid & 7;
        u32x4 o;
#pragma unroll
        for (int e = 0; e < 4; ++e) o[e] = pk2(tile[(kc * 8 + 2 * e) * 65 + nl2], tile[(kc * 8 + 2 * e + 1) * 65 + nl2]);
        *(u32x4*)(dst + (size_t)(tn * 64 + nl2) * K + tk * 64 + kc * 8) = o;
        __syncthreads();
    }
}
__device__ void phase_weights(const Params& p, int i, unsigned char* ldsg) {
    unsigned char* ws = p.ws; const int j = i >> 1;
    if (!(i & 1)) {
        tjob(p.in[10] + (size_t)j * 1024 * 1696, 1024, 1696, 1792, (bf16_t*)(ws + OFF_WIN), nullptr, 1.f, ldsg);
        tjob(p.in[12] + (size_t)j * 384 * 768, 384, 768, 768, (bf16_t*)(ws + OFF_WUQ), p.in[11] + j * 384, 0.10206207262f * 1.44269504089f, ldsg);
        tjob(p.in[14] + (size_t)j * 256 * 1024, 256, 1024, 1024, (bf16_t*)(ws + OFF_WUKV), p.in[13] + j * 256, 1.f, ldsg);
        tjob(p.in[18] + (size_t)j * 1024 * 1024, 1024, 1024, 1024, (bf16_t*)(ws + OFF_WOUT), nullptr, 1.f, ldsg);
        bf16_t* wcm = (bf16_t*)(ws + OFF_WCM); const float* src = p.in[16] + (size_t)j * 65536;
        for (int e = blockIdx.x * 512 + ltid(); e < 65536; e += gridDim.x * 512) wcm[e] = f2bf(src[e]);
    } else {
        tjob(p.in[19] + (size_t)j * 1024 * 3104, 1024, 3104, 3328, (bf16_t*)(ws + OFF_WIN), nullptr, 1.f, ldsg);
        tjob(p.in[25] + (size_t)j * 1024 * 1024, 1024, 1024, 1024, (bf16_t*)(ws + OFF_WOUT), nullptr, 1.f, ldsg);
    }
    tjob(p.in[8] + (size_t)i * 1024 * 4096, 1024, 4096, 4096, (bf16_t*)(ws + OFF_W1), nullptr, 1.f, ldsg);
    tjob(p.in[9] + (size_t)i * 4096 * 1024, 4096, 1024, 1024, (bf16_t*)(ws + OFF_W2), nullptr, 1.f, ldsg);
}

__device__ void phase_norm(const float* xl, const float* xc, const float* g, const float* mod  , int shift_i, int scale_i, bf16_t* H,
                           int nrows, const float* part, int npart, const float* pgate, float* xc_out) {
    const int lane = ltid() & 63, gw = blockIdx.x * 8 + (ltid() >> 6), nw = gridDim.x * 8;
    f32x4 xn[4];
    if (gw < nrows) { const float* src = gw < RL ? xl + (size_t)gw * DM : xc + (size_t)(gw - RL) * DM;
#pragma unroll
        for (int q = 0; q < 4; ++q) xn[q] = *(const f32x4*)(src + q * 256 + lane * 4); }
    for (int row = gw; row < nrows; row += nw) {
        const int var = row < 16384 ? 0 : (row < RL ? 1 : 2);
        const float* sh = mod + var * 6144 + shift_i * 1024; const float* sc = mod + var * 6144 + scale_i * 1024;
        f32x4 x[4]; float ss = 0.f;
#pragma unroll
        for (int q = 0; q < 4; ++q) x[q] = xn[q];
        { const int nr = row + nw;
          if (nr < nrows) { const float* src = nr < RL ? xl + (size_t)nr * DM : xc + (size_t)(nr - RL) * DM;
#pragma unroll
              for (int q = 0; q < 4; ++q) xn[q] = *(const f32x4*)(src + q * 256 + lane * 4); } }
        if (row >= RL && part) {
#pragma unroll
            for (int q = 0; q < 4; ++q) { const int c = q * 256 + lane * 4;
                f32x4 acc = {0.f, 0.f, 0.f, 0.f};
                for (int kp = 0; kp < npart; ++kp) acc += *(const f32x4*)(part + ((size_t)kp * 512 + (row - RL)) * DM + c);
                x[q] += *(const f32x4*)(pgate + c) * acc;
                *(f32x4*)(xc_out + (size_t)(row - RL) * DM + c) = x[q]; }
        }
#pragma unroll
        for (int q = 0; q < 4; ++q) ss += x[q][0] * x[q][0] + x[q][1] * x[q][1] + x[q][2] * x[q][2] + x[q][3] * x[q][3];
        ss = wsum(ss);
        const float rstd = rsqrtf(ss * (1.f / 1024.f) + 1e-6f);
#pragma unroll
        for (int q = 0; q < 4; ++q) { const int c = q * 256 + lane * 4;
            const f32x4 gg = *(const f32x4*)(g + c), s1 = *(const f32x4*)(sc + c), s0 = *(const f32x4*)(sh + c);
            float o[4];
#pragma unroll
            for (int e = 0; e < 4; ++e) o[e] = x[q][e] * rstd * gg[e] * (1.f + s1[e]) + s0[e];
            const u32x2 pk = {pk2(o[0], o[1]), pk2(o[2], o[3])};
            *(u32x2*)(H + (size_t)row * DM + c) = pk; }
    }
}
__device__ void phase_final(const float* g, float* X) {
    const int lane = ltid() & 63, gw = blockIdx.x * 8 + (ltid() >> 6), nw = gridDim.x * 8;
    f32x4 xn[4];
    if (gw < RL) {
#pragma unroll
        for (int q = 0; q < 4; ++q) xn[q] = *(const f32x4*)(X + (size_t)gw * DM + q * 256 + lane * 4); }
    for (int row = gw; row < RL; row += nw) {
        float* src = X + (size_t)row * DM;
        f32x4 x[4]; float ss = 0.f;
#pragma unroll
        for (int q = 0; q < 4; ++q) { x[q] = xn[q]; ss += x[q][0] * x[q][0] + x[q][1] * x[q][1] + x[q][2] * x[q][2] + x[q][3] * x[q][3]; }
        if (row + nw < RL) {
#pragma unroll
            for (int q = 0; q < 4; ++q) xn[q] = *(const f32x4*)(X + (size_t)(row + nw) * DM + q * 256 + lane * 4); }
        ss = wsum(ss);
        const float rstd = rsqrtf(ss * (1.f / 1024.f) + 1e-6f);
#pragma unroll
        for (int q = 0; q < 4; ++q) { const int c = q * 256 + lane * 4; const f32x4 gg = *(const f32x4*)(g + c); *(f32x4*)(src + c) = x[q] * rstd * gg; }
    }
}

__device__ void phase_even_prep(const Params& p, int j, unsigned char* ldsg) {
    unsigned char* ws = p.ws;
    const bf16_t* P = (const bf16_t*)(ws + OFF_BIG);
    float* RSQ = (float*)(ws + OFF_RSQ); float* RSKV = (float*)(ws + OFF_RSKV);
    bf16_t* KR = (bf16_t*)(ws + OFF_KR); bf16_t* MIX = (bf16_t*)(ws + OFF_MIX);
    const int tid = ltid(), lane = tid & 63, w = tid >> 6, l32 = lane & 31, hh = lane >> 5;
    {
        const int gw = blockIdx.x * 8 + w, nw = gridDim.x * 8;
        for (int row = gw; row < R; row += nw) {
            const bf16_t* pr = P + (size_t)row * LDPE;
            float ss = 0.f;
#pragma unroll
            for (int q = 0; q < 3; ++q) { const unsigned u = *(const unsigned*)(pr + 2 * lane + 128 * q); const float a = bflo(u), b = bfhi(u); ss += a * a + b * b; }
            ss = wsum(ss);
            const u32x2 u2 = *(const u32x2*)(pr + 384 + 4 * lane);
            float s2 = bflo(u2[0]) * bflo(u2[0]) + bfhi(u2[0]) * bfhi(u2[0]) + bflo(u2[1]) * bflo(u2[1]) + bfhi(u2[1]) * bfhi(u2[1]);
            s2 = wsum(s2);
            if (lane == 0) { RSQ[row] = rsqrtf(ss * (1.f / 384.f) + 1e-6f); RSKV[row] = rsqrtf(s2 * (1.f / 256.f) + 1e-6f); }
            const float x = bf2f(pr[640 + l32]); const float y = __shfl_xor(x, 8);
            float o = x;
            if (row < RL) { const int l = row & 16383; const float pos = (float)(l32 < 16 ? (l >> 6) : (l & 63));
                float s, c; sincos_red(pos * rope_inv(l32 & 7), s, c);
                o = (l32 & 8) ? x * c + y * s : x * c - y * s; }
            if (lane < 32) KR[(size_t)row * 32 + lane] = f2bf(o);
        }
    }
    LAS unsigned char* lds = (LAS unsigned char*)ldsg;
    const bf16_t* WCM = (const bf16_t*)(ws + OFF_WCM);
    const float* cmn = p.in[15] + j * 128; const float* bs = p.in[17] + j * 512;
    for (int item = blockIdx.x; item < 1040; item += gridDim.x) {
        const int n = item >> 2, g = item & 3, r0 = n * 128;
        {
            const int s = tid >> 2, cq = tid & 3;
            const bf16_t* src = P + (size_t)(r0 + s) * LDPE + 1184 + g * 128 + cq * 32;
            float v[32]; float ss = 0.f;
#pragma unroll
            for (int q = 0; q < 4; ++q) { const u32x4 u = *(const u32x4*)(src + q * 8);
#pragma unroll
                for (int e = 0; e < 4; ++e) { const float a = gelu_t(bflo(u[e])), b = gelu_t(bfhi(u[e])); v[q * 8 + 2 * e] = a; v[q * 8 + 2 * e + 1] = b; ss += a * a + b * b; } }
            ss += __shfl_xor(ss, 1); ss += __shfl_xor(ss, 2);
            const float rstd = rsqrtf(ss * (1.f / 128.f) + 1e-6f);
#pragma unroll
            for (int q = 0; q < 4; ++q) { u32x4 o;
#pragma unroll
                for (int e = 0; e < 4; ++e) { const int c = cq * 32 + q * 8 + 2 * e; o[e] = pk2(v[q * 8 + 2 * e] * rstd * cmn[c], v[q * 8 + 2 * e + 1] * rstd * cmn[c + 1]); }
                *(LAS u32x4*)(lds + s * 272 + (cq * 32 + q * 8) * 2) = o; }
        }
        __syncthreads();
        const int tt = w >> 1, cp = (w & 1) * 2;
        f32x16 acc[2];
#pragma unroll
        for (int e = 0; e < 16; ++e) { acc[0][e] = 0.f; acc[1][e] = 0.f; }
#pragma unroll
        for (int ks = 0; ks < 8; ++ks) {
            const bf16x8 a = *(const bf16x8*)(WCM + g * 16384 + (32 * tt + l32) * 128 + 16 * ks + 8 * hh);
#pragma unroll
            for (int ct = 0; ct < 2; ++ct) { const bf16x8 b = tr_nat(lds, 272, 16 * ks, 32 * (cp + ct), lane); acc[ct] = MFMA32(a, b, acc[ct]); }
        }
#pragma unroll
        for (int ct = 0; ct < 2; ++ct)
#pragma unroll
            for (int i = 0; i < 16; ++i) {
                const int t = 32 * tt + (i >> 2) * 8 + 4 * hh + (i & 3), c = 32 * (cp + ct) + l32;
                const float val = acc[ct][i] + bs[g * 128 + t];
                const float u = gelu_t(bf2f(P[(size_t)(r0 + t) * LDPE + 672 + g * 128 + c]));
                MIX[(size_t)(r0 + t) * DM + 512 + g * 128 + c] = f2bf(u * val);
            }
        __syncthreads();
    }
}

__device__ void phase_kmax(const Params& p, unsigned char* ldsg) {
    unsigned char* ws = p.ws;
    const bf16_t* KV = (const bf16_t*)(ws + OFF_KV); const bf16_t* KR = (const bf16_t*)(ws + OFF_KR);
    float* KMS = (float*)(ws + OFF_KMS);
    float* red = (float*)ldsg;
    const int tid = ltid(), lane = tid & 63, w = tid >> 6, h = lane >> 3, jj = lane & 7;
    float mx0 = 0.f, mx1 = 0.f;
    for (int row = blockIdx.x * 8 + w; row < R; row += gridDim.x * 8) {
        const u32x4 a = *(const u32x4*)(KV + (size_t)row * 1024 + h * 128 + jj * 8);
        const u32x4 r = *(const u32x4*)(KR + (size_t)row * 32 + (jj & 3) * 8);
        float ss = 0.f, sr = 0.f;
#pragma unroll
        for (int e = 0; e < 4; ++e) { ss += bflo(a[e]) * bflo(a[e]) + bfhi(a[e]) * bfhi(a[e]); sr += bflo(r[e]) * bflo(r[e]) + bfhi(r[e]) * bfhi(r[e]); }
        ss += 0.5f * sr;
        ss += __shfl_xor(ss, 1); ss += __shfl_xor(ss, 2); ss += __shfl_xor(ss, 4);
        const int b = row < 16384 ? 0 : (row < RL ? 1 : ((row - RL) >> 8));
        if (b == 0) mx0 = fmaxf(mx0, ss); else mx1 = fmaxf(mx1, ss);
    }
    if (jj == 0) { red[w * 16 + h] = mx0; red[w * 16 + 8 + h] = mx1; }
    __syncthreads();
    if (tid < 16) { float m = red[tid];
#pragma unroll
        for (int q = 1; q < 8; ++q) m = fmaxf(m, red[q * 16 + tid]);
        KMS[blockIdx.x * 16 + tid] = m; }
    __syncthreads();
}

__device__ void phase_attn(const Params& p, unsigned char* ldsg) {
    unsigned char* ws = p.ws;
    const bf16_t* Q = (const bf16_t*)(ws + OFF_Q); const bf16_t* KV = (const bf16_t*)(ws + OFF_KV); const bf16_t* KR = (const bf16_t*)(ws + OFF_KR);
    bf16_t* MIX = (bf16_t*)(ws + OFF_MIX);
    LAS unsigned char* lds = (LAS unsigned char*)ldsg;
    const int tid = ltid(), lane = tid & 63, w = tid >> 6, l32 = lane & 31, hh = lane >> 5;
    constexpr int KROW = 208, VROW = 192, KBUF = 64 * KROW, VBUF = 64 * VROW, VBASE = 4 * KBUF;
    for (int it = blockIdx.x; it < 1040; it += gridDim.x) {
        int b, h, q0row, nkt; bool isctx;
        if (it < 1024) { h = it & 7; const int rest = it >> 3; b = rest >> 6; q0row = b * 16384 + (rest & 63) * 256; nkt = 260; isctx = false; }
        else { const int e = it - 1024; b = e >> 3; h = e & 7; q0row = RL + b * 256; nkt = 4; isctx = true; }
        const int qrow = q0row + w * 32 + l32;
        const bf16_t* qp = Q + (size_t)qrow * 768 + h * 96;
        bf16x8 qf[6];
#pragma unroll
        for (int s = 0; s < 4; ++s) qf[s] = *(const bf16x8*)(qp + 16 * s + 8 * hh);
#pragma unroll
        for (int s = 4; s < 6; ++s) {
            const bf16x8 own = *(const bf16x8*)(qp + 16 * s + 8 * hh);
            const bf16x8 oth = *(const bf16x8*)(qp + 16 * s + 8 * (1 - hh));
            if (!isctx) {
                const int l = qrow & 16383; const float pos = (float)(s == 4 ? (l >> 6) : (l & 63));
                float r[8];
#pragma unroll
                for (int jj = 0; jj < 8; ++jj) { float sn, cs; sincos_red(pos * rope_inv(jj), sn, cs);
                    const float x = bf2f((bf16_t)own[jj]), y = bf2f((bf16_t)oth[jj]); r[jj] = hh ? x * cs + y * sn : x * cs - y * sn; }
                qf[s] = pack8(r[0], r[1], r[2], r[3], r[4], r[5], r[6], r[7]);
            } else qf[s] = own;
        }
        float negm;
        {
            float qs = 0.f;
#pragma unroll
            for (int s = 0; s < 6; ++s)
#pragma unroll
                for (int e = 0; e < 8; ++e) { const float x = bf2f((bf16_t)qf[s][e]); qs += x * x; }
            qs += __shfl_xor(qs, 32);
            const float* KMS = (const float*)(ws + OFF_KMS) + b * 8 + h;
            float km = 0.f;
            for (int q = lane; q < (int)gridDim.x; q += 64) km = fmaxf(km, KMS[q * 16]);
#pragma unroll
            for (int o2 = 32; o2 >= 1; o2 >>= 1) km = fmaxf(km, __shfl_xor(km, o2));
            negm = -sqrtf(qs * km) * 1.0001f - 1e-3f;
        }
        const bf16_t* kp[2]; int kst[2]; int kdo[2]; bool kv_[2];
#pragma unroll
        for (int pp = 0; pp < 2; ++pp) {
            int c = tid + 512 * pp; if (c >= 768) c -= 512; kv_[pp] = true; const int key = c / 12, part = c % 12;
            if (part < 8) { kp[pp] = KV + (size_t)key * 1024 + h * 128 + part * 8; kst[pp] = 1024; }
            else { kp[pp] = KR + (size_t)key * 32 + (part - 8) * 8; kst[pp] = 32; }
            kdo[pp] = key * KROW + part * 16;
        }
        const bf16_t* vp = KV + (size_t)(tid >> 3) * 1024 + h * 128 + 64 + (tid & 7) * 8; const int vdo = (tid >> 3) * VROW + (tid & 7) * 16;
        auto rowbase = [&](int kt) -> int { return isctx ? (RL + b * 256 + kt * 64) : (kt < 256 ? b * 16384 + kt * 64 : RL + b * 256 + (kt - 256) * 64); };
        u32x4 prk[2], prv;
        auto loadK = [&](int kt) { const int rb = rowbase(kt);
#pragma unroll
            for (int pp = 0; pp < 2; ++pp) prk[pp] = *(const u32x4*)(kp[pp] + (size_t)rb * kst[pp]); };
        auto storeK = [&](int buf) {
#pragma unroll
            for (int pp = 0; pp < 2; ++pp) *(LAS u32x4*)(lds + buf * KBUF + kdo[pp]) = prk[pp]; };
        auto loadV = [&](int kt) { prv = *(const u32x4*)(vp + (size_t)rowbase(kt) * 1024); };
        auto storeV = [&](int buf) { *(LAS u32x4*)(lds + VBASE + buf * VBUF + vdo) = prv; };
        f32x16 pA[2], pB[2];
        f32x16 o[2];
#pragma unroll
        for (int e = 0; e < 16; ++e) { o[0][e] = 0.f; o[1][e] = 0.f; }
        float lsum = 0.f;
        auto qk = [&](int buf, f32x16 (&st)[2]) {
            LAS unsigned char* kb = lds + buf * KBUF;
#pragma unroll
            for (int e = 0; e < 16; ++e) { st[0][e] = negm; st[1][e] = negm; }
#pragma unroll
            for (int half = 0; half < 2; ++half) {
                bf16x8 kf[6];
#pragma unroll
                for (int s = 0; s < 3; ++s) {
                    kf[2 * s] = *(const LAS bf16x8*)(kb + l32 * KROW + (16 * (3 * half + s) + 8 * hh) * 2);
                    kf[2 * s + 1] = *(const LAS bf16x8*)(kb + (32 + l32) * KROW + (16 * (3 * half + s) + 8 * hh) * 2);
                }
                __builtin_amdgcn_sched_barrier(0);
#pragma unroll
                for (int s = 0; s < 3; ++s) { st[0] = MFMA32(kf[2 * s], qf[3 * half + s], st[0]); st[1] = MFMA32(kf[2 * s + 1], qf[3 * half + s], st[1]); }
            }
        };
        auto partialSM = [&](f32x16 (&pp)[2]) {
#pragma unroll
            for (int e = 0; e < 16; ++e) pp[0][e] = __builtin_amdgcn_exp2f(pp[0][e]);
        };
        bf16x8 pa[4];
        auto finishSM = [&](f32x16 (&pp)[2]) {
#pragma unroll
            for (int e = 0; e < 16; ++e) pp[1][e] = __builtin_amdgcn_exp2f(pp[1][e]);
            float ps = 0.f;
#pragma unroll
            for (int e = 0; e < 16; ++e) ps += pp[0][e] + pp[1][e];
            lsum += ps;
            pa[0] = pack8(pp[0][0], pp[0][1], pp[0][2], pp[0][3], pp[0][4], pp[0][5], pp[0][6], pp[0][7]);
            pa[1] = pack8(pp[0][8], pp[0][9], pp[0][10], pp[0][11], pp[0][12], pp[0][13], pp[0][14], pp[0][15]);
            pa[2] = pack8(pp[1][0], pp[1][1], pp[1][2], pp[1][3], pp[1][4], pp[1][5], pp[1][6], pp[1][7]);
            pa[3] = pack8(pp[1][8], pp[1][9], pp[1][10], pp[1][11], pp[1][12], pp[1][13], pp[1][14], pp[1][15]);
        };
        auto pv = [&](int buf) {
            LAS unsigned char* vb = lds + VBASE + buf * VBUF;
#pragma unroll
            for (int vt = 0; vt < 2; ++vt) {
                bf16x8 vf[4];
#pragma unroll
                for (int q = 0; q < 4; ++q) vf[q] = tr_perm(vb, VROW, 16 * q, 32 * vt, lane);
                __builtin_amdgcn_sched_barrier(0);
#pragma unroll
                for (int q = 0; q < 4; ++q) o[vt] = MFMA32(vf[q], pa[q], o[vt]);
            }
        };
        auto step = [&](int j, f32x16 (&pc)[2], f32x16 (&pn)[2], bool bar) {
            const int jk = j + 3 < nkt ? j + 3 : nkt - 1, jv = j + 2 < nkt ? j + 2 : nkt - 1;
            __builtin_amdgcn_sched_barrier(0);
            qk((j + 1) & 3, pn);
            finishSM(pc);
            __builtin_amdgcn_sched_barrier(0);
            loadK(jk); loadV(jv);
            __builtin_amdgcn_sched_barrier(0);
            pv(j & 3);
            partialSM(pn);
            __builtin_amdgcn_sched_barrier(0);
            storeK((j + 3) & 3); storeV((j + 2) & 3);
            if (bar) __syncthreads();
        };
        loadK(0); loadV(0); storeK(0); storeV(0);
        loadK(1); loadV(1); storeK(1); storeV(1);
        loadK(2); storeK(2);
        __syncthreads();
        qk(0, pA); partialSM(pA);
        __syncthreads();
        for (int kt = 0; kt + 2 < nkt; kt += 2) {
            step(kt, pA, pB, false);
            step(kt + 1, pB, pA, true);
        }
        step(nkt - 2, pA, pB, true);
        finishSM(pB);
        pv((nkt - 1) & 3);
        __syncthreads();
        lsum += __shfl_xor(lsum, 32);
        const float inv = 1.f / lsum;
        bf16_t* op = MIX + (size_t)qrow * DM + h * 64;
#pragma unroll
        for (int vt = 0; vt < 2; ++vt)
#pragma unroll
            for (int g4 = 0; g4 < 4; ++g4) {
                const u32x2 pk = {pk2(o[vt][4 * g4] * inv, o[vt][4 * g4 + 1] * inv), pk2(o[vt][4 * g4 + 2] * inv, o[vt][4 * g4 + 3] * inv)};
                *(u32x2*)(op + 32 * vt + 8 * g4 + 4 * hh) = pk;
            }
    }
}

__device__ void phase_gla_prep(const Params& p, int j, unsigned char* ldsg) {
    unsigned char* ws = p.ws;
    const bf16_t* P = (const bf16_t*)(ws + OFF_BIG);
    bf16_t* QTF = (bf16_t*)(ws + OFF_QTF); bf16_t* KTF = (bf16_t*)(ws + OFF_KTF); bf16_t* QTB = (bf16_t*)(ws + OFF_QTB); bf16_t* KTB = (bf16_t*)(ws + OFF_KTB);
    float* DECF = (float*)(ws + OFF_DECF); float* DECB = (float*)(ws + OFF_DECB);
    float* zl = (float*)ldsg;
    float* seg = zl + 2048;
    const int tid = ltid();
    const float* wgf = p.in[20] + (size_t)j * 16 * 512; const float* wgb = p.in[22] + (size_t)j * 16 * 512;
    const float* bgf = p.in[21] + j * 512; const float* bgb = p.in[23] + j * 512;
    for (int item = blockIdx.x; item < 2080; item += gridDim.x) {
        const int ck = item >> 2, h = item & 3, r0 = ck * 64;
        { const int t = tid >> 3, j0 = (tid & 7) * 4; const u32x2 u = *(const u32x2*)(P + (size_t)(r0 + t) * LDPO + 1536 + j0);
          zl[t * 32 + j0] = bflo(u[0]); zl[t * 32 + j0 + 1] = bfhi(u[0]); zl[t * 32 + j0 + 2] = bflo(u[1]); zl[t * 32 + j0 + 3] = bfhi(u[1]); }
        __syncthreads();
        const int d = tid & 127, tq = tid >> 7, hd = h * 128 + d;
        float wf[16], wb[16];
#pragma unroll
        for (int q = 0; q < 16; ++q) { wf[q] = wgf[q * 512 + hd]; wb[q] = wgb[q * 512 + hd]; }
        const float bf_ = bgf[hd], bb_ = bgb[hd];
        float lf[16], lb[16];
#pragma unroll
        for (int i = 0; i < 16; ++i) {
            const float* zr = zl + (tq * 16 + i) * 32;
            float gf = bf_, gb = bb_;
#pragma unroll
            for (int q = 0; q < 16; ++q) { gf = fmaf(zr[q], wf[q], gf); gb = fmaf(zr[16 + q], wb[q], gb); }
            lf[i] = (fminf(gf, 0.f) - __logf(1.f + __expf(-fabsf(gf)))) * 0.0625f;
            lb[i] = (fminf(gb, 0.f) - __logf(1.f + __expf(-fabsf(gb)))) * 0.0625f;
        }
        float run = 0.f;
#pragma unroll
        for (int i = 0; i < 16; ++i) { run += lf[i]; lf[i] = run; }
        const float segF = run; run = 0.f;
#pragma unroll
        for (int i = 15; i >= 0; --i) { run += lb[i]; lb[i] = run; }
        const float segB = run;
        seg[tq * 128 + d] = segF; seg[512 + tq * 128 + d] = segB;
        __syncthreads();
        float offF = 0.f, totF = 0.f, offB = 0.f, totB = 0.f;
#pragma unroll
        for (int q = 0; q < 4; ++q) { const float a = seg[q * 128 + d], b2 = seg[512 + q * 128 + d]; totF += a; totB += b2; if (q < tq) offF += a; if (q > tq) offB += b2; }
#pragma unroll
        for (int i = 0; i < 16; ++i) {
            const size_t row = (size_t)(r0 + tq * 16 + i);
            const float q = bf2f(P[row * LDPO + 1568 + hd]) * 0.08838834764f, k = bf2f(P[row * LDPO + hd]);
            const float cf = lf[i] + offF, cb = lb[i] + offB;
            QTF[row * 512 + hd] = f2bf(q * __expf(cf)); KTF[row * 512 + hd] = f2bf(k * __expf(-cf));
            QTB[row * 512 + hd] = f2bf(q * __expf(cb)); KTB[row * 512 + hd] = f2bf(k * __expf(-cb));
        }
        if (tq == 0) { DECF[(size_t)(ck * 4 + h) * 128 + d] = __expf(totF); DECB[(size_t)(ck * 4 + h) * 128 + d] = __expf(totB); }
        __syncthreads();
    }
}

constexpr int NGRP = 32, NSLOT = NGRP + 1;
__device__ __forceinline__ int gstart(int g) { return g < 27 ? 8 * g : (g < 31 ? 216 + 9 * (g - 27) : 252); }
__device__ __forceinline__ int gsize(int g) { return g < 27 ? 8 : (g < 31 ? 9 : 4); }
constexpr int G_QOFF = 0, G_KOFF = 17408, G_VOFF = 34816, G_DOFF = 68608, G_BUF = 69120, G_SSQ = 2 * G_BUF;
template <bool OUT>
__device__ __forceinline__ void gla_seq(const Params& p, int j, LAS unsigned char* lds, int b, int h, int dir, bool ctx, int g, f32x16 (&S)[4], float* gdout) {
    unsigned char* ws = p.ws;
    const bf16_t* P = (const bf16_t*)(ws + OFF_BIG);
    const bf16_t* QT = (const bf16_t*)(ws + (dir ? OFF_QTB : OFF_QTF)); const bf16_t* KT = (const bf16_t*)(ws + (dir ? OFF_KTB : OFF_KTF));
    const float* DEC = (const float*)(ws + (dir ? OFF_DECB : OFF_DECF));
    bf16_t* MIX = (bf16_t*)(ws + OFF_MIX);
    const float* onorm = p.in[24] + j * 256;
    const int tid = ltid(), lane = tid & 63, w = tid >> 6, l32 = lane & 31, hh = lane >> 5;
    const int nsteps = ctx ? 4 : gsize(g), g0 = gstart(g);
    auto chunk_of = [&](int i) -> int { const int c = ctx ? (dir ? 3 - i : i) : (dir ? g0 + nsteps - 1 - i : g0 + i); return ctx ? 512 + b * 4 + c : b * 256 + c; };
    u32x4 pq[2], pk[2], pv[4], pd;
    auto gload = [&](int ck, int tid) {
        const size_t rb = (size_t)ck * 64;
#pragma unroll
        for (int pp = 0; pp < 2; ++pp) { const int c = tid + 512 * pp, row = c >> 4, cc = c & 15;
            if (OUT) pq[pp] = *(const u32x4*)(QT + (rb + row) * 512 + h * 128 + cc * 8);
            pk[pp] = *(const u32x4*)(KT + (rb + row) * 512 + h * 128 + cc * 8); }
#pragma unroll
        for (int pp = 0; pp < 4; ++pp) { const int c = tid + 512 * pp, row = c >> 5, cc = c & 31; pv[pp] = *(const u32x4*)(P + (rb + row) * LDPO + 512 + h * 256 + cc * 8); }
        if (tid < 32) pd = *(const u32x4*)(DEC + (size_t)(ck * 4 + h) * 128 + tid * 4);
    };
    auto lstore = [&](LAS unsigned char* bb, int tid) {
#pragma unroll
        for (int pp = 0; pp < 2; ++pp) { const int c = tid + 512 * pp, row = c >> 4, cc = c & 15;
            if (OUT) *(LAS u32x4*)(bb + G_QOFF + row * 272 + cc * 16) = pq[pp];
            *(LAS u32x4*)(bb + G_KOFF + row * 272 + cc * 16) = pk[pp]; }
#pragma unroll
        for (int pp = 0; pp < 4; ++pp) { const int c = tid + 512 * pp, row = c >> 5, cc = c & 31; *(LAS u32x4*)(bb + G_VOFF + row * 528 + cc * 16) = pv[pp]; }
        if (tid < 32) *(LAS u32x4*)(bb + G_DOFF + tid * 16) = pd;
    };
    float gd = 1.f;
    gload(chunk_of(0), tid); lstore(lds, tid);
    __syncthreads();
    for (int i = 0; i < nsteps; ++i) {
        const bool more = i + 1 < nsteps;
        const int ck = chunk_of(i);
        const int tid2 = ltid();
        if (more) gload(chunk_of(i + 1), tid2);
        LAS unsigned char* bb = lds + (i & 1) * G_BUF;
        LAS unsigned char* qb = bb + G_QOFF; LAS unsigned char* kb = bb + G_KOFF; LAS unsigned char* vb = bb + G_VOFF;
        const LAS float* dec = (const LAS float*)(bb + G_DOFF);
        if (!OUT) { if (tid < 128) gd *= dec[tid]; }
        if (OUT) {
            f32x16 o[2];
#pragma unroll
            for (int e = 0; e < 16; ++e) { o[0][e] = 0.f; o[1][e] = 0.f; }
#pragma unroll
            for (int st = 0; st < 2; ++st)
#pragma unroll
                for (int tt = 0; tt < 2; ++tt) {
                    if (dir ? (st == 0 && tt == 1) : (st == 1 && tt == 0)) continue;
                    f32x16 am;
#pragma unroll
                    for (int e = 0; e < 16; ++e) am[e] = 0.f;
#pragma unroll
                    for (int ks = 0; ks < 8; ++ks) {
                        const bf16x8 a = *(const LAS bf16x8*)(kb + (32 * st + l32) * 272 + (16 * ks + 8 * hh) * 2);
                        const bf16x8 bq = *(const LAS bf16x8*)(qb + (32 * tt + l32) * 272 + (16 * ks + 8 * hh) * 2);
                        am = MFMA32(a, bq, am);
                    }
                    const int t = 32 * tt + l32;
#pragma unroll
                    for (int e = 0; e < 16; ++e) { const int s = 32 * st + (e >> 2) * 8 + 4 * hh + (e & 3); const bool keep = dir ? (t <= s) : (t >= s); am[e] = keep ? am[e] : 0.f; }
                    const bf16x8 pm0 = pack8(am[0], am[1], am[2], am[3], am[4], am[5], am[6], am[7]);
                    const bf16x8 pm1 = pack8(am[8], am[9], am[10], am[11], am[12], am[13], am[14], am[15]);
                    const bf16x8 a0 = tr_perm(vb, 528, 32 * st, 32 * w, lane);
                    o[tt] = MFMA32(a0, pm0, o[tt]);
                    const bf16x8 a1 = tr_perm(vb, 528, 32 * st + 16, 32 * w, lane);
                    o[tt] = MFMA32(a1, pm1, o[tt]);
                    __builtin_amdgcn_sched_barrier(0);
                }
#pragma unroll
            for (int dt = 0; dt < 4; ++dt)
#pragma unroll
                for (int ks2 = 0; ks2 < 2; ++ks2) {
                    const bf16x8 a = pack8(S[dt][8 * ks2], S[dt][8 * ks2 + 1], S[dt][8 * ks2 + 2], S[dt][8 * ks2 + 3], S[dt][8 * ks2 + 4], S[dt][8 * ks2 + 5], S[dt][8 * ks2 + 6], S[dt][8 * ks2 + 7]);
#pragma unroll
                    for (int tt = 0; tt < 2; ++tt) {
                        LAS unsigned char* qa = qb + (32 * tt + l32) * 272 + (32 * dt + 16 * ks2 + 4 * hh) * 2;
                        const bf16x4 x = *(const LAS bf16x4*)qa, y = *(const LAS bf16x4*)(qa + 16);
                        const bf16x8 bq = __builtin_shufflevector(x, y, 0, 1, 2, 3, 4, 5, 6, 7);
                        o[tt] = MFMA32(a, bq, o[tt]);
                    }
                    __builtin_amdgcn_sched_barrier(0);
                }
            {
                LAS unsigned char* stg = lds + ((i + 1) & 1) * G_BUF + G_VOFF;
#pragma unroll
                for (int tt = 0; tt < 2; ++tt)
#pragma unroll
                    for (int g4 = 0; g4 < 4; ++g4) {
                        const u32x2 pkv = {pk2(o[tt][4 * g4], o[tt][4 * g4 + 1]), pk2(o[tt][4 * g4 + 2], o[tt][4 * g4 + 3])};
                        *(LAS u32x2*)(stg + (32 * tt + l32) * 528 + (32 * w + 8 * g4 + 4 * hh) * 2) = pkv;
                    }
                __syncthreads();
                const size_t rbase = (size_t)ck * 64;
                const int tq = tid2 >> 5, cc = tid2 & 31;
                if (dir == 0) {
#pragma unroll
                    for (int pp = 0; pp < 4; ++pp) {
                        const int t = tq + 16 * pp;
                        *(u32x4*)(MIX + (rbase + t) * DM + h * 256 + cc * 8) = *(const LAS u32x4*)(stg + t * 528 + cc * 16);
                    }
                } else {
                    u32x4 of[4], rg[4];
#pragma unroll
                    for (int pp = 0; pp < 4; ++pp) {
                        const int t = tq + 16 * pp;
                        of[pp] = *(const u32x4*)(MIX + (rbase + t) * DM + h * 256 + cc * 8);
                        rg[pp] = *(const u32x4*)(P + (rbase + t) * LDPO + 2080 + h * 256 + cc * 8);
                    }
                    const f32x4 gn0 = *(const f32x4*)(onorm + cc * 8), gn1 = *(const f32x4*)(onorm + cc * 8 + 4);
#pragma unroll
                    for (int pp = 0; pp < 4; ++pp) {
                        const int t = tq + 16 * pp;
                        const u32x4 ob = *(const LAS u32x4*)(stg + t * 528 + cc * 16);
                        float v[8]; float ss = 0.f;
#pragma unroll
                        for (int e = 0; e < 4; ++e) { v[2 * e] = bflo(ob[e]) + bflo(of[pp][e]); v[2 * e + 1] = bfhi(ob[e]) + bfhi(of[pp][e]); ss += v[2 * e] * v[2 * e] + v[2 * e + 1] * v[2 * e + 1]; }
#pragma unroll
                        for (int o2 = 16; o2 >= 1; o2 >>= 1) ss += __shfl_xor(ss, o2);
                        const float rstd = rsqrtf(ss * (1.f / 256.f) + 1e-6f);
                        u32x4 ov;
#pragma unroll
                        for (int e = 0; e < 4; ++e) {
                            const float g0 = e < 2 ? gn0[2 * e] : gn1[2 * e - 4], g1 = e < 2 ? gn0[2 * e + 1] : gn1[2 * e - 3];
                            ov[e] = pk2(v[2 * e] * rstd * g0 * silu_f(bflo(rg[pp][e])), v[2 * e + 1] * rstd * g1 * silu_f(bfhi(rg[pp][e])));
                        }
                        *(u32x4*)(MIX + (rbase + t) * DM + h * 256 + cc * 8) = ov;
                    }
                }
            }
        }
        if (OUT) { __builtin_amdgcn_sched_barrier(0); }
#pragma unroll
        for (int ks = 0; ks < 4; ++ks) {
            const bf16x8 bv = tr_nat(vb, 528, 16 * ks, 32 * w, lane);
#pragma unroll
            for (int dt = 0; dt < 4; ++dt) { const bf16x8 a = tr_nat(kb, 272, 16 * ks, 32 * dt, lane); S[dt] = MFMA32(a, bv, S[dt]); }
        }
#pragma unroll
        for (int dt = 0; dt < 4; ++dt)
#pragma unroll
            for (int g4 = 0; g4 < 4; ++g4) { const f32x4 dv = *(const LAS f32x4*)(dec + 32 * dt + 8 * g4 + 4 * hh);
#pragma unroll
                for (int e = 0; e < 4; ++e) S[dt][4 * g4 + e] *= dv[e]; }
        if (OUT) __syncthreads();
        if (more) lstore(lds + ((i + 1) & 1) * G_BUF, tid2);
        __syncthreads();
    }
    if (!OUT) { if (tid < 128) gdout[tid] = gd; }
}
__device__ __forceinline__ void s_zero(f32x16 (&S)[4]) {
#pragma unroll
    for (int dt = 0; dt < 4; ++dt)
#pragma unroll
        for (int e = 0; e < 16; ++e) S[dt][e] = 0.f;
}
__device__ __forceinline__ void s_store(const f32x16 (&S)[4], bf16_t* slot) {
    const int lane = ltid() & 63, w = ltid() >> 6, l32 = lane & 31, hh = lane >> 5;
#pragma unroll
    for (int dt = 0; dt < 4; ++dt)
#pragma unroll
        for (int e = 0; e < 16; ++e) slot[(32 * dt + (e >> 2) * 8 + 4 * hh + (e & 3)) * 256 + 32 * w + l32] = f2bf(S[dt][e]);
}
__device__ __forceinline__ void s_load(f32x16 (&S)[4], const bf16_t* slot) {
    const int lane = ltid() & 63, w = ltid() >> 6, l32 = lane & 31, hh = lane >> 5;
#pragma unroll
    for (int dt = 0; dt < 4; ++dt)
#pragma unroll
        for (int e = 0; e < 16; ++e) S[dt][e] = bf2f(slot[(32 * dt + (e >> 2) * 8 + 4 * hh + (e & 3)) * 256 + 32 * w + l32]);
}
__device__ void phase_gla_a(const Params& p, int j, unsigned char* ldsg) {
    bf16_t* SLOC = (bf16_t*)(p.ws + OFF_SLOC); float* GD = (float*)(p.ws + OFF_GD);
    for (int item = blockIdx.x; item < 16 * NSLOT; item += gridDim.x) {
        const int combo = item < 16 * NGRP ? item / NGRP : item - 16 * NGRP, g = item < 16 * NGRP ? item % NGRP : NGRP;
        const int dir = combo & 1, h = (combo >> 1) & 3, b = combo >> 3, slot = combo * NSLOT + g;
        f32x16 S[4]; s_zero(S);
        gla_seq<false>(p, j, (LAS unsigned char*)ldsg, b, h, dir, g == NGRP, g, S, GD + (size_t)slot * 128);
        s_store(S, SLOC + (size_t)slot * 32768);
    }
}
__device__ void phase_gla_b(const Params& p) {
    bf16_t* SLOC = (bf16_t*)(p.ws + OFF_SLOC); const float* GD = (const float*)(p.ws + OFF_GD);
    for (int e = blockIdx.x * 512 + ltid(); e < 16 * 32768; e += gridDim.x * 512) {
        const int combo = e >> 15, dv = e & 32767, d = dv >> 8, dir = combo & 1, base = combo * NSLOT;
        float S = bf2f(SLOC[(size_t)(base + NGRP) * 32768 + dv]);
        for (int q = 0; q < NGRP; ++q) {
            const int g = dir ? NGRP - 1 - q : q;
            const size_t o = (size_t)(base + g) * 32768 + dv;
            const float tmp = bf2f(SLOC[o]); SLOC[o] = f2bf(S); S = GD[(base + g) * 128 + d] * S + tmp;
        }
    }
}
__device__ void phase_gla_c(const Params& p, int j, unsigned char* ldsg) {
    const bf16_t* SLOC = (const bf16_t*)(p.ws + OFF_SLOC);
    for (int item = blockIdx.x; item < 8 * NSLOT; item += gridDim.x) {
        const int bh = item < 8 * NGRP ? (item & 7) : item - 8 * NGRP, g = item < 8 * NGRP ? NGRP - 1 - (item >> 3) : NGRP;
        const int h = bh & 3, b = bh >> 2;
        f32x16 S[4];
        for (int dir = 0; dir < 2; ++dir) {
            if (g == NGRP) s_zero(S); else s_load(S, SLOC + (size_t)((bh * 2 + dir) * NSLOT + g) * 32768);
            gla_seq<true>(p, j, (LAS unsigned char*)ldsg, b, h, dir, g == NGRP, g, S, nullptr);
        }
    }
}

#define XB_TMO      128
#define XB_XCNT(j)  (256  + 64 * (j))
#define XB_XSUB(j)  (1280 + 64 * (j))
#define XB_XGEN(j)  (2304 + 64 * (j))
#define XB_TOP      3328
#define XB_TOPGEN   3392
#define XCD_BAR_WORDS 3456
#define XB_SPIN_CAP (1u << 18)
__device__ __forceinline__ unsigned xb_ld(unsigned* p)              { return __hip_atomic_load(p, __ATOMIC_RELAXED, __HIP_MEMORY_SCOPE_AGENT); }
__device__ __forceinline__ unsigned xb_add(unsigned* p, unsigned v) { return __hip_atomic_fetch_add(p, v, __ATOMIC_RELAXED, __HIP_MEMORY_SCOPE_AGENT); }
__device__ __forceinline__ unsigned xb_xcc_id() { return (unsigned)__builtin_amdgcn_s_getreg((3 << 11) | 20) & 0xFu; }
#define XB_SPIN(cond, bar) do { unsigned _sp = 0; while (cond) { __builtin_amdgcn_s_sleep(1); \
    if ((++_sp & 255u) == 0u) { if (xb_ld(&(bar)[XB_TMO])) break; if (_sp > XB_SPIN_CAP) { atomicAdd(&(bar)[XB_TMO], 1u); break; } } } } while (0)
struct XcdBarrier { unsigned* bar; unsigned x; volatile LAS unsigned* st; };
__device__ __forceinline__ XcdBarrier xcd_barrier_post(unsigned* bar, volatile LAS unsigned* st) {
    XcdBarrier b; b.bar = bar; b.x = xb_xcc_id(); b.st = st;
    if (threadIdx.x == 0) (void)xb_add(&bar[XB_XCNT(b.x)], 1u);
    return b;
}
__device__ __forceinline__ void xcd_barrier_complete(unsigned* bar, unsigned x, unsigned& nloc, unsigned& nx) {
    const unsigned G = gridDim.x * gridDim.y * gridDim.z;
    unsigned sum, cnt, mine, sp = 0u;
    for (;;) {
        sum = 0u; cnt = 0u; mine = 0u;
#pragma unroll
        for (unsigned j = 0; j < 16; ++j) { const unsigned c = xb_ld(&bar[XB_XCNT(j)]); sum += c; cnt += (c > 0u) ? 1u : 0u; mine = (j == x) ? c : mine; }
        if (sum == G) break;
        __builtin_amdgcn_s_sleep(1);
        if ((++sp & 255u) == 0u) { if (xb_ld(&bar[XB_TMO])) break; if (sp > XB_SPIN_CAP) { atomicAdd(&bar[XB_TMO], 1u); break; } }
    }
    nloc = mine > 0u ? mine : 1u; nx = cnt > 0u ? cnt : 1u;
}
__device__ __forceinline__ void xcd_barrier(const XcdBarrier& b) {
    asm volatile("s_waitcnt vmcnt(0)" ::: "memory");
    __syncthreads();
    if (threadIdx.x == 0) {
        unsigned* bar = b.bar;
        __builtin_amdgcn_s_waitcnt(0);
        unsigned nloc = b.st[0], nx = b.st[1];
        if (nloc == 0u) { xcd_barrier_complete(bar, b.x, nloc, nx); b.st[0] = nloc; b.st[1] = nx; }
        const unsigned old = xb_add(&bar[XB_XSUB(b.x)], 1u);
        const unsigned gen = old / nloc;
        if (old + 1u == (gen + 1u) * nloc) {
            __builtin_amdgcn_fence(__ATOMIC_RELEASE, "agent");
            asm volatile("s_waitcnt vmcnt(0)" ::: "memory");
            const unsigned og = xb_add(&bar[XB_TOP], 1u);
            const unsigned tg = og / nx;
            if (og + 1u == (tg + 1u) * nx) xb_add(&bar[XB_TOPGEN], 1u);
            else XB_SPIN(xb_ld(&bar[XB_TOPGEN]) == tg, bar);
            __builtin_amdgcn_fence(__ATOMIC_ACQUIRE, "agent");
            xb_add(&bar[XB_XGEN(b.x)], 1u);
            asm volatile("s_waitcnt vmcnt(0)" ::: "memory");
        } else {
            XB_SPIN(xb_ld(&bar[XB_XGEN(b.x)]) == gen, bar);
            __builtin_amdgcn_fence(__ATOMIC_ACQUIRE, "agent");
            asm volatile("s_waitcnt vmcnt(0)" ::: "memory");
        }
    }
    __syncthreads();
}
#ifndef PROBE_REP
#define PROBE_REP 0
#endif
#ifndef PHM
#define PHM 0xFFFF
#endif
#define PH(b) if (PHM & (1 << (b)))
enum { K_N1 = 0, K_GIN, K_PREP, K_GQ, K_GKV, K_ATT, K_GPREP, K_GA, K_GB, K_GC, K_GOUT, K_N2, K_GUP, K_GDN, K_COPY, K_NONE, K_KMAX };
__global__ void __launch_bounds__(512, 2) mega(Params p) {
    extern __shared__ __attribute__((aligned(16))) unsigned char ldsg[];
    LAS unsigned char* lds = (LAS unsigned char*)ldsg;
    cg::grid_group grid = cg::this_grid();
    unsigned char* ws = p.ws;
    float* MOD = (float*)(ws + OFF_MOD);
    float* XC = (float*)(ws + OFF_XC);
    bf16_t* H = (bf16_t*)(ws + OFF_H); bf16_t* MIX = (bf16_t*)(ws + OFF_MIX);
    bf16_t* PB = (bf16_t*)(ws + OFF_BIG);
    const bool en_even = p.flags & 1, en_odd = p.flags & 2, en_mlp = p.flags & 4;

    volatile LAS unsigned* xst = (volatile LAS unsigned*)(lds + LDS_BYTES - 16);
    if (threadIdx.x == 0) { xst[0] = 0u; xst[1] = 0u; }
    __syncthreads();
    const XcdBarrier xbar = xcd_barrier_post((unsigned*)(ws + OFF_BAR), xst);
    PH(0) phase_ada(p, ldsg);
    grid.sync();
    for (int step = 0; step < 44; ++step) {
        const int i = step / 11, s = step % 11, j = i >> 1; const bool even = !(i & 1);
        const float* mod = MOD + (size_t)i * 3 * 6144;
        const bool en_mix = even ? en_even : en_odd;
        const bool first = (i == 0) && (s <= 7);
        const float* xl = first ? p.in[0] : p.out; const float* xc = ((i == 0) && (s <= 8)) ? p.in[2] : XC;
        float* PART = (float*)(ws + OFF_PART);
        int kind;
        switch (s) {
            case 0: kind = K_N1; break;
            case 1: kind = K_GIN; break;
            case 2: kind = even ? K_PREP : K_GPREP; break;
            case 3: kind = even ? K_GQ : K_GA; break;
            case 4: kind = even ? K_GKV : K_GB; break;
            case 5: kind = even ? K_KMAX : K_GC; break;
            case 6: kind = even ? K_ATT : K_NONE; break;
            case 7: kind = K_GOUT; break;
            case 8: kind = K_N2; break;
            case 9: kind = K_GUP; break;
            default: kind = K_GDN; break;
        }
        if (s <= 7 && !en_mix) kind = (s == 0) ? K_NONE : ((i == 0 && s == 7) ? K_COPY : K_NONE);
        if (s >= 8 && !en_mlp) kind = K_NONE;
        if (s == 0) { PH(1) phase_weights(p, i, ldsg); }
        if (kind == K_NONE) { if (s == 0) xcd_barrier(xbar); continue; }
        bool gemmB = false, gemmR = false, nosync = false;
        pg8::EpiB EB; EB.O = PB; EB.ldo = 0; EB.rs = nullptr; EB.mode = 0;
        pg8::EpiR ER; ER.xin_l = xl; ER.xin_c = xc; ER.xout_l = p.out; ER.xout_c = XC; ER.gate = mod;
        const bf16_t* gA = H; const bf16_t* gB = (const bf16_t*)(ws + OFF_WIN); int lda = 1024, ldb = 1024, gN = 1024, gK = 1024, gM = R, nP = 0, Kp = 256;
        const int reps = ((p.flags >> (8 + kind)) & 1) ? 2 : 1;
        for (int rep = 0; rep < reps; ++rep) {
        if (rep) __syncthreads();
        switch (kind) {
            case K_N1: PH(2) phase_norm(xl, xc, p.in[6] + i * 1024, mod, 0, 1, H, R, i > 0 ? PART : nullptr, 8, mod - 3 * 6144 + 2 * 6144 + 5 * 1024, XC); break;
            case K_N2: PH(2) phase_norm(xl, xc, p.in[7] + i * 1024, mod, 3, 4, H, i < 3 ? R : RL, PART, 4, mod + 2 * 6144 + 2 * 1024, XC); break;
            case K_GIN: gemmB = true; gN = even ? 1792 : 3328; EB.ldo = gN; break;
            case K_PREP: PH(4) phase_even_prep(p, j, ldsg); break;
            case K_GQ: gemmB = true; nosync = true; gA = PB; lda = LDPE; gB = (const bf16_t*)(ws + OFF_WUQ); ldb = 384; gN = 768; gK = 384; EB.O = (bf16_t*)(ws + OFF_Q); EB.ldo = 768; EB.rs = (const float*)(ws + OFF_RSQ); break;
            case K_GKV: gemmB = true; gA = PB + 384; lda = LDPE; gB = (const bf16_t*)(ws + OFF_WUKV); ldb = 256; gN = 1024; gK = 256; EB.O = (bf16_t*)(ws + OFF_KV); EB.ldo = 1024; EB.rs = (const float*)(ws + OFF_RSKV); break;
            case K_KMAX: PH(4) phase_kmax(p, ldsg); break;
            case K_ATT: PH(5) phase_attn(p, ldsg); break;
            case K_GPREP: PH(6) phase_gla_prep(p, j, ldsg); break;
            case K_GA: PH(7) phase_gla_a(p, j, ldsg); break;
            case K_GB: PH(8) phase_gla_b(p); break;
            case K_GC: PH(9) phase_gla_c(p, j, ldsg); break;
            case K_GOUT: gemmR = true; gA = MIX; gB = (const bf16_t*)(ws + OFF_WOUT); ER.gate = mod + 2 * 1024; gM = RL; nP = i < 3 ? 4 : 0; Kp = 256; break;
            case K_GUP: gemmB = true; gB = (const bf16_t*)(ws + OFF_W1); gN = 4096; EB.ldo = 4096; EB.mode = 1; gM = i < 3 ? R : RL; break;
            case K_GDN: gemmR = true; gA = PB; lda = 4096; gB = (const bf16_t*)(ws + OFF_W2); ldb = 4096; gK = 4096; ER.gate = mod + 5 * 1024; gM = RL; nP = i < 3 ? 8 : 0; Kp = 512; break;
            case K_COPY:
                for (size_t e = (size_t)blockIdx.x * 512 + ltid(); e < (size_t)R * 256; e += (size_t)gridDim.x * 512) {
                    const size_t row = e >> 8, c4 = (e & 255) * 4;
                    if (row < RL) *(f32x4*)(p.out + row * DM + c4) = *(const f32x4*)(xl + row * DM + c4);
                    else *(f32x4*)(XC + (row - RL) * DM + c4) = *(const f32x4*)(xc + (row - RL) * DM + c4);
                }
                break;
            default: break;
        }
        if (gemmB) { PH(3) run_gemm(lds, gA, lda, gB, ldb, gM, gN, gK, EB, kind == K_GKV); }
        if (gemmR) { PH(10) { run_gemm(lds, gA, lda, gB, ldb, gM, gN, gK, ER); if (nP) run_pieces(lds, gA + (size_t)RL * lda, lda, gB, ldb, nP, Kp, PART); } }
        }
        if (!nosync) xcd_barrier(xbar);
    }
    PH(11) phase_final(p.in[26], p.out);
}

extern "C" void kernel_launch(void* const* d_in, const int* in_sizes, int n_in, void* d_out, int out_size, void* d_ws, size_t ws_size, hipStream_t stream) {
    static int grid = 0;
    if (grid == 0) {
        if (n_in != 27 || ws_size < WS_NEED) { fprintf(stderr, "kernel_launch: unexpected n_in %d / ws %zu\n", n_in, ws_size); grid = -1; return; }
        int dev = 0, cus = 0, per_cu = 0;
        hipGetDevice(&dev);
        hipDeviceGetAttribute(&cus, hipDeviceAttributeMultiprocessorCount, dev);
        hipFuncSetAttribute((const void*)mega, hipFuncAttributeMaxDynamicSharedMemorySize, LDS_BYTES);
        hipOccupancyMaxActiveBlocksPerMultiprocessor(&per_cu, (const void*)mega, 512, LDS_BYTES);
        (void)hipGetLastError();
        if (per_cu < 1) fprintf(stderr, "kernel_launch: occupancy query reports %d blocks per CU\n", per_cu);
        grid = cus > 0 ? cus : 256;
    }
    if (grid < 0) return;
    if (hipMemsetAsync((char*)d_ws + OFF_BAR, 0, 16384, stream) != hipSuccess) { fprintf(stderr, "kernel_launch: memset failed\n"); return; }
    Params p{};
    for (int i = 0; i < 27; ++i) p.in[i] = (const float*)d_in[i];
    p.out = (float*)d_out; p.ws = (unsigned char*)d_ws; p.flags = 7 | PROBE_REP;
    void* args[] = {&p};
    hipError_t e = hipLaunchCooperativeKernel((const void*)mega, dim3(grid), dim3(512), args, LDS_BYTES, stream);
    if (e != hipSuccess) fprintf(stderr, "cooperative launch failed: %s (grid %d)\n", hipGetErrorString(e), grid);
}
```

```cpp
#include <hip/hip_runtime.h>
#include <hip/hip_cooperative_groups.h>
#include <cstdio>
namespace cg = cooperative_groups;

#define LAS __attribute__((address_space(3)))
typedef unsigned short bf16_t;
typedef short bf16x8 __attribute__((ext_vector_type(8)));
typedef short bf16x4 __attribute__((ext_vector_type(4)));
typedef float f32x4 __attribute__((ext_vector_type(4)));
typedef float f32x16 __attribute__((ext_vector_type(16)));
typedef unsigned u32x4 __attribute__((ext_vector_type(4)));
typedef unsigned u32x2 __attribute__((ext_vector_type(2)));

constexpr int R = 33280, RL = 32768, DM = 1024;
constexpr int LDPE = 1792, LDPO = 3328;
constexpr size_t MiB = (size_t)1 << 20;
constexpr size_t OFF_WIN = 0, OFF_WOUT = 8 * MiB, OFF_WUQ = 10 * MiB, OFF_WUKV = 11 * MiB, OFF_WCM = 12 * MiB, OFF_W1 = 13 * MiB, OFF_W2 = 21 * MiB;
constexpr size_t OFF_MOD = 30 * MiB, OFF_XC = 31 * MiB, OFF_RSQ = 33 * MiB, OFF_RSKV = 33 * MiB + 256 * 1024, OFF_GD = 36 * MiB + 640 * 1024;
constexpr size_t OFF_BAR = 33 * MiB + 768 * 1024;
constexpr size_t OFF_KMS = 33 * MiB + 800 * 1024;
constexpr size_t OFF_DECF = 34 * MiB, OFF_DECB = 35 * MiB + 512 * 1024;
constexpr size_t OFF_H = 37 * MiB, OFF_MIX = 102 * MiB, OFF_BIG = 167 * MiB, OFF_G = 427 * MiB;
constexpr size_t OFF_Q = OFF_BIG + 114 * MiB, OFF_KV = OFF_BIG + 163 * MiB, OFF_KR = OFF_BIG + 228 * MiB;
constexpr size_t OFF_QTF = OFF_H, OFF_KTF = OFF_H + 34078720, OFF_QTB = OFF_BIG + 212 * MiB, OFF_SLOC = OFF_G, OFF_KTB = OFF_G + 34 * MiB;
constexpr size_t OFF_PART = 494 * MiB;
constexpr size_t WS_NEED = 510 * MiB;
constexpr int LDS_BYTES = 144 * 1024;

struct Params {
    const float* in[27];
    float* out;
    unsigned char* ws;
    long long flags;
};

__device__ __forceinline__ float bf2f(bf16_t b) { return __uint_as_float(((unsigned)b) << 16); }
__device__ __forceinline__ float bflo(unsigned u) { return __uint_as_float(u << 16); }
__device__ __forceinline__ float bfhi(unsigned u) { return __uint_as_float(u & 0xffff0000u); }
__device__ __forceinline__ bf16_t f2bf(float f) { unsigned u = __float_as_uint(f); u += 0x7FFFu + ((u >> 16) & 1u); return (bf16_t)(u >> 16); }
typedef __bf16 hwbf2_t __attribute__((ext_vector_type(2)));
typedef float f32x2v_t __attribute__((ext_vector_type(2)));
__device__ __forceinline__ unsigned pk2(float lo, float hi) { const f32x2v_t v = {lo, hi}; const hwbf2_t b = __builtin_convertvector(v, hwbf2_t); return __builtin_bit_cast(unsigned, b); }
__device__ __forceinline__ bf16x8 pack8(float a0, float a1, float a2, float a3, float a4, float a5, float a6, float a7) {
    u32x4 u = {pk2(a0, a1), pk2(a2, a3), pk2(a4, a5), pk2(a6, a7)};
    return __builtin_bit_cast(bf16x8, u);
}
__device__ __forceinline__ float wsum(float v) {
#pragma unroll
    for (int o = 32; o >= 1; o >>= 1) v += __shfl_xor(v, o);
    return v;
}
__device__ __forceinline__ float gelu_t(float x) { const float u = 0.7978845608f * (x + 0.044715f * x * x * x); return x / (1.f + __expf(-2.f * u)); }
__device__ __forceinline__ float silu_f(float x) { return x / (1.f + __expf(-x)); }
__device__ __forceinline__ void sincos_red(float ang, float& s, float& c) {
    const float k = rintf(ang * 0.15915494309f);
    float r = fmaf(-k, 6.2831854820251465f, ang);
    r = fmaf(-k, -1.7484555e-7f, r);
    s = __sinf(r); c = __cosf(r);
}
__device__ __forceinline__ float rope_inv(int jj) { return exp2f(-(float)jj * 1.6609640474f); }

__device__ __forceinline__ bf16x4 tr16(LAS unsigned char* a) { return __builtin_amdgcn_ds_read_tr16_b64_v4i16((LAS bf16x4*)a); }
__device__ __forceinline__ bf16x8 tr_nat(LAS unsigned char* base, int stride, int k0, int n0, int lane) {
    const int i = lane & 15, q = i >> 2, pq = i & 3, hh = lane >> 5, g1 = (lane >> 4) & 1;
    LAS unsigned char* a0 = base + (k0 + 8 * hh + q) * stride + (n0 + 16 * g1 + 4 * pq) * 2;
    const bf16x4 x = tr16(a0), y = tr16(a0 + 4 * stride);
    return __builtin_shufflevector(x, y, 0, 1, 2, 3, 4, 5, 6, 7);
}
__device__ __forceinline__ bf16x8 tr_perm(LAS unsigned char* base, int stride, int k0, int n0, int lane) {
    const int i = lane & 15, q = i >> 2, pq = i & 3, hh = lane >> 5, g1 = (lane >> 4) & 1;
    LAS unsigned char* a0 = base + (k0 + 4 * hh + q) * stride + (n0 + 16 * g1 + 4 * pq) * 2;
    const bf16x4 x = tr16(a0), y = tr16(a0 + 8 * stride);
    return __builtin_shufflevector(x, y, 0, 1, 2, 3, 4, 5, 6, 7);
}
__device__ __forceinline__ int ltid() { int t = threadIdx.x; asm volatile("" : "+v"(t)); return t; }
#define MFMA32(a, b, c) __builtin_amdgcn_mfma_f32_32x32x16_bf16((a), (b), (c), 0, 0, 0)

namespace pg8 {
constexpr int BM = 256, BK = 64, HALF = 128, HTB = HALF * BK * 2, STAGE_BYTES = 8 * HTB, NXCD = 8, WGM = 8;
__device__ __forceinline__ int lds_byte(int r, int c) { const int st = (r >> 4) * 2 + (c >> 5), rr = r & 15, cc = c & 31, ob = rr * 64 + cc * 2; return st * 1024 + (ob ^ (((ob >> 9) & 1) << 5)); }
__device__ __forceinline__ void stage_rc(int b, int& Rr, int& C) { const int st = b / 1024, sb = b % 1024, swz = sb ^ (((sb >> 9) & 1) << 5); Rr = (st >> 1) * 16 + swz / 64; C = (st & 1) * 32 + (swz % 64) / 2; }
__device__ __forceinline__ int perm32(int rho) { const int n = rho >> 4, i = rho & 15; return 8 * (i >> 2) + 4 * n + (i & 3); }
struct Unit { int pm, pn, ko; };
struct Gemm { const bf16_t* A; const bf16_t* Bt; int lda, ldb, M, N, K; };
struct StaticOrder {
    int nM, nN, nwg, G, c;
    __device__ void init(int M, int N, int G_, int c_) { nM = M / BM; nN = N / BM; nwg = nM * nN; G = G_; c = c_; }
    __device__ bool next(int i, Unit& u) const {
        const long L = (long)i * G + c; if (L >= nwg) return false;
        int wgid = (int)L; { const int q = nwg / NXCD, r = nwg % NXCD, xcd = wgid % NXCD, off = wgid / NXCD; wgid = (xcd < r ? xcd * (q + 1) : r * (q + 1) + (xcd - r) * q) + off; }
        const int nig = WGM * nN, gid = wgid / nig, fm = gid * WGM, gsz = (nM - fm) < WGM ? (nM - fm) : WGM;
        u.pm = fm + ((wgid % nig) % gsz); u.pn = (wgid % nig) / gsz; u.ko = 0; return true;
    }
};
struct PieceOrder {
    int nP, Kp, G, c;
    __device__ bool next(int i, Unit& u) const {
        const long L = (long)i * G + c; if (L >= 8 * nP) return false;
        const int kp = (int)L >> 3, r = (int)L & 7; u.pm = r >> 2; u.pn = r & 3; u.ko = kp * Kp; return true;
    }
};

template <class Epi, class Sched>
__device__ __forceinline__ void gemm_phase(LAS unsigned char* lds, const Gemm g, const Sched& S, const Epi& E) {
    const int tid = ltid(), wid = __builtin_amdgcn_readfirstlane(tid >> 6), lane = tid & 63, wr = wid >> 2, wc = wid & 3, fr = lane & 15, fq = lane >> 4;
    const int K = g.K, nt = K / BK;
    unsigned voffA[2], voffB[2];
#pragma unroll
    for (int i = 0; i < 2; ++i) { int Rr, C; stage_rc(tid * 16 + i * 8192, Rr, C); const int Rb = Epi::PERM ? ((Rr & ~31) + perm32(Rr & 31)) : Rr;
        voffA[i] = (unsigned)(Rr * g.lda + C) * 2u; voffB[i] = (unsigned)(Rb * g.ldb + C) * 2u; }
    const size_t kstep = (size_t)(BK * 2);
    const size_t hA = (size_t)HALF * g.lda * 2, hB = (size_t)HALF * g.ldb * 2;
    const size_t tA = 2 * hA, tB = 2 * hB;
    const unsigned ldsw = (unsigned)wid * 1024u;
    const int aoff = lds_byte(wr * 64 + fr, fq * 8), boff = lds_byte(wc * 32 + fr, fq * 8);
#define PG8_SA(b, h) (((b) * 2 + (h)) * HTB)
#define PG8_SB(b, h) ((4 + (b) * 2 + (h)) * HTB)
#define PG8_STAGE(bufoff, gbase, voff) do { _Pragma("unroll") for (int _i = 0; _i < 2; ++_i) \
        __builtin_amdgcn_global_load_lds((const unsigned*)((const char*)(gbase) + (voff)[_i]), (LAS unsigned*)(lds + (bufoff) + ldsw + _i * 8192), 16, 0, 0); } while (0)
#define PG8_LDA(dst, b, h) do { _Pragma("unroll") for (int m = 0; m < 4; ++m) _Pragma("unroll") for (int k = 0; k < 2; ++k) dst[m][k] = *(const LAS bf16x8*)(lds + PG8_SA(b, h) + aoff + m * 2048 + k * 1024); } while (0)
#define PG8_LDB(dst, b, h) do { _Pragma("unroll") for (int n = 0; n < 2; ++n) _Pragma("unroll") for (int k = 0; k < 2; ++k) dst[n][k] = *(const LAS bf16x8*)(lds + PG8_SB(b, h) + boff + n * 2048 + k * 1024); } while (0)
#define PG8_MMA(ai, bj, At, Bt) do { __builtin_amdgcn_s_setprio(1); _Pragma("unroll") for (int m = 0; m < 4; ++m) _Pragma("unroll") for (int n = 0; n < 2; ++n) _Pragma("unroll") for (int k = 0; k < 2; ++k) \
        acc[ai][bj][m][n] = __builtin_amdgcn_mfma_f32_16x16x32_bf16(Bt[n][k], At[m][k], acc[ai][bj][m][n], 0, 0, 0); __builtin_amdgcn_s_setprio(0); } while (0)
#define PG8_WAIT_V(n) asm volatile("s_waitcnt vmcnt(" #n ")" ::: "memory")
#define PG8_WAIT_L(n) asm volatile("s_waitcnt lgkmcnt(" #n ")" ::: "memory")
#define PG8_BAR __builtin_amdgcn_s_barrier()
#define PG8_SCHED __builtin_amdgcn_sched_barrier(0)
    Unit cur, nxt; int ui = 0;
    if (!S.next(0, cur)) return;
    f32x4 acc[2][2][4][2];
#pragma unroll
    for (int a = 0; a < 2; ++a)
#pragma unroll
        for (int b = 0; b < 2; ++b)
#pragma unroll
            for (int m = 0; m < 4; ++m)
#pragma unroll
                for (int n = 0; n < 2; ++n) acc[a][b][m][n] = (f32x4){0.f, 0.f, 0.f, 0.f};
    bf16x8 At[4][2], B0[2][2], B1[2][2];
    const char* cA = (const char*)g.A + (size_t)cur.pm * tA + (size_t)cur.ko * 2; const char* cB = (const char*)g.Bt + (size_t)cur.pn * tB + (size_t)cur.ko * 2;
    PG8_STAGE(PG8_SB(0, 0), cB, voffB); PG8_STAGE(PG8_SA(0, 0), cA, voffA); PG8_STAGE(PG8_SB(0, 1), cB + hB, voffB); PG8_STAGE(PG8_SA(0, 1), cA + hA, voffA);
    if (wr == 1) PG8_BAR;
    PG8_WAIT_V(4); PG8_BAR;
    PG8_STAGE(PG8_SB(1, 0), cB + kstep, voffB); PG8_STAGE(PG8_SA(1, 0), cA + kstep, voffA); PG8_STAGE(PG8_SB(1, 1), cB + hB + kstep, voffB);
    PG8_WAIT_V(6); PG8_BAR;
    for (;;) {
        const bool has_next = S.next(ui + 1, nxt);
        const char* nA = has_next ? (const char*)g.A + (size_t)nxt.pm * tA + (size_t)nxt.ko * 2 : cA; const char* nB = has_next ? (const char*)g.Bt + (size_t)nxt.pn * tB + (size_t)nxt.ko * 2 : cB;
        for (int t = 0; t < nt; t += 2) {
            const bool last = (t == nt - 2);
            const char* a1 = cA + (size_t)(t + 1) * kstep;
            const char* a2 = last ? nA : cA + (size_t)(t + 2) * kstep; const char* b2 = last ? nB : cB + (size_t)(t + 2) * kstep;
            const char* a3 = a2 + kstep; const char* b3 = b2 + kstep;
            PG8_LDB(B0, 0, 0); PG8_SCHED; PG8_LDA(At, 0, 0); PG8_STAGE(PG8_SA(1, 1), a1 + hA, voffA);
            PG8_WAIT_L(8); PG8_BAR; PG8_WAIT_L(0); PG8_MMA(0, 0, At, B0); PG8_BAR; PG8_SCHED;
            PG8_LDB(B1, 0, 1); PG8_STAGE(PG8_SB(0, 0), b2, voffB);
            PG8_BAR; PG8_WAIT_L(0); PG8_MMA(0, 1, At, B1); PG8_BAR;
            PG8_LDA(At, 0, 1); PG8_STAGE(PG8_SA(0, 0), a2, voffA);
            PG8_BAR; PG8_WAIT_L(0); PG8_MMA(1, 0, At, B0); PG8_BAR; PG8_SCHED;
            PG8_STAGE(PG8_SB(0, 1), b2 + hB, voffB);
            PG8_WAIT_V(6); PG8_BAR; PG8_MMA(1, 1, At, B1); PG8_BAR;
            PG8_LDB(B0, 1, 0); PG8_SCHED; PG8_LDA(At, 1, 0); PG8_STAGE(PG8_SA(0, 1), a2 + hA, voffA);
            PG8_WAIT_L(8); PG8_BAR; PG8_WAIT_L(0); PG8_MMA(0, 0, At, B0); PG8_BAR; PG8_SCHED;
            PG8_LDB(B1, 1, 1); PG8_STAGE(PG8_SB(1, 0), b3, voffB);
            PG8_BAR; PG8_WAIT_L(0); PG8_MMA(0, 1, At, B1); PG8_BAR;
            PG8_LDA(At, 1, 1); PG8_STAGE(PG8_SA(1, 0), a3, voffA);
            PG8_BAR; PG8_WAIT_L(0); PG8_MMA(1, 0, At, B0); PG8_BAR; PG8_SCHED;
            PG8_STAGE(PG8_SB(1, 1), b3 + hB, voffB);
            PG8_WAIT_V(6); PG8_BAR; PG8_MMA(1, 1, At, B1); PG8_BAR;
        }
        E(acc, cur, wr, wc, fr, fq);
        if (!has_next) break;
#pragma unroll
        for (int a = 0; a < 2; ++a)
#pragma unroll
            for (int b = 0; b < 2; ++b)
#pragma unroll
                for (int m = 0; m < 4; ++m)
#pragma unroll
                    for (int n = 0; n < 2; ++n) acc[a][b][m][n] = (f32x4){0.f, 0.f, 0.f, 0.f};
        cur = nxt; cA = nA; cB = nB; ++ui;
    }
    PG8_WAIT_V(0);
    if (wr == 0) PG8_BAR;
    PG8_BAR;
#undef PG8_SA
#undef PG8_SB
#undef PG8_STAGE
#undef PG8_LDA
#undef PG8_LDB
#undef PG8_MMA
#undef PG8_WAIT_V
#undef PG8_WAIT_L
#undef PG8_BAR
#undef PG8_SCHED
}

struct EpiB {
    static constexpr bool PERM = true;
    bf16_t* O; int ldo; const float* rs; int mode;
    __device__ __forceinline__ void operator()(const f32x4 (&acc)[2][2][4][2], const Unit& u, int wr, int wc, int fr, int fq) const {
        const int row0 = u.pm * BM + wr * 64 + fr, col0 = u.pn * BM + wc * 32 + 8 * fq;
#pragma unroll
        for (int ai = 0; ai < 2; ++ai)
#pragma unroll
            for (int m = 0; m < 4; ++m) {
                const int row = row0 + ai * HALF + m * 16;
                const float s = rs ? rs[row] : 1.f;
                bf16_t* rowp = O + (size_t)row * ldo + col0;
#pragma unroll
                for (int bj = 0; bj < 2; ++bj) {
                    f32x4 v0 = acc[ai][bj][m][0] * s, v1 = acc[ai][bj][m][1] * s;
                    if (mode == 1) {
#pragma unroll
                        for (int e = 0; e < 4; ++e) { const float a = fmaxf(v0[e], 0.f), b = fmaxf(v1[e], 0.f); v0[e] = a * a; v1[e] = b * b; }
                    }
                    const u32x4 o = {pk2(v0[0], v0[1]), pk2(v0[2], v0[3]), pk2(v1[0], v1[1]), pk2(v1[2], v1[3])};
                    *(u32x4*)(rowp + bj * HALF) = o;
                }
            }
    }
};
struct EpiR {
    static constexpr bool PERM = false;
    const float* xin_l; const float* xin_c; float* xout_l; float* xout_c; const float* gate;
    __device__ __forceinline__ void operator()(const f32x4 (&acc)[2][2][4][2], const Unit& u, int wr, int wc, int fr, int fq) const {
        const int var = u.pm < 64 ? 0 : (u.pm < 128 ? 1 : 2);
        const float* gp = gate + var * 6144;
        const int rowt = (u.pm < 128 ? u.pm : u.pm - 128) * BM + wr * 64 + fr;
        const float* xi = u.pm < 128 ? xin_l : xin_c; float* xo = u.pm < 128 ? xout_l : xout_c;
        const int col0 = u.pn * BM + wc * 32 + 4 * fq;
        f32x4 gv[2][2];
#pragma unroll
        for (int bj = 0; bj < 2; ++bj)
#pragma unroll
            for (int n = 0; n < 2; ++n) gv[bj][n] = *(const f32x4*)(gp + col0 + bj * HALF + n * 16);
#pragma unroll
        for (int ai = 0; ai < 2; ++ai)
#pragma unroll
            for (int m = 0; m < 4; ++m) {
                const size_t ro = (size_t)(rowt + ai * HALF + m * 16) * DM + col0;
#pragma unroll
                for (int bj = 0; bj < 2; ++bj)
#pragma unroll
                    for (int n = 0; n < 2; ++n) {
                        const f32x4 x = *(const f32x4*)(xi + ro + bj * HALF + n * 16);
                        *(f32x4*)(xo + ro + bj * HALF + n * 16) = x + gv[bj][n] * acc[ai][bj][m][n];
                    }
            }
    }
};
struct EpiP {
    static constexpr bool PERM = false;
    float* part; int kpiece;
    __device__ __forceinline__ void operator()(const f32x4 (&acc)[2][2][4][2], const Unit& u, int wr, int wc, int fr, int fq) const {
        const int kp = u.ko / kpiece;
        const int rowt = u.pm * BM + wr * 64 + fr, col0 = u.pn * BM + wc * 32 + 4 * fq;
        float* base = part + (size_t)kp * 512 * DM;
#pragma unroll
        for (int ai = 0; ai < 2; ++ai)
#pragma unroll
            for (int m = 0; m < 4; ++m) {
                const size_t ro = (size_t)(rowt + ai * HALF + m * 16) * DM + col0;
#pragma unroll
                for (int bj = 0; bj < 2; ++bj)
#pragma unroll
                    for (int n = 0; n < 2; ++n) *(f32x4*)(base + ro + bj * HALF + n * 16) = acc[ai][bj][m][n];
            }
    }
};
}

template <class Epi>
__device__ __forceinline__ void run_gemm(LAS unsigned char* lds, const bf16_t* A, int lda, const bf16_t* Bt, int ldb, int M, int N, int K, const Epi& E, bool rev = false) {
    pg8::Gemm g; g.A = A; g.Bt = Bt; g.lda = lda; g.ldb = ldb; g.M = M; g.N = N; g.K = K;
    pg8::StaticOrder S; S.init(M, N, (int)gridDim.x, rev ? (int)(gridDim.x - 1 - blockIdx.x) : (int)blockIdx.x);
    pg8::gemm_phase<Epi, pg8::StaticOrder>(lds, g, S, E);
}
__device__ __forceinline__ void run_pieces(LAS unsigned char* lds, const bf16_t* A, int lda, const bf16_t* Bt, int ldb, int nP, int Kp, float* part) {
    pg8::Gemm g; g.A = A; g.Bt = Bt; g.lda = lda; g.ldb = ldb; g.M = 512; g.N = 1024; g.K = Kp;
    pg8::PieceOrder S; S.nP = nP; S.Kp = Kp; S.G = (int)gridDim.x; S.c = (int)blockIdx.x;
    pg8::EpiP E; E.part = part; E.kpiece = Kp;
    pg8::gemm_phase<pg8::EpiP, pg8::PieceOrder>(lds, g, S, E);
}

__device__ void phase_ada(const Params& p, unsigned char* ldsg) {
    float* sl = (float*)ldsg;
    float* red = sl + 3072;
    const int tid = ltid();
    float* MOD = (float*)(p.ws + OFF_MOD);
    for (int idx = tid; idx < 3072; idx += 512) { const int var = idx >> 10, k = idx & 1023; const float v = var < 2 ? p.in[1][var * 1024 + k] : p.in[3][k]; sl[idx] = silu_f(v); }
    __syncthreads();
    for (int item = blockIdx.x; item < 192; item += gridDim.x) {
        const int i = item / 48, cb = item % 48, cc = tid & 127, kq = tid >> 7, col = cb * 128 + cc;
        const float* w = p.in[4] + ((size_t)i * 1024 + kq * 256) * 6144 + col;
        const float* s0 = sl + kq * 256;
        float a0 = 0.f, a1 = 0.f, a2 = 0.f;
#pragma unroll 8
        for (int k = 0; k < 256; ++k) { const float wv = w[(size_t)k * 6144]; a0 = fmaf(s0[k], wv, a0); a1 = fmaf(s0[1024 + k], wv, a1); a2 = fmaf(s0[2048 + k], wv, a2); }
        red[(kq * 3 + 0) * 128 + cc] = a0; red[(kq * 3 + 1) * 128 + cc] = a1; red[(kq * 3 + 2) * 128 + cc] = a2;
        __syncthreads();
        if (tid < 384) { const int var = tid >> 7, c2 = tid & 127; float s = p.in[5][i * 6144 + cb * 128 + c2];
#pragma unroll
            for (int q = 0; q < 4; ++q) s += red[(q * 3 + var) * 128 + c2];
            MOD[(size_t)(i * 3 + var) * 6144 + cb * 128 + c2] = s; }
        __syncthreads();
    }
}

__device__ void tjob(const float* src, int K, int N, int Npad, bf16_t* dst, const float* rs, float mult, unsigned char* ldsg) {
    float* tile = (float*)ldsg;
    const int tid = ltid(), ntk = K / 64, ntn = Npad / 64;
    for (int t = blockIdx.x; t < ntk * ntn; t += gridDim.x) {
        const int tk = t % ntk, tn = t / ntk;
        const int nl = tid & 63, kl0 = tid >> 6;
#pragma unroll
        for (int j = 0; j < 8; ++j) { const int kl = kl0 + 8 * j, k = tk * 64 + kl, n = tn * 64 + nl;
            float v = n < N ? src[(size_t)k * N + n] : 0.f; if (rs) v *= rs[k]; tile[kl * 65 + nl] = v * mult; }
        __syncthreads();
        const int nl2 = tid >> 3, kc = tid & 7;
        u32x4 o;
#pragma unroll
        for (int e = 0; e < 4; ++e) o[e] = pk2(tile[(kc * 8 + 2 * e) * 65 + nl2], tile[(kc * 8 + 2 * e + 1) * 65 + nl2]);
        *(u32x4*)(dst + (size_t)(tn * 64 + nl2) * K + tk * 64 + kc * 8) = o;
        __syncthreads();
    }
}
__device__ void phase_weights(const Params& p, int i, unsigned char* ldsg) {
    unsigned char* ws = p.ws; const int j = i >> 1;
    if (!(i & 1)) {
        tjob(p.in[10] + (size_t)j * 1024 * 1696, 1024, 1696, 1792, (bf16_t*)(ws + OFF_WIN), nullptr, 1.f, ldsg);
        tjob(p.in[12] + (size_t)j * 384 * 768, 384, 768, 768, (bf16_t*)(ws + OFF_WUQ), p.in[11] + j * 384, 0.10206207262f * 1.44269504089f, ldsg);
        tjob(p.in[14] + (size_t)j * 256 * 1024, 256, 1024, 1024, (bf16_t*)(ws + OFF_WUKV), p.in[13] + j * 256, 1.f, ldsg);
        tjob(p.in[18] + (size_t)j * 1024 * 1024, 1024, 1024, 1024, (bf16_t*)(ws + OFF_WOUT), nullptr, 1.f, ldsg);
        bf16_t* wcm = (bf16_t*)(ws + OFF_WCM); const float* src = p.in[16] + (size_t)j * 65536;
        for (int e = blockIdx.x * 512 + ltid(); e < 65536; e += gridDim.x * 512) wcm[e] = f2bf(src[e]);
    } else {
        tjob(p.in[19] + (size_t)j * 1024 * 3104, 1024, 3104, 3328, (bf16_t*)(ws + OFF_WIN), nullptr, 1.f, ldsg);
        tjob(p.in[25] + (size_t)j * 1024 * 1024, 1024, 1024, 1024, (bf16_t*)(ws + OFF_WOUT), nullptr, 1.f, ldsg);
    }
    tjob(p.in[8] + (size_t)i * 1024 * 4096, 1024, 4096, 4096, (bf16_t*)(ws + OFF_W1), nullptr, 1.f, ldsg);
    tjob(p.in[9] + (size_t)i * 4096 * 1024, 4096, 1024, 1024, (bf16_t*)(ws + OFF_W2), nullptr, 1.f, ldsg);
}

__device__ void phase_norm(const float* xl, const float* xc, const float* g, const float* mod  , int shift_i, int scale_i, bf16_t* H,
                           int nrows, const float* part, int npart, const float* pgate, float* xc_out) {
    const int lane = ltid() & 63, gw = blockIdx.x * 8 + (ltid() >> 6), nw = gridDim.x * 8;
    f32x4 xn[4];
    if (gw < nrows) { const float* src = gw < RL ? xl + (size_t)gw * DM : xc + (size_t)(gw - RL) * DM;
#pragma unroll
        for (int q = 0; q < 4; ++q) xn[q] = *(const f32x4*)(src + q * 256 + lane * 4); }
    for (int row = gw; row < nrows; row += nw) {
        const int var = row < 16384 ? 0 : (row < RL ? 1 : 2);
        const float* sh = mod + var * 6144 + shift_i * 1024; const float* sc = mod + var * 6144 + scale_i * 1024;
        f32x4 x[4]; float ss = 0.f;
#pragma unroll
        for (int q = 0; q < 4; ++q) x[q] = xn[q];
        { const int nr = row + nw;
          if (nr < nrows) { const float* src = nr < RL ? xl + (size_t)nr * DM : xc + (size_t)(nr - RL) * DM;
#pragma unroll
              for (int q = 0; q < 4; ++q) xn[q] = *(const f32x4*)(src + q * 256 + lane * 4); } }
        if (row >= RL && part) {
#pragma unroll
            for (int q = 0; q < 4; ++q) { const int c = q * 256 + lane * 4;
                f32x4 acc = {0.f, 0.f, 0.f, 0.f};
                for (int kp = 0; kp < npart; ++kp) acc += *(const f32x4*)(part + ((size_t)kp * 512 + (row - RL)) * DM + c);
                x[q] += *(const f32x4*)(pgate + c) * acc;
                *(f32x4*)(xc_out + (size_t)(row - RL) * DM + c) = x[q]; }
        }
#pragma unroll
        for (int q = 0; q < 4; ++q) ss += x[q][0] * x[q][0] + x[q][1] * x[q][1] + x[q][2] * x[q][2] + x[q][3] * x[q][3];
        ss = wsum(ss);
        const float rstd = rsqrtf(ss * (1.f / 1024.f) + 1e-6f);
#pragma unroll
        for (int q = 0; q < 4; ++q) { const int c = q * 256 + lane * 4;
            const f32x4 gg = *(const f32x4*)(g + c), s1 = *(const f32x4*)(sc + c), s0 = *(const f32x4*)(sh + c);
            float o[4];
#pragma unroll
            for (int e = 0; e < 4; ++e) o[e] = x[q][e] * rstd * gg[e] * (1.f + s1[e]) + s0[e];
            const u32x2 pk = {pk2(o[0], o[1]), pk2(o[2], o[3])};
            *(u32x2*)(H + (size_t)row * DM + c) = pk; }
    }
}
__device__ void phase_final(const float* g, float* X) {
    const int lane = ltid() & 63, gw = blockIdx.x * 8 + (ltid() >> 6), nw = gridDim.x * 8;
    f32x4 xn[4];
    if (gw < RL) {
#pragma unroll
        for (int q = 0; q < 4; ++q) xn[q] = *(const f32x4*)(X + (size_t)gw * DM + q * 256 + lane * 4); }
    for (int row = gw; row < RL; row += nw) {
        float* src = X + (size_t)row * DM;
        f32x4 x[4]; float ss = 0.f;
#pragma unroll
        for (int q = 0; q < 4; ++q) { x[q] = xn[q]; ss += x[q][0] * x[q][0] + x[q][1] * x[q][1] + x[q][2] * x[q][2] + x[q][3] * x[q][3]; }
        if (row + nw < RL) {
#pragma unroll
            for (int q = 0; q < 4; ++q) xn[q] = *(const f32x4*)(X + (size_t)(row + nw) * DM + q * 256 + lane * 4); }
        ss = wsum(ss);
        const float rstd = rsqrtf(ss * (1.f / 1024.f) + 1e-6f);
#pragma unroll
        for (int q = 0; q < 4; ++q) { const int c = q * 256 + lane * 4; const f32x4 gg = *(const f32x4*)(g + c); *(f32x4*)(src + c) = x[q] * rstd * gg; }
    }
}

__device__ void phase_even_prep(const Params& p, int j, unsigned char* ldsg) {
    unsigned char* ws = p.ws;
    const bf16_t* P = (const bf16_t*)(ws + OFF_BIG);
    float* RSQ = (float*)(ws + OFF_RSQ); float* RSKV = (float*)(ws + OFF_RSKV);
    bf16_t* KR = (bf16_t*)(ws + OFF_KR); bf16_t* MIX = (bf16_t*)(ws + OFF_MIX);
    const int tid = ltid(), lane = tid & 63, w = tid >> 6, l32 = lane & 31, hh = lane >> 5;
    {
        const int gw = blockIdx.x * 8 + w, nw = gridDim.x * 8;
        for (int row = gw; row < R; row += nw) {
            const bf16_t* pr = P + (size_t)row * LDPE;
            float ss = 0.f;
#pragma unroll
            for (int q = 0; q < 3; ++q) { const unsigned u = *(const unsigned*)(pr + 2 * lane + 128 * q); const float a = bflo(u), b = bfhi(u); ss += a * a + b * b; }
            ss = wsum(ss);
            const u32x2 u2 = *(const u32x2*)(pr + 384 + 4 * lane);
            float s2 = bflo(u2[0]) * bflo(u2[0]) + bfhi(u2[0]) * bfhi(u2[0]) + bflo(u2[1]) * bflo(u2[1]) + bfhi(u2[1]) * bfhi(u2[1]);
            s2 = wsum(s2);
            if (lane == 0) { RSQ[row] = rsqrtf(ss * (1.f / 384.f) + 1e-6f); RSKV[row] = rsqrtf(s2 * (1.f / 256.f) + 1e-6f); }
            const float x = bf2f(pr[640 + l32]); const float y = __shfl_xor(x, 8);
            float o = x;
            if (row < RL) { const int l = row & 16383; const float pos = (float)(l32 < 16 ? (l >> 6) : (l & 63));
                float s, c; sincos_red(pos * rope_inv(l32 & 7), s, c);
                o = (l32 & 8) ? x * c + y * s : x * c - y * s; }
            if (lane < 32) KR[(size_t)row * 32 + lane] = f2bf(o);
        }
    }
    LAS unsigned char* lds = (LAS unsigned char*)ldsg;
    const bf16_t* WCM = (const bf16_t*)(ws + OFF_WCM);
    const float* cmn = p.in[15] + j * 128; const float* bs = p.in[17] + j * 512;
    for (int item = blockIdx.x; item < 1040; item += gridDim.x) {
        const int n = item >> 2, g = item & 3, r0 = n * 128;
        {
            const int s = tid >> 2, cq = tid & 3;
            const bf16_t* src = P + (size_t)(r0 + s) * LDPE + 1184 + g * 128 + cq * 32;
            float v[32]; float ss = 0.f;
#pragma unroll
            for (int q = 0; q < 4; ++q) { const u32x4 u = *(const u32x4*)(src + q * 8);
#pragma unroll
                for (int e = 0; e < 4; ++e) { const float a = gelu_t(bflo(u[e])), b = gelu_t(bfhi(u[e])); v[q * 8 + 2 * e] = a; v[q * 8 + 2 * e + 1] = b; ss += a * a + b * b; } }
            ss += __shfl_xor(ss, 1); ss += __shfl_xor(ss, 2);
            const float rstd = rsqrtf(ss * (1.f / 128.f) + 1e-6f);
#pragma unroll
            for (int q = 0; q < 4; ++q) { u32x4 o;
#pragma unroll
                for (int e = 0; e < 4; ++e) { const int c = cq * 32 + q * 8 + 2 * e; o[e] = pk2(v[q * 8 + 2 * e] * rstd * cmn[c], v[q * 8 + 2 * e + 1] * rstd * cmn[c + 1]); }
                *(LAS u32x4*)(lds + s * 272 + (cq * 32 + q * 8) * 2) = o; }
        }
        __syncthreads();
        const int tt = w >> 1, cp = (w & 1) * 2;
        f32x16 acc[2];
#pragma unroll
        for (int e = 0; e < 16; ++e) { acc[0][e] = 0.f; acc[1][e] = 0.f; }
#pragma unroll
        for (int ks = 0; ks < 8; ++ks) {
            const bf16x8 a = *(const bf16x8*)(WCM + g * 16384 + (32 * tt + l32) * 128 + 16 * ks + 8 * hh);
#pragma unroll
            for (int ct = 0; ct < 2; ++ct) { const bf16x8 b = tr_nat(lds, 272, 16 * ks, 32 * (cp + ct), lane); acc[ct] = MFMA32(a, b, acc[ct]); }
        }
#pragma unroll
        for (int ct = 0; ct < 2; ++ct)
#pragma unroll
            for (int i = 0; i < 16; ++i) {
                const int t = 32 * tt + (i >> 2) * 8 + 4 * hh + (i & 3), c = 32 * (cp + ct) + l32;
                const float val = acc[ct][i] + bs[g * 128 + t];
                const float u = gelu_t(bf2f(P[(size_t)(r0 + t) * LDPE + 672 + g * 128 + c]));
                MIX[(size_t)(r0 + t) * DM + 512 + g * 128 + c] = f2bf(u * val);
            }
        __syncthreads();
    }
}

__device__ void phase_kmax(const Params& p, unsigned char* ldsg) {
    unsigned char* ws = p.ws;
    const bf16_t* KV = (const bf16_t*)(ws + OFF_KV); const bf16_t* KR = (const bf16_t*)(ws + OFF_KR);
    float* KMS = (float*)(ws + OFF_KMS);
    float* red = (float*)ldsg;
    const int tid = ltid(), lane = tid & 63, w = tid >> 6, h = lane >> 3, jj = lane & 7;
    float mx0 = 0.f, mx1 = 0.f;
    for (int row = blockIdx.x * 8 + w; row < R; row += gridDim.x * 8) {
        const u32x4 a = *(const u32x4*)(KV + (size_t)row * 1024 + h * 128 + jj * 8);
        const u32x4 r = *(const u32x4*)(KR + (size_t)row * 32 + (jj & 3) * 8);
        float ss = 0.f, sr = 0.f;
#pragma unroll
        for (int e = 0; e < 4; ++e) { ss += bflo(a[e]) * bflo(a[e]) + bfhi(a[e]) * bfhi(a[e]); sr += bflo(r[e]) * bflo(r[e]) + bfhi(r[e]) * bfhi(r[e]); }
        ss += 0.5f * sr;
        ss += __shfl_xor(ss, 1); ss += __shfl_xor(ss, 2); ss += __shfl_xor(ss, 4);
        const int b = row < 16384 ? 0 : (row < RL ? 1 : ((row - RL) >> 8));
        if (b == 0) mx0 = fmaxf(mx0, ss); else mx1 = fmaxf(mx1, ss);
    }
    if (jj == 0) { red[w * 16 + h] = mx0; red[w * 16 + 8 + h] = mx1; }
    __syncthreads();
    if (tid < 16) { float m = red[tid];
#pragma unroll
        for (int q = 1; q < 8; ++q) m = fmaxf(m, red[q * 16 + tid]);
        KMS[blockIdx.x * 16 + tid] = m; }
    __syncthreads();
}

__device__ void phase_attn(const Params& p, unsigned char* ldsg) {
    unsigned char* ws = p.ws;
    const bf16_t* Q = (const bf16_t*)(ws + OFF_Q); const bf16_t* KV = (const bf16_t*)(ws + OFF_KV); const bf16_t* KR = (const bf16_t*)(ws + OFF_KR);
    bf16_t* MIX = (bf16_t*)(ws + OFF_MIX);
    LAS unsigned char* lds = (LAS unsigned char*)ldsg;
    const int tid = ltid(), lane = tid & 63, w = tid >> 6, l32 = lane & 31, hh = lane >> 5;
    constexpr int KROW = 208, VROW = 192, KBUF = 64 * KROW, VBUF = 64 * VROW, VBASE = 4 * KBUF;
    for (int it = blockIdx.x; it < 1040; it += gridDim.x) {
        int b, h, q0row, nkt; bool isctx;
        if (it < 1024) { h = it & 7; const int rest = it >> 3; b = rest >> 6; q0row = b * 16384 + (rest & 63) * 256; nkt = 260; isctx = false; }
        else { const int e = it - 1024; b = e >> 3; h = e & 7; q0row = RL + b * 256; nkt = 4; isctx = true; }
        const int qrow = q0row + w * 32 + l32;
        const bf16_t* qp = Q + (size_t)qrow * 768 + h * 96;
        bf16x8 qf[6];
#pragma unroll
        for (int s = 0; s < 4; ++s) qf[s] = *(const bf16x8*)(qp + 16 * s + 8 * hh);
#pragma unroll
        for (int s = 4; s < 6; ++s) {
            const bf16x8 own = *(const bf16x8*)(qp + 16 * s + 8 * hh);
            const bf16x8 oth = *(const bf16x8*)(qp + 16 * s + 8 * (1 - hh));
            if (!isctx) {
                const int l = qrow & 16383; const float pos = (float)(s == 4 ? (l >> 6) : (l & 63));
                float r[8];
#pragma unroll
                for (int jj = 0; jj < 8; ++jj) { float sn, cs; sincos_red(pos * rope_inv(jj), sn, cs);
                    const float x = bf2f((bf16_t)own[jj]), y = bf2f((bf16_t)oth[jj]); r[jj] = hh ? x * cs + y * sn : x * cs - y * sn; }
                qf[s] = pack8(r[0], r[1], r[2], r[3], r[4], r[5], r[6], r[7]);
            } else qf[s] = own;
        }
        float negm;
        {
            float qs = 0.f;
#pragma unroll
            for (int s = 0; s < 6; ++s)
#pragma unroll
                for (int e = 0; e < 8; ++e) { const float x = bf2f((bf16_t)qf[s][e]); qs += x * x; }
            qs += __shfl_xor(qs, 32);
            const float* KMS = (const float*)(ws + OFF_KMS) + b * 8 + h;
            float km = 0.f;
            for (int q = lane; q < (int)gridDim.x; q += 64) km = fmaxf(km, KMS[q * 16]);
#pragma unroll
            for (int o2 = 32; o2 >= 1; o2 >>= 1) km = fmaxf(km, __shfl_xor(km, o2));
            negm = -sqrtf(qs * km) * 1.0001f - 1e-3f;
        }
        const bf16_t* kp[2]; int kst[2]; int kdo[2]; bool kv_[2];
#pragma unroll
        for (int pp = 0; pp < 2; ++pp) {
            int c = tid + 512 * pp; if (c >= 768) c -= 512; kv_[pp] = true; const int key = c / 12, part = c % 12;
            if (part < 8) { kp[pp] = KV + (size_t)key * 1024 + h * 128 + part * 8; kst[pp] = 1024; }
            else { kp[pp] = KR + (size_t)key * 32 + (part - 8) * 8; kst[pp] = 32; }
            kdo[pp] = key * KROW + part * 16;
        }
        const bf16_t* vp = KV + (size_t)(tid >> 3) * 1024 + h * 128 + 64 + (tid & 7) * 8; const int vdo = (tid >> 3) * VROW + (tid & 7) * 16;
        auto rowbase = [&](int kt) -> int { return isctx ? (RL + b * 256 + kt * 64) : (kt < 256 ? b * 16384 + kt * 64 : RL + b * 256 + (kt - 256) * 64); };
        u32x4 prk[2], prv;
        auto loadK = [&](int kt) { const int rb = rowbase(kt);
#pragma unroll
            for (int pp = 0; pp < 2; ++pp) prk[pp] = *(const u32x4*)(kp[pp] + (size_t)rb * kst[pp]); };
        auto storeK = [&](int buf) {
#pragma unroll
            for (int pp = 0; pp < 2; ++pp) *(LAS u32x4*)(lds + buf * KBUF + kdo[pp]) = prk[pp]; };
        auto loadV = [&](int kt) { prv = *(const u32x4*)(vp + (size_t)rowbase(kt) * 1024); };
        auto storeV = [&](int buf) { *(LAS u32x4*)(lds + VBASE + buf * VBUF + vdo) = prv; };
        f32x16 pA[2], pB[2];
        f32x16 o[2];
#pragma unroll
        for (int e = 0; e < 16; ++e) { o[0][e] = 0.f; o[1][e] = 0.f; }
        float lsum = 0.f;
        auto qk = [&](int buf, f32x16 (&st)[2]) {
            LAS unsigned char* kb = lds + buf * KBUF;
#pragma unroll
            for (int e = 0; e < 16; ++e) { st[0][e] = negm; st[1][e] = negm; }
#pragma unroll
            for (int half = 0; half < 2; ++half) {
                bf16x8 kf[6];
#pragma unroll
                for (int s = 0; s < 3; ++s) {
                    kf[2 * s] = *(const LAS bf16x8*)(kb + l32 * KROW + (16 * (3 * half + s) + 8 * hh) * 2);
                    kf[2 * s + 1] = *(const LAS bf16x8*)(kb + (32 + l32) * KROW + (16 * (3 * half + s) + 8 * hh) * 2);
                }
                __builtin_amdgcn_sched_barrier(0);
#pragma unroll
                for (int s = 0; s < 3; ++s) { st[0] = MFMA32(kf[2 * s], qf[3 * half + s], st[0]); st[1] = MFMA32(kf[2 * s + 1], qf[3 * half + s], st[1]); }
            }
        };
        auto partialSM = [&](f32x16 (&pp)[2]) {
#pragma unroll
            for (int e = 0; e < 16; ++e) pp[0][e] = __builtin_amdgcn_exp2f(pp[0][e]);
        };
        bf16x8 pa[4];
        auto finishSM = [&](f32x16 (&pp)[2]) {
#pragma unroll
            for (int e = 0; e < 16; ++e) pp[1][e] = __builtin_amdgcn_exp2f(pp[1][e]);
            float ps = 0.f;
#pragma unroll
            for (int e = 0; e < 16; ++e) ps += pp[0][e] + pp[1][e];
            lsum += ps;
            pa[0] = pack8(pp[0][0], pp[0][1], pp[0][2], pp[0][3], pp[0][4], pp[0][5], pp[0][6], pp[0][7]);
            pa[1] = pack8(pp[0][8], pp[0][9], pp[0][10], pp[0][11], pp[0][12], pp[0][13], pp[0][14], pp[0][15]);
            pa[2] = pack8(pp[1][0], pp[1][1], pp[1][2], pp[1][3], pp[1][4], pp[1][5], pp[1][6], pp[1][7]);
            pa[3] = pack8(pp[1][8], pp[1][9], pp[1][10], pp[1][11], pp[1][12], pp[1][13], pp[1][14], pp[1][15]);
        };
        auto pv = [&](int buf) {
            LAS unsigned char* vb = lds + VBASE + buf * VBUF;
#pragma unroll
            for (int vt = 0; vt < 2; ++vt) {
                bf16x8 vf[4];
#pragma unroll
                for (int q = 0; q < 4; ++q) vf[q] = tr_perm(vb, VROW, 16 * q, 32 * vt, lane);
                __builtin_amdgcn_sched_barrier(0);
#pragma unroll
                for (int q = 0; q < 4; ++q) o[vt] = MFMA32(vf[q], pa[q], o[vt]);
            }
        };
        auto step = [&](int j, f32x16 (&pc)[2], f32x16 (&pn)[2], bool bar) {
            const int jk = j + 3 < nkt ? j + 3 : nkt - 1, jv = j + 2 < nkt ? j + 2 : nkt - 1;
            __builtin_amdgcn_sched_barrier(0);
            qk((j + 1) & 3, pn);
            finishSM(pc);
            __builtin_amdgcn_sched_barrier(0);
            loadK(jk); loadV(jv);
            __builtin_amdgcn_sched_barrier(0);
            pv(j & 3);
            partialSM(pn);
            __builtin_amdgcn_sched_barrier(0);
            storeK((j + 3) & 3); storeV((j + 2) & 3);
            if (bar) __syncthreads();
        };
        {
            u32x4 k0[2], k1[2], v0, v1;
            loadK(0); k0[0] = prk[0]; k0[1] = prk[1]; loadV(0); v0 = prv;
            loadK(1); k1[0] = prk[0]; k1[1] = prk[1]; loadV(1); v1 = prv;
            loadK(2); storeK(2);
            prk[0] = k0[0]; prk[1] = k0[1]; prv = v0; storeK(0); storeV(0);
            prk[0] = k1[0]; prk[1] = k1[1]; prv = v1; storeK(1); storeV(1);
        }
        __syncthreads();
        qk(0, pA); partialSM(pA);
        __syncthreads();
        for (int kt = 0; kt + 2 < nkt; kt += 2) {
            step(kt, pA, pB, false);
            step(kt + 1, pB, pA, true);
        }
        step(nkt - 2, pA, pB, true);
        finishSM(pB);
        pv((nkt - 1) & 3);
        __syncthreads();
        lsum += __shfl_xor(lsum, 32);
        const float inv = 1.f / lsum;
        bf16_t* op = MIX + (size_t)qrow * DM + h * 64;
#pragma unroll
        for (int vt = 0; vt < 2; ++vt)
#pragma unroll
            for (int g4 = 0; g4 < 4; ++g4) {
                const u32x2 pk = {pk2(o[vt][4 * g4] * inv, o[vt][4 * g4 + 1] * inv), pk2(o[vt][4 * g4 + 2] * inv, o[vt][4 * g4 + 3] * inv)};
                *(u32x2*)(op + 32 * vt + 8 * g4 + 4 * hh) = pk;
            }
    }
}

__device__ void phase_gla_prep(const Params& p, int j, unsigned char* ldsg) {
    unsigned char* ws = p.ws;
    const bf16_t* P = (const bf16_t*)(ws + OFF_BIG);
    bf16_t* QTF = (bf16_t*)(ws + OFF_QTF); bf16_t* KTF = (bf16_t*)(ws + OFF_KTF); bf16_t* QTB = (bf16_t*)(ws + OFF_QTB); bf16_t* KTB = (bf16_t*)(ws + OFF_KTB);
    float* DECF = (float*)(ws + OFF_DECF); float* DECB = (float*)(ws + OFF_DECB);
    float* zl = (float*)ldsg;
    float* seg = zl + 2048;
    const int tid = ltid();
    const float* wgf = p.in[20] + (size_t)j * 16 * 512; const float* wgb = p.in[22] + (size_t)j * 16 * 512;
    const float* bgf = p.in[21] + j * 512; const float* bgb = p.in[23] + j * 512;
    for (int item = blockIdx.x; item < 2080; item += gridDim.x) {
        const int ck = item >> 2, h = item & 3, r0 = ck * 64;
        { const int t = tid >> 3, j0 = (tid & 7) * 4; const u32x2 u = *(const u32x2*)(P + (size_t)(r0 + t) * LDPO + 1536 + j0);
          zl[t * 32 + j0] = bflo(u[0]); zl[t * 32 + j0 + 1] = bfhi(u[0]); zl[t * 32 + j0 + 2] = bflo(u[1]); zl[t * 32 + j0 + 3] = bfhi(u[1]); }
        __syncthreads();
        const int d = tid & 127, tq = tid >> 7, hd = h * 128 + d;
        float wf[16], wb[16];
#pragma unroll
        for (int q = 0; q < 16; ++q) { wf[q] = wgf[q * 512 + hd]; wb[q] = wgb[q * 512 + hd]; }
        const float bf_ = bgf[hd], bb_ = bgb[hd];
        float lf[16], lb[16];
#pragma unroll
        for (int i = 0; i < 16; ++i) {
            const float* zr = zl + (tq * 16 + i) * 32;
            float gf = bf_, gb = bb_;
#pragma unroll
            for (int q = 0; q < 16; ++q) { gf = fmaf(zr[q], wf[q], gf); gb = fmaf(zr[16 + q], wb[q], gb); }
            lf[i] = (fminf(gf, 0.f) - __logf(1.f + __expf(-fabsf(gf)))) * 0.0625f;
            lb[i] = (fminf(gb, 0.f) - __logf(1.f + __expf(-fabsf(gb)))) * 0.0625f;
        }
        float run = 0.f;
#pragma unroll
        for (int i = 0; i < 16; ++i) { run += lf[i]; lf[i] = run; }
        const float segF = run; run = 0.f;
#pragma unroll
        for (int i = 15; i >= 0; --i) { run += lb[i]; lb[i] = run; }
        const float segB = run;
        seg[tq * 128 + d] = segF; seg[512 + tq * 128 + d] = segB;
        __syncthreads();
        float offF = 0.f, totF = 0.f, offB = 0.f, totB = 0.f;
#pragma unroll
        for (int q = 0; q < 4; ++q) { const float a = seg[q * 128 + d], b2 = seg[512 + q * 128 + d]; totF += a; totB += b2; if (q < tq) offF += a; if (q > tq) offB += b2; }
#pragma unroll
        for (int i = 0; i < 16; ++i) {
            const size_t row = (size_t)(r0 + tq * 16 + i);
            const float q = bf2f(P[row * LDPO + 1568 + hd]) * 0.08838834764f, k = bf2f(P[row * LDPO + hd]);
            const float cf = lf[i] + offF, cb = lb[i] + offB;
            QTF[row * 512 + hd] = f2bf(q * __expf(cf)); KTF[row * 512 + hd] = f2bf(k * __expf(-cf));
            QTB[row * 512 + hd] = f2bf(q * __expf(cb)); KTB[row * 512 + hd] = f2bf(k * __expf(-cb));
        }
        if (tq == 0) { DECF[(size_t)(ck * 4 + h) * 128 + d] = __expf(totF); DECB[(size_t)(ck * 4 + h) * 128 + d] = __expf(totB); }
        __syncthreads();
    }
}

constexpr int NGRP = 32, NSLOT = NGRP + 1;
__device__ __forceinline__ int gstart(int g) { return g < 27 ? 8 * g : (g < 31 ? 216 + 9 * (g - 27) : 252); }
__device__ __forceinline__ int gsize(int g) { return g < 27 ? 8 : (g < 31 ? 9 : 4); }
constexpr int G_QOFF = 0, G_KOFF = 17408, G_VOFF = 34816, G_DOFF = 68608, G_BUF = 69120, G_SSQ = 2 * G_BUF;
template <bool OUT>
__device__ __forceinline__ void gla_seq(const Params& p, int j, LAS unsigned char* lds, int b, int h, int dir, bool ctx, int g, f32x16 (&S)[4], float* gdout) {
    unsigned char* ws = p.ws;
    const bf16_t* P = (const bf16_t*)(ws + OFF_BIG);
    const bf16_t* QT = (const bf16_t*)(ws + (dir ? OFF_QTB : OFF_QTF)); const bf16_t* KT = (const bf16_t*)(ws + (dir ? OFF_KTB : OFF_KTF));
    const float* DEC = (const float*)(ws + (dir ? OFF_DECB : OFF_DECF));
    bf16_t* MIX = (bf16_t*)(ws + OFF_MIX);
    const float* onorm = p.in[24] + j * 256;
    const int tid = ltid(), lane = tid & 63, w = tid >> 6, l32 = lane & 31, hh = lane >> 5;
    const int nsteps = ctx ? 4 : gsize(g), g0 = gstart(g);
    auto chunk_of = [&](int i) -> int { const int c = ctx ? (dir ? 3 - i : i) : (dir ? g0 + nsteps - 1 - i : g0 + i); return ctx ? 512 + b * 4 + c : b * 256 + c; };
    u32x4 pq[2], pk[2], pv[4], pd;
    auto gload = [&](int ck, int tid) {
        const size_t rb = (size_t)ck * 64;
#pragma unroll
        for (int pp = 0; pp < 2; ++pp) { const int c = tid + 512 * pp, row = c >> 4, cc = c & 15;
            if (OUT) pq[pp] = *(const u32x4*)(QT + (rb + row) * 512 + h * 128 + cc * 8);
            pk[pp] = *(const u32x4*)(KT + (rb + row) * 512 + h * 128 + cc * 8); }
#pragma unroll
        for (int pp = 0; pp < 4; ++pp) { const int c = tid + 512 * pp, row = c >> 5, cc = c & 31; pv[pp] = *(const u32x4*)(P + (rb + row) * LDPO + 512 + h * 256 + cc * 8); }
        if (tid < 32) pd = *(const u32x4*)(DEC + (size_t)(ck * 4 + h) * 128 + tid * 4);
    };
    auto lstore = [&](LAS unsigned char* bb, int tid) {
#pragma unroll
        for (int pp = 0; pp < 2; ++pp) { const int c = tid + 512 * pp, row = c >> 4, cc = c & 15;
            if (OUT) *(LAS u32x4*)(bb + G_QOFF + row * 272 + cc * 16) = pq[pp];
            *(LAS u32x4*)(bb + G_KOFF + row * 272 + cc * 16) = pk[pp]; }
#pragma unroll
        for (int pp = 0; pp < 4; ++pp) { const int c = tid + 512 * pp, row = c >> 5, cc = c & 31; *(LAS u32x4*)(bb + G_VOFF + row * 528 + cc * 16) = pv[pp]; }
        if (tid < 32) *(LAS u32x4*)(bb + G_DOFF + tid * 16) = pd;
    };
    float gd = 1.f;
    gload(chunk_of(0), tid); lstore(lds, tid);
    __syncthreads();
    for (int i = 0; i < nsteps; ++i) {
        const bool more = i + 1 < nsteps;
        const int ck = chunk_of(i);
        const int tid2 = ltid();
        if (more) gload(chunk_of(i + 1), tid2);
        LAS unsigned char* bb = lds + (i & 1) * G_BUF;
        LAS unsigned char* qb = bb + G_QOFF; LAS unsigned char* kb = bb + G_KOFF; LAS unsigned char* vb = bb + G_VOFF;
        const LAS float* dec = (const LAS float*)(bb + G_DOFF);
        if (!OUT) { if (tid < 128) gd *= dec[tid]; }
        if (OUT) {
            f32x16 o[2];
#pragma unroll
            for (int e = 0; e < 16; ++e) { o[0][e] = 0.f; o[1][e] = 0.f; }
#pragma unroll
            for (int st = 0; st < 2; ++st)
#pragma unroll
                for (int tt = 0; tt < 2; ++tt) {
                    if (dir ? (st == 0 && tt == 1) : (st == 1 && tt == 0)) continue;
                    f32x16 am;
#pragma unroll
                    for (int e = 0; e < 16; ++e) am[e] = 0.f;
#pragma unroll
                    for (int ks = 0; ks < 8; ++ks) {
                        const bf16x8 a = *(const LAS bf16x8*)(kb + (32 * st + l32) * 272 + (16 * ks + 8 * hh) * 2);
                        const bf16x8 bq = *(const LAS bf16x8*)(qb + (32 * tt + l32) * 272 + (16 * ks + 8 * hh) * 2);
                        am = MFMA32(a, bq, am);
                    }
                    const int t = 32 * tt + l32;
#pragma unroll
                    for (int e = 0; e < 16; ++e) { const int s = 32 * st + (e >> 2) * 8 + 4 * hh + (e & 3); const bool keep = dir ? (t <= s) : (t >= s); am[e] = keep ? am[e] : 0.f; }
                    const bf16x8 pm0 = pack8(am[0], am[1], am[2], am[3], am[4], am[5], am[6], am[7]);
                    const bf16x8 pm1 = pack8(am[8], am[9], am[10], am[11], am[12], am[13], am[14], am[15]);
                    const bf16x8 a0 = tr_perm(vb, 528, 32 * st, 32 * w, lane);
                    o[tt] = MFMA32(a0, pm0, o[tt]);
                    const bf16x8 a1 = tr_perm(vb, 528, 32 * st + 16, 32 * w, lane);
                    o[tt] = MFMA32(a1, pm1, o[tt]);
                    __builtin_amdgcn_sched_barrier(0);
                }
#pragma unroll
            for (int dt = 0; dt < 4; ++dt)
#pragma unroll
                for (int ks2 = 0; ks2 < 2; ++ks2) {
                    const bf16x8 a = pack8(S[dt][8 * ks2], S[dt][8 * ks2 + 1], S[dt][8 * ks2 + 2], S[dt][8 * ks2 + 3], S[dt][8 * ks2 + 4], S[dt][8 * ks2 + 5], S[dt][8 * ks2 + 6], S[dt][8 * ks2 + 7]);
#pragma unroll
                    for (int tt = 0; tt < 2; ++tt) {
                        LAS unsigned char* qa = qb + (32 * tt + l32) * 272 + (32 * dt + 16 * ks2 + 4 * hh) * 2;
                        const bf16x4 x = *(const LAS bf16x4*)qa, y = *(const LAS bf16x4*)(qa + 16);
                        const bf16x8 bq = __builtin_shufflevector(x, y, 0, 1, 2, 3, 4, 5, 6, 7);
                        o[tt] = MFMA32(a, bq, o[tt]);
                    }
                    __builtin_amdgcn_sched_barrier(0);
                }
            {
                LAS unsigned char* stg = lds + ((i + 1) & 1) * G_BUF + G_VOFF;
#pragma unroll
                for (int tt = 0; tt < 2; ++tt)
#pragma unroll
                    for (int g4 = 0; g4 < 4; ++g4) {
                        const u32x2 pkv = {pk2(o[tt][4 * g4], o[tt][4 * g4 + 1]), pk2(o[tt][4 * g4 + 2], o[tt][4 * g4 + 3])};
                        *(LAS u32x2*)(stg + (32 * tt + l32) * 528 + (32 * w + 8 * g4 + 4 * hh) * 2) = pkv;
                    }
                __syncthreads();
                const size_t rbase = (size_t)ck * 64;
                const int tq = tid2 >> 5, cc = tid2 & 31;
                if (dir == 0) {
#pragma unroll
                    for (int pp = 0; pp < 4; ++pp) {
                        const int t = tq + 16 * pp;
                        *(u32x4*)(MIX + (rbase + t) * DM + h * 256 + cc * 8) = *(const LAS u32x4*)(stg + t * 528 + cc * 16);
                    }
                } else {
                    u32x4 of[4], rg[4];
#pragma unroll
                    for (int pp = 0; pp < 4; ++pp) {
                        const int t = tq + 16 * pp;
                        of[pp] = *(const u32x4*)(MIX + (rbase + t) * DM + h * 256 + cc * 8);
                        rg[pp] = *(const u32x4*)(P + (rbase + t) * LDPO + 2080 + h * 256 + cc * 8);
                    }
                    const f32x4 gn0 = *(const f32x4*)(onorm + cc * 8), gn1 = *(const f32x4*)(onorm + cc * 8 + 4);
#pragma unroll
                    for (int pp = 0; pp < 4; ++pp) {
                        const int t = tq + 16 * pp;
                        const u32x4 ob = *(const LAS u32x4*)(stg + t * 528 + cc * 16);
                        float v[8]; float ss = 0.f;
#pragma unroll
                        for (int e = 0; e < 4; ++e) { v[2 * e] = bflo(ob[e]) + bflo(of[pp][e]); v[2 * e + 1] = bfhi(ob[e]) + bfhi(of[pp][e]); ss += v[2 * e] * v[2 * e] + v[2 * e + 1] * v[2 * e + 1]; }
#pragma unroll
                        for (int o2 = 16; o2 >= 1; o2 >>= 1) ss += __shfl_xor(ss, o2);
                        const float rstd = rsqrtf(ss * (1.f / 256.f) + 1e-6f);
                        u32x4 ov;
#pragma unroll
                        for (int e = 0; e < 4; ++e) {
                            const float g0 = e < 2 ? gn0[2 * e] : gn1[2 * e - 4], g1 = e < 2 ? gn0[2 * e + 1] : gn1[2 * e - 3];
                            ov[e] = pk2(v[2 * e] * rstd * g0 * silu_f(bflo(rg[pp][e])), v[2 * e + 1] * rstd * g1 * silu_f(bfhi(rg[pp][e])));
                        }
                        *(u32x4*)(MIX + (rbase + t) * DM + h * 256 + cc * 8) = ov;
                    }
                }
            }
        }
        if (OUT) { __builtin_amdgcn_sched_barrier(0); }
#pragma unroll
        for (int ks = 0; ks < 4; ++ks) {
            const bf16x8 bv = tr_nat(vb, 528, 16 * ks, 32 * w, lane);
#pragma unroll
            for (int dt = 0; dt < 4; ++dt) { const bf16x8 a = tr_nat(kb, 272, 16 * ks, 32 * dt, lane); S[dt] = MFMA32(a, bv, S[dt]); }
        }
#pragma unroll
        for (int dt = 0; dt < 4; ++dt)
#pragma unroll
            for (int g4 = 0; g4 < 4; ++g4) { const f32x4 dv = *(const LAS f32x4*)(dec + 32 * dt + 8 * g4 + 4 * hh);
#pragma unroll
                for (int e = 0; e < 4; ++e) S[dt][4 * g4 + e] *= dv[e]; }
        if (OUT) __syncthreads();
        if (more) lstore(lds + ((i + 1) & 1) * G_BUF, tid2);
        __syncthreads();
    }
    if (!OUT) { if (tid < 128) gdout[tid] = gd; }
}
__device__ __forceinline__ void s_zero(f32x16 (&S)[4]) {
#pragma unroll
    for (int dt = 0; dt < 4; ++dt)
#pragma unroll
        for (int e = 0; e < 16; ++e) S[dt][e] = 0.f;
}
__device__ __forceinline__ void s_store(const f32x16 (&S)[4], bf16_t* slot) {
    const int lane = ltid() & 63, w = ltid() >> 6, l32 = lane & 31, hh = lane >> 5;
#pragma unroll
    for (int dt = 0; dt < 4; ++dt)
#pragma unroll
        for (int e = 0; e < 16; ++e) slot[(32 * dt + (e >> 2) * 8 + 4 * hh + (e & 3)) * 256 + 32 * w + l32] = f2bf(S[dt][e]);
}
__device__ __forceinline__ void s_load(f32x16 (&S)[4], const bf16_t* slot) {
    const int lane = ltid() & 63, w = ltid() >> 6, l32 = lane & 31, hh = lane >> 5;
#pragma unroll
    for (int dt = 0; dt < 4; ++dt)
#pragma unroll
        for (int e = 0; e < 16; ++e) S[dt][e] = bf2f(slot[(32 * dt + (e >> 2) * 8 + 4 * hh + (e & 3)) * 256 + 32 * w + l32]);
}
__device__ void phase_gla_a(const Params& p, int j, unsigned char* ldsg) {
    bf16_t* SLOC = (bf16_t*)(p.ws + OFF_SLOC); float* GD = (float*)(p.ws + OFF_GD);
    for (int item = blockIdx.x; item < 16 * NSLOT; item += gridDim.x) {
        const int combo = item < 16 * NGRP ? item / NGRP : item - 16 * NGRP, g = item < 16 * NGRP ? item % NGRP : NGRP;
        const int dir = combo & 1, h = (combo >> 1) & 3, b = combo >> 3, slot = combo * NSLOT + g;
        f32x16 S[4]; s_zero(S);
        gla_seq<false>(p, j, (LAS unsigned char*)ldsg, b, h, dir, g == NGRP, g, S, GD + (size_t)slot * 128);
        s_store(S, SLOC + (size_t)slot * 32768);
    }
}
__device__ void phase_gla_b(const Params& p) {
    bf16_t* SLOC = (bf16_t*)(p.ws + OFF_SLOC); const float* GD = (const float*)(p.ws + OFF_GD);
    for (int e = blockIdx.x * 512 + ltid(); e < 16 * 32768; e += gridDim.x * 512) {
        const int combo = e >> 15, dv = e & 32767, d = dv >> 8, dir = combo & 1, base = combo * NSLOT;
        float S = bf2f(SLOC[(size_t)(base + NGRP) * 32768 + dv]);
        bf16_t tl[NGRP]; float gl[NGRP];
#pragma unroll
        for (int q = 0; q < NGRP; ++q) { const int g = dir ? NGRP - 1 - q : q; tl[q] = SLOC[(size_t)(base + g) * 32768 + dv]; gl[q] = GD[(base + g) * 128 + d]; }
#pragma unroll
        for (int q = 0; q < NGRP; ++q) {
            const int g = dir ? NGRP - 1 - q : q;
            SLOC[(size_t)(base + g) * 32768 + dv] = f2bf(S); S = gl[q] * S + bf2f(tl[q]);
        }
    }
}
__device__ void phase_gla_c(const Params& p, int j, unsigned char* ldsg) {
    const bf16_t* SLOC = (const bf16_t*)(p.ws + OFF_SLOC);
    for (int item = blockIdx.x; item < 8 * NSLOT; item += gridDim.x) {
        const int bh = item < 8 * NGRP ? (item & 7) : item - 8 * NGRP, g = item < 8 * NGRP ? NGRP - 1 - (item >> 3) : NGRP;
        const int h = bh & 3, b = bh >> 2;
        f32x16 S[4];
        for (int dir = 0; dir < 2; ++dir) {
            if (g == NGRP) s_zero(S); else s_load(S, SLOC + (size_t)((bh * 2 + dir) * NSLOT + g) * 32768);
            gla_seq<true>(p, j, (LAS unsigned char*)ldsg, b, h, dir, g == NGRP, g, S, nullptr);
        }
    }
}

#define XB_TMO      128
#define XB_XCNT(j)  (256  + 64 * (j))
#define XB_XSUB(j)  (1280 + 64 * (j))
#define XB_XGEN(j)  (2304 + 64 * (j))
#define XB_TOP      3328
#define XB_TOPGEN   3392
#define XCD_BAR_WORDS 3456
#define XB_SPIN_CAP (1u << 18)
__device__ __forceinline__ unsigned xb_ld(unsigned* p)              { return __hip_atomic_load(p, __ATOMIC_RELAXED, __HIP_MEMORY_SCOPE_AGENT); }
__device__ __forceinline__ unsigned xb_add(unsigned* p, unsigned v) { return __hip_atomic_fetch_add(p, v, __ATOMIC_RELAXED, __HIP_MEMORY_SCOPE_AGENT); }
__device__ __forceinline__ unsigned xb_xcc_id() { return (unsigned)__builtin_amdgcn_s_getreg((3 << 11) | 20) & 0xFu; }
#define XB_SPIN(cond, bar) do { unsigned _sp = 0; while (cond) { __builtin_amdgcn_s_sleep(1); \
    if ((++_sp & 255u) == 0u) { if (xb_ld(&(bar)[XB_TMO])) break; if (_sp > XB_SPIN_CAP) { atomicAdd(&(bar)[XB_TMO], 1u); break; } } } } while (0)
struct XcdBarrier { unsigned* bar; unsigned x; volatile LAS unsigned* st; };
__device__ __forceinline__ XcdBarrier xcd_barrier_post(unsigned* bar, volatile LAS unsigned* st) {
    XcdBarrier b; b.bar = bar; b.x = xb_xcc_id(); b.st = st;
    if (threadIdx.x == 0) (void)xb_add(&bar[XB_XCNT(b.x)], 1u);
    return b;
}
__device__ __forceinline__ void xcd_barrier_complete(unsigned* bar, unsigned x, unsigned& nloc, unsigned& nx) {
    const unsigned G = gridDim.x * gridDim.y * gridDim.z;
    unsigned sum, cnt, mine, sp = 0u;
    for (;;) {
        sum = 0u; cnt = 0u; mine = 0u;
#pragma unroll
        for (unsigned j = 0; j < 16; ++j) { const unsigned c = xb_ld(&bar[XB_XCNT(j)]); sum += c; cnt += (c > 0u) ? 1u : 0u; mine = (j == x) ? c : mine; }
        if (sum == G) break;
        __builtin_amdgcn_s_sleep(1);
        if ((++sp & 255u) == 0u) { if (xb_ld(&bar[XB_TMO])) break; if (sp > XB_SPIN_CAP) { atomicAdd(&bar[XB_TMO], 1u); break; } }
    }
    nloc = mine > 0u ? mine : 1u; nx = cnt > 0u ? cnt : 1u;
}
__device__ __forceinline__ void xcd_barrier(const XcdBarrier& b) {
    asm volatile("s_waitcnt vmcnt(0)" ::: "memory");
    __syncthreads();
    if (threadIdx.x == 0) {
        unsigned* bar = b.bar;
        __builtin_amdgcn_s_waitcnt(0);
        unsigned nloc = b.st[0], nx = b.st[1];
        if (nloc == 0u) { xcd_barrier_complete(bar, b.x, nloc, nx); b.st[0] = nloc; b.st[1] = nx; }
        const unsigned old = xb_add(&bar[XB_XSUB(b.x)], 1u);
        const unsigned gen = old / nloc;
        if (old + 1u == (gen + 1u) * nloc) {
            __builtin_amdgcn_fence(__ATOMIC_RELEASE, "agent");
            asm volatile("s_waitcnt vmcnt(0)" ::: "memory");
            const unsigned og = xb_add(&bar[XB_TOP], 1u);
            const unsigned tg = og / nx;
            if (og + 1u == (tg + 1u) * nx) xb_add(&bar[XB_TOPGEN], 1u);
            else XB_SPIN(xb_ld(&bar[XB_TOPGEN]) == tg, bar);
            __builtin_amdgcn_fence(__ATOMIC_ACQUIRE, "agent");
            xb_add(&bar[XB_XGEN(b.x)], 1u);
            asm volatile("s_waitcnt vmcnt(0)" ::: "memory");
        } else {
            XB_SPIN(xb_ld(&bar[XB_XGEN(b.x)]) == gen, bar);
            __builtin_amdgcn_fence(__ATOMIC_ACQUIRE, "agent");
            asm volatile("s_waitcnt vmcnt(0)" ::: "memory");
        }
    }
    __syncthreads();
}
#ifndef PROBE_REP
#define PROBE_REP 0
#endif
#ifndef PHM
#define PHM 0xFFFF
#endif
#define PH(b) if (PHM & (1 << (b)))
enum { K_N1 = 0, K_GIN, K_PREP, K_GQ, K_GKV, K_ATT, K_GPREP, K_GA, K_GB, K_GC, K_GOUT, K_N2, K_GUP, K_GDN, K_COPY, K_NONE, K_KMAX };
__global__ void __launch_bounds__(512, 2) mega(Params p) {
    extern __shared__ __attribute__((aligned(16))) unsigned char ldsg[];
    LAS unsigned char* lds = (LAS unsigned char*)ldsg;
    cg::grid_group grid = cg::this_grid();
    unsigned char* ws = p.ws;
    float* MOD = (float*)(ws + OFF_MOD);
    float* XC = (float*)(ws + OFF_XC);
    bf16_t* H = (bf16_t*)(ws + OFF_H); bf16_t* MIX = (bf16_t*)(ws + OFF_MIX);
    bf16_t* PB = (bf16_t*)(ws + OFF_BIG);
    const bool en_even = p.flags & 1, en_odd = p.flags & 2, en_mlp = p.flags & 4;

    volatile LAS unsigned* xst = (volatile LAS unsigned*)(lds + LDS_BYTES - 16);
    if (threadIdx.x == 0) { xst[0] = 0u; xst[1] = 0u; }
    __syncthreads();
    const XcdBarrier xbar = xcd_barrier_post((unsigned*)(ws + OFF_BAR), xst);
    PH(0) phase_ada(p, ldsg);
    PH(1) phase_weights(p, 0, ldsg);
    grid.sync();
    for (int step = 0; step < 44; ++step) {
        const int i = step / 11, s = step % 11, j = i >> 1; const bool even = !(i & 1);
        const float* mod = MOD + (size_t)i * 3 * 6144;
        const bool en_mix = even ? en_even : en_odd;
        const bool first = (i == 0) && (s <= 7);
        const float* xl = first ? p.in[0] : p.out; const float* xc = ((i == 0) && (s <= 8)) ? p.in[2] : XC;
        float* PART = (float*)(ws + OFF_PART);
        int kind;
        switch (s) {
            case 0: kind = K_N1; break;
            case 1: kind = K_GIN; break;
            case 2: kind = even ? K_PREP : K_GPREP; break;
            case 3: kind = even ? K_GQ : K_GA; break;
            case 4: kind = even ? K_GKV : K_GB; break;
            case 5: kind = even ? K_KMAX : K_GC; break;
            case 6: kind = even ? K_ATT : K_NONE; break;
            case 7: kind = K_GOUT; break;
            case 8: kind = K_N2; break;
            case 9: kind = K_GUP; break;
            default: kind = K_GDN; break;
        }
        if (s <= 7 && !en_mix) kind = (s == 0) ? K_NONE : ((i == 0 && s == 7) ? K_COPY : K_NONE);
        if (s >= 8 && !en_mlp) kind = K_NONE;
        if (s == 0 && i > 0) { PH(1) phase_weights(p, i, ldsg); }
        if (kind == K_NONE) { if (s == 0) xcd_barrier(xbar); continue; }
        bool gemmB = false, gemmR = false, nosync = false;
        pg8::EpiB EB; EB.O = PB; EB.ldo = 0; EB.rs = nullptr; EB.mode = 0;
        pg8::EpiR ER; ER.xin_l = xl; ER.xin_c = xc; ER.xout_l = p.out; ER.xout_c = XC; ER.gate = mod;
        const bf16_t* gA = H; const bf16_t* gB = (const bf16_t*)(ws + OFF_WIN); int lda = 1024, ldb = 1024, gN = 1024, gK = 1024, gM = R, nP = 0, Kp = 256;
        const int reps = ((p.flags >> (8 + kind)) & 1) ? 2 : 1;
        for (int rep = 0; rep < reps; ++rep) {
        if (rep) __syncthreads();
        switch (kind) {
            case K_N1: PH(2) phase_norm(xl, xc, p.in[6] + i * 1024, mod, 0, 1, H, R, i > 0 ? PART : nullptr, 8, mod - 3 * 6144 + 2 * 6144 + 5 * 1024, XC); break;
            case K_N2: PH(2) phase_norm(xl, xc, p.in[7] + i * 1024, mod, 3, 4, H, i < 3 ? R : RL, PART, 4, mod + 2 * 6144 + 2 * 1024, XC); break;
            case K_GIN: gemmB = true; gN = even ? 1792 : 3328; EB.ldo = gN; break;
            case K_PREP: PH(4) phase_even_prep(p, j, ldsg); break;
            case K_GQ: gemmB = true; nosync = true; gA = PB; lda = LDPE; gB = (const bf16_t*)(ws + OFF_WUQ); ldb = 384; gN = 768; gK = 384; EB.O = (bf16_t*)(ws + OFF_Q); EB.ldo = 768; EB.rs = (const float*)(ws + OFF_RSQ); break;
            case K_GKV: gemmB = true; gA = PB + 384; lda = LDPE; gB = (const bf16_t*)(ws + OFF_WUKV); ldb = 256; gN = 1024; gK = 256; EB.O = (bf16_t*)(ws + OFF_KV); EB.ldo = 1024; EB.rs = (const float*)(ws + OFF_RSKV); break;
            case K_KMAX: PH(4) phase_kmax(p, ldsg); break;
            case K_ATT: PH(5) phase_attn(p, ldsg); break;
            case K_GPREP: PH(6) phase_gla_prep(p, j, ldsg); break;
            case K_GA: PH(7) phase_gla_a(p, j, ldsg); break;
            case K_GB: PH(8) phase_gla_b(p); break;
            case K_GC: PH(9) phase_gla_c(p, j, ldsg); break;
            case K_GOUT: gemmR = true; gA = MIX; gB = (const bf16_t*)(ws + OFF_WOUT); ER.gate = mod + 2 * 1024; gM = RL; nP = i < 3 ? 4 : 0; Kp = 256; break;
            case K_GUP: gemmB = true; gB = (const bf16_t*)(ws + OFF_W1); gN = 4096; EB.ldo = 4096; EB.mode = 1; gM = i < 3 ? R : RL; break;
            case K_GDN: gemmR = true; gA = PB; lda = 4096; gB = (const bf16_t*)(ws + OFF_W2); ldb = 4096; gK = 4096; ER.gate = mod + 5 * 1024; gM = RL; nP = i < 3 ? 8 : 0; Kp = 512; break;
            case K_COPY:
                for (size_t e = (size_t)blockIdx.x * 512 + ltid(); e < (size_t)R * 256; e += (size_t)gridDim.x * 512) {
                    const size_t row = e >> 8, c4 = (e & 255) * 4;
                    if (row < RL) *(f32x4*)(p.out + row * DM + c4) = *(const f32x4*)(xl + row * DM + c4);
                    else *(f32x4*)(XC + (row - RL) * DM + c4) = *(const f32x4*)(xc + (row - RL) * DM + c4);
                }
                break;
            default: break;
        }
        if (gemmB) { PH(3) run_gemm(lds, gA, lda, gB, ldb, gM, gN, gK, EB, kind == K_GKV); }
        if (gemmR) { PH(10) { run_gemm(lds, gA, lda, gB, ldb, gM, gN, gK, ER); if (nP) run_pieces(lds, gA + (size_t)RL * lda, lda, gB, ldb, nP, Kp, PART); } }
        }
        if (!nosync) xcd_barrier(xbar);
    }
    PH(11) phase_final(p.in[26], p.out);
}

extern "C" void kernel_launch(void* const* d_in, const int* in_sizes, int n_in, void* d_out, int out_size, void* d_ws, size_t ws_size, hipStream_t stream) {
    static int grid = 0;
    if (grid == 0) {
        if (n_in != 27 || ws_size < WS_NEED) { fprintf(stderr, "kernel_launch: unexpected n_in %d / ws %zu\n", n_in, ws_size); grid = -1; return; }
        int dev = 0, cus = 0, per_cu = 0;
        hipGetDevice(&dev);
        hipDeviceGetAttribute(&cus, hipDeviceAttributeMultiprocessorCount, dev);
        hipFuncSetAttribute((const void*)mega, hipFuncAttributeMaxDynamicSharedMemorySize, LDS_BYTES);
        hipOccupancyMaxActiveBlocksPerMultiprocessor(&per_cu, (const void*)mega, 512, LDS_BYTES);
        (void)hipGetLastError();
        if (per_cu < 1) fprintf(stderr, "kernel_launch: occupancy query reports %d blocks per CU\n", per_cu);
        grid = cus > 0 ? cus : 256;
    }
    if (grid < 0) return;
    if (hipMemsetAsync((char*)d_ws + OFF_BAR, 0, 16384, stream) != hipSuccess) { fprintf(stderr, "kernel_launch: memset failed\n"); return; }
    Params p{};
    for (int i = 0; i < 27; ++i) p.in[i] = (const float*)d_in[i];
    p.out = (float*)d_out; p.ws = (unsigned char*)d_ws; p.flags = 7 | PROBE_REP;
    void* args[] = {&p};
    hipError_t e = hipLaunchCooperativeKernel((const void*)mega, dim3(grid), dim3(512), args, LDS_BYTES, stream);
    if (e != hipSuccess) fprintf(stderr, "cooperative launch failed: %s (grid %d)\n", hipGetErrorString(e), grid);
}
```

```cpp
#include <hip/hip_runtime.h>
#include <hip/hip_cooperative_groups.h>
#include <cstdio>
namespace cg = cooperative_groups;

#define LAS __attribute__((address_space(3)))
typedef unsigned short bf16_t;
typedef short bf16x8 __attribute__((ext_vector_type(8)));
typedef short bf16x4 __attribute__((ext_vector_type(4)));
typedef float f32x4 __attribute__((ext_vector_type(4)));
typedef float f32x16 __attribute__((ext_vector_type(16)));
typedef unsigned u32x4 __attribute__((ext_vector_type(4)));
typedef unsigned u32x2 __attribute__((ext_vector_type(2)));

constexpr int R = 33280, RL = 32768, DM = 1024;
constexpr int LDPE = 1792, LDPO = 3328;
constexpr size_t MiB = (size_t)1 << 20;
constexpr size_t OFF_WIN = 0, OFF_WOUT = 8 * MiB, OFF_WUQ = 10 * MiB, OFF_WUKV = 11 * MiB, OFF_WCM = 12 * MiB, OFF_W1 = 13 * MiB, OFF_W2 = 21 * MiB;
constexpr size_t OFF_MOD = 30 * MiB, OFF_XC = 31 * MiB, OFF_RSQ = 33 * MiB, OFF_RSKV = 33 * MiB + 256 * 1024, OFF_GD = 36 * MiB + 640 * 1024;
constexpr size_t OFF_BAR = 33 * MiB + 768 * 1024;
constexpr size_t OFF_KMS = 33 * MiB + 800 * 1024;
constexpr size_t OFF_DECF = 34 * MiB, OFF_DECB = 35 * MiB + 512 * 1024;
constexpr size_t OFF_H = 37 * MiB, OFF_MIX = 102 * MiB, OFF_BIG = 167 * MiB, OFF_G = 427 * MiB;
constexpr size_t OFF_Q = OFF_BIG + 114 * MiB, OFF_KV = OFF_BIG + 163 * MiB, OFF_KR = OFF_BIG + 228 * MiB;
constexpr size_t OFF_QTF = OFF_H, OFF_KTF = OFF_H + 34078720, OFF_QTB = OFF_BIG + 212 * MiB, OFF_SLOC = OFF_G, OFF_KTB = OFF_G + 34 * MiB;
constexpr size_t OFF_PART = 494 * MiB;
constexpr size_t WS_NEED = 510 * MiB;
constexpr int LDS_BYTES = 144 * 1024;

struct Params {
    const float* in[27];
    float* out;
    unsigned char* ws;
    long long flags;
};

__device__ __forceinline__ float bf2f(bf16_t b) { return __uint_as_float(((unsigned)b) << 16); }
__device__ __forceinline__ float bflo(unsigned u) { return __uint_as_float(u << 16); }
__device__ __forceinline__ float bfhi(unsigned u) { return __uint_as_float(u & 0xffff0000u); }
__device__ __forceinline__ bf16_t f2bf(float f) { unsigned u = __float_as_uint(f); u += 0x7FFFu + ((u >> 16) & 1u); return (bf16_t)(u >> 16); }
typedef __bf16 hwbf2_t __attribute__((ext_vector_type(2)));
typedef float f32x2v_t __attribute__((ext_vector_type(2)));
__device__ __forceinline__ unsigned pk2(float lo, float hi) { const f32x2v_t v = {lo, hi}; const hwbf2_t b = __builtin_convertvector(v, hwbf2_t); return __builtin_bit_cast(unsigned, b); }
__device__ __forceinline__ bf16x8 pack8(float a0, float a1, float a2, float a3, float a4, float a5, float a6, float a7) {
    u32x4 u = {pk2(a0, a1), pk2(a2, a3), pk2(a4, a5), pk2(a6, a7)};
    return __builtin_bit_cast(bf16x8, u);
}
__device__ __forceinline__ float wsum(float v) {
#pragma unroll
    for (int o = 32; o >= 1; o >>= 1) v += __shfl_xor(v, o);
    return v;
}
__device__ __forceinline__ float gelu_t(float x) { const float u = 0.7978845608f * (x + 0.044715f * x * x * x); return x / (1.f + __expf(-2.f * u)); }
__device__ __forceinline__ float silu_f(float x) { return x / (1.f + __expf(-x)); }
__device__ __forceinline__ void sincos_red(float ang, float& s, float& c) {
    const float k = rintf(ang * 0.15915494309f);
    float r = fmaf(-k, 6.2831854820251465f, ang);
    r = fmaf(-k, -1.7484555e-7f, r);
    s = __sinf(r); c = __cosf(r);
}
__device__ __forceinline__ float rope_inv(int jj) { return exp2f(-(float)jj * 1.6609640474f); }

__device__ __forceinline__ bf16x4 tr16(LAS unsigned char* a) { return __builtin_amdgcn_ds_read_tr16_b64_v4i16((LAS bf16x4*)a); }
__device__ __forceinline__ bf16x8 tr_nat(LAS unsigned char* base, int stride, int k0, int n0, int lane) {
    const int i = lane & 15, q = i >> 2, pq = i & 3, hh = lane >> 5, g1 = (lane >> 4) & 1;
    LAS unsigned char* a0 = base + (k0 + 8 * hh + q) * stride + (n0 + 16 * g1 + 4 * pq) * 2;
    const bf16x4 x = tr16(a0), y = tr16(a0 + 4 * stride);
    return __builtin_shufflevector(x, y, 0, 1, 2, 3, 4, 5, 6, 7);
}
__device__ __forceinline__ bf16x8 tr_perm(LAS unsigned char* base, int stride, int k0, int n0, int lane) {
    const int i = lane & 15, q = i >> 2, pq = i & 3, hh = lane >> 5, g1 = (lane >> 4) & 1;
    LAS unsigned char* a0 = base + (k0 + 4 * hh + q) * stride + (n0 + 16 * g1 + 4 * pq) * 2;
    const bf16x4 x = tr16(a0), y = tr16(a0 + 8 * stride);
    return __builtin_shufflevector(x, y, 0, 1, 2, 3, 4, 5, 6, 7);
}
__device__ __forceinline__ int ltid() { int t = threadIdx.x; asm volatile("" : "+v"(t)); return t; }
#define MFMA32(a, b, c) __builtin_amdgcn_mfma_f32_32x32x16_bf16((a), (b), (c), 0, 0, 0)

namespace pg8 {
constexpr int BM = 256, BK = 64, HALF = 128, HTB = HALF * BK * 2, STAGE_BYTES = 8 * HTB, NXCD = 8, WGM = 8;
__device__ __forceinline__ int lds_byte(int r, int c) { const int st = (r >> 4) * 2 + (c >> 5), rr = r & 15, cc = c & 31, ob = rr * 64 + cc * 2; return st * 1024 + (ob ^ (((ob >> 9) & 1) << 5)); }
__device__ __forceinline__ void stage_rc(int b, int& Rr, int& C) { const int st = b / 1024, sb = b % 1024, swz = sb ^ (((sb >> 9) & 1) << 5); Rr = (st >> 1) * 16 + swz / 64; C = (st & 1) * 32 + (swz % 64) / 2; }
__device__ __forceinline__ int perm32(int rho) { const int n = rho >> 4, i = rho & 15; return 8 * (i >> 2) + 4 * n + (i & 3); }
struct Unit { int pm, pn, ko; };
struct Gemm { const bf16_t* A; const bf16_t* Bt; int lda, ldb, M, N, K; };
struct StaticOrder {
    int nM, nN, nwg, G, c;
    __device__ void init(int M, int N, int G_, int c_) { nM = M / BM; nN = N / BM; nwg = nM * nN; G = G_; c = c_; }
    __device__ bool next(int i, Unit& u) const {
        const long L = (long)i * G + c; if (L >= nwg) return false;
        int wgid = (int)L; { const int q = nwg / NXCD, r = nwg % NXCD, xcd = wgid % NXCD, off = wgid / NXCD; wgid = (xcd < r ? xcd * (q + 1) : r * (q + 1) + (xcd - r) * q) + off; }
        const int nig = WGM * nN, gid = wgid / nig, fm = gid * WGM, gsz = (nM - fm) < WGM ? (nM - fm) : WGM;
        u.pm = fm + ((wgid % nig) % gsz); u.pn = (wgid % nig) / gsz; u.ko = 0; return true;
    }
};
struct PieceOrder {
    int nP, Kp, G, c;
    __device__ bool next(int i, Unit& u) const {
        const long L = (long)i * G + c; if (L >= 8 * nP) return false;
        const int kp = (int)L >> 3, r = (int)L & 7; u.pm = r >> 2; u.pn = r & 3; u.ko = kp * Kp; return true;
    }
};

template <class Epi, class Sched>
__device__ __forceinline__ void gemm_phase(LAS unsigned char* lds, const Gemm g, const Sched& S, const Epi& E) {
    const int tid = ltid(), wid = __builtin_amdgcn_readfirstlane(tid >> 6), lane = tid & 63, wr = wid >> 2, wc = wid & 3, fr = lane & 15, fq = lane >> 4;
    const int K = g.K, nt = K / BK;
    unsigned voffA[2], voffB[2];
#pragma unroll
    for (int i = 0; i < 2; ++i) { int Rr, C; stage_rc(tid * 16 + i * 8192, Rr, C); const int Rb = Epi::PERM ? ((Rr & ~31) + perm32(Rr & 31)) : Rr;
        voffA[i] = (unsigned)(Rr * g.lda + C) * 2u; voffB[i] = (unsigned)(Rb * g.ldb + C) * 2u; }
    const size_t kstep = (size_t)(BK * 2);
    const size_t hA = (size_t)HALF * g.lda * 2, hB = (size_t)HALF * g.ldb * 2;
    const size_t tA = 2 * hA, tB = 2 * hB;
    const unsigned ldsw = (unsigned)wid * 1024u;
    const int aoff = lds_byte(wr * 64 + fr, fq * 8), boff = lds_byte(wc * 32 + fr, fq * 8);
#define PG8_SA(b, h) (((b) * 2 + (h)) * HTB)
#define PG8_SB(b, h) ((4 + (b) * 2 + (h)) * HTB)
#define PG8_STAGE(bufoff, gbase, voff) do { _Pragma("unroll") for (int _i = 0; _i < 2; ++_i) \
        __builtin_amdgcn_global_load_lds((const unsigned*)((const char*)(gbase) + (voff)[_i]), (LAS unsigned*)(lds + (bufoff) + ldsw + _i * 8192), 16, 0, 0); } while (0)
#define PG8_LDA(dst, b, h) do { _Pragma("unroll") for (int m = 0; m < 4; ++m) _Pragma("unroll") for (int k = 0; k < 2; ++k) dst[m][k] = *(const LAS bf16x8*)(lds + PG8_SA(b, h) + aoff + m * 2048 + k * 1024); } while (0)
#define PG8_LDB(dst, b, h) do { _Pragma("unroll") for (int n = 0; n < 2; ++n) _Pragma("unroll") for (int k = 0; k < 2; ++k) dst[n][k] = *(const LAS bf16x8*)(lds + PG8_SB(b, h) + boff + n * 2048 + k * 1024); } while (0)
#define PG8_MMA(ai, bj, At, Bt) do { __builtin_amdgcn_s_setprio(1); _Pragma("unroll") for (int m = 0; m < 4; ++m) _Pragma("unroll") for (int n = 0; n < 2; ++n) _Pragma("unroll") for (int k = 0; k < 2; ++k) \
        acc[ai][bj][m][n] = __builtin_amdgcn_mfma_f32_16x16x32_bf16(Bt[n][k], At[m][k], acc[ai][bj][m][n], 0, 0, 0); __builtin_amdgcn_s_setprio(0); } while (0)
#define PG8_WAIT_V(n) asm volatile("s_waitcnt vmcnt(" #n ")" ::: "memory")
#define PG8_WAIT_L(n) asm volatile("s_waitcnt lgkmcnt(" #n ")" ::: "memory")
#define PG8_BAR __builtin_amdgcn_s_barrier()
#define PG8_SCHED __builtin_amdgcn_sched_barrier(0)
    Unit cur, nxt; int ui = 0;
    if (!S.next(0, cur)) return;
    f32x4 acc[2][2][4][2];
#pragma unroll
    for (int a = 0; a < 2; ++a)
#pragma unroll
        for (int b = 0; b < 2; ++b)
#pragma unroll
            for (int m = 0; m < 4; ++m)
#pragma unroll
                for (int n = 0; n < 2; ++n) acc[a][b][m][n] = (f32x4){0.f, 0.f, 0.f, 0.f};
    bf16x8 At[4][2], B0[2][2], B1[2][2];
    const char* cA = (const char*)g.A + (size_t)cur.pm * tA + (size_t)cur.ko * 2; const char* cB = (const char*)g.Bt + (size_t)cur.pn * tB + (size_t)cur.ko * 2;
    PG8_STAGE(PG8_SB(0, 0), cB, voffB); PG8_STAGE(PG8_SA(0, 0), cA, voffA); PG8_STAGE(PG8_SB(0, 1), cB + hB, voffB); PG8_STAGE(PG8_SA(0, 1), cA + hA, voffA);
    if (wr == 1) PG8_BAR;
    PG8_WAIT_V(4); PG8_BAR;
    PG8_STAGE(PG8_SB(1, 0), cB + kstep, voffB); PG8_STAGE(PG8_SA(1, 0), cA + kstep, voffA); PG8_STAGE(PG8_SB(1, 1), cB + hB + kstep, voffB);
    PG8_WAIT_V(6); PG8_BAR;
    for (;;) {
        const bool has_next = S.next(ui + 1, nxt);
        const char* nA = has_next ? (const char*)g.A + (size_t)nxt.pm * tA + (size_t)nxt.ko * 2 : cA; const char* nB = has_next ? (const char*)g.Bt + (size_t)nxt.pn * tB + (size_t)nxt.ko * 2 : cB;
        for (int t = 0; t < nt; t += 2) {
            const bool last = (t == nt - 2);
            const char* a1 = cA + (size_t)(t + 1) * kstep;
            const char* a2 = last ? nA : cA + (size_t)(t + 2) * kstep; const char* b2 = last ? nB : cB + (size_t)(t + 2) * kstep;
            const char* a3 = a2 + kstep; const char* b3 = b2 + kstep;
            PG8_LDB(B0, 0, 0); PG8_SCHED; PG8_LDA(At, 0, 0); PG8_STAGE(PG8_SA(1, 1), a1 + hA, voffA);
            PG8_WAIT_L(8); PG8_BAR; PG8_WAIT_L(0); PG8_MMA(0, 0, At, B0); PG8_BAR; PG8_SCHED;
            PG8_LDB(B1, 0, 1); PG8_STAGE(PG8_SB(0, 0), b2, voffB);
            PG8_BAR; PG8_WAIT_L(0); PG8_MMA(0, 1, At, B1); PG8_BAR;
            PG8_LDA(At, 0, 1); PG8_STAGE(PG8_SA(0, 0), a2, voffA);
            PG8_BAR; PG8_WAIT_L(0); PG8_MMA(1, 0, At, B0); PG8_BAR; PG8_SCHED;
            PG8_STAGE(PG8_SB(0, 1), b2 + hB, voffB);
            PG8_WAIT_V(6); PG8_BAR; PG8_MMA(1, 1, At, B1); PG8_BAR;
            PG8_LDB(B0, 1, 0); PG8_SCHED; PG8_LDA(At, 1, 0); PG8_STAGE(PG8_SA(0, 1), a2 + hA, voffA);
            PG8_WAIT_L(8); PG8_BAR; PG8_WAIT_L(0); PG8_MMA(0, 0, At, B0); PG8_BAR; PG8_SCHED;
            PG8_LDB(B1, 1, 1); PG8_STAGE(PG8_SB(1, 0), b3, voffB);
            PG8_BAR; PG8_WAIT_L(0); PG8_MMA(0, 1, At, B1); PG8_BAR;
            PG8_LDA(At, 1, 1); PG8_STAGE(PG8_SA(1, 0), a3, voffA);
            PG8_BAR; PG8_WAIT_L(0); PG8_MMA(1, 0, At, B0); PG8_BAR; PG8_SCHED;
            PG8_STAGE(PG8_SB(1, 1), b3 + hB, voffB);
            PG8_WAIT_V(6); PG8_BAR; PG8_MMA(1, 1, At, B1); PG8_BAR;
        }
        E(acc, cur, wr, wc, fr, fq);
        if (!has_next) break;
#pragma unroll
        for (int a = 0; a < 2; ++a)
#pragma unroll
            for (int b = 0; b < 2; ++b)
#pragma unroll
                for (int m = 0; m < 4; ++m)
#pragma unroll
                    for (int n = 0; n < 2; ++n) acc[a][b][m][n] = (f32x4){0.f, 0.f, 0.f, 0.f};
        cur = nxt; cA = nA; cB = nB; ++ui;
    }
    PG8_WAIT_V(0);
    if (wr == 0) PG8_BAR;
    PG8_BAR;
#undef PG8_SA
#undef PG8_SB
#undef PG8_STAGE
#undef PG8_LDA
#undef PG8_LDB
#undef PG8_MMA
#undef PG8_WAIT_V
#undef PG8_WAIT_L
#undef PG8_BAR
#undef PG8_SCHED
}

struct EpiB {
    static constexpr bool PERM = true;
    bf16_t* O; int ldo; const float* rs; int mode;
    __device__ __forceinline__ void operator()(const f32x4 (&acc)[2][2][4][2], const Unit& u, int wr, int wc, int fr, int fq) const {
        const int row0 = u.pm * BM + wr * 64 + fr, col0 = u.pn * BM + wc * 32 + 8 * fq;
#pragma unroll
        for (int ai = 0; ai < 2; ++ai)
#pragma unroll
            for (int m = 0; m < 4; ++m) {
                const int row = row0 + ai * HALF + m * 16;
                const float s = rs ? rs[row] : 1.f;
                bf16_t* rowp = O + (size_t)row * ldo + col0;
#pragma unroll
                for (int bj = 0; bj < 2; ++bj) {
                    f32x4 v0 = acc[ai][bj][m][0] * s, v1 = acc[ai][bj][m][1] * s;
                    if (mode == 1) {
#pragma unroll
                        for (int e = 0; e < 4; ++e) { const float a = fmaxf(v0[e], 0.f), b = fmaxf(v1[e], 0.f); v0[e] = a * a; v1[e] = b * b; }
                    }
                    const u32x4 o = {pk2(v0[0], v0[1]), pk2(v0[2], v0[3]), pk2(v1[0], v1[1]), pk2(v1[2], v1[3])};
                    *(u32x4*)(rowp + bj * HALF) = o;
                }
            }
    }
};
struct EpiR {
    static constexpr bool PERM = false;
    const float* xin_l; const float* xin_c; float* xout_l; float* xout_c; const float* gate;
    __device__ __forceinline__ void operator()(const f32x4 (&acc)[2][2][4][2], const Unit& u, int wr, int wc, int fr, int fq) const {
        const int var = u.pm < 64 ? 0 : (u.pm < 128 ? 1 : 2);
        const float* gp = gate + var * 6144;
        const int rowt = (u.pm < 128 ? u.pm : u.pm - 128) * BM + wr * 64 + fr;
        const float* xi = u.pm < 128 ? xin_l : xin_c; float* xo = u.pm < 128 ? xout_l : xout_c;
        const int col0 = u.pn * BM + wc * 32 + 4 * fq;
        f32x4 gv[2][2];
#pragma unroll
        for (int bj = 0; bj < 2; ++bj)
#pragma unroll
            for (int n = 0; n < 2; ++n) gv[bj][n] = *(const f32x4*)(gp + col0 + bj * HALF + n * 16);
#pragma unroll
        for (int ai = 0; ai < 2; ++ai)
#pragma unroll
            for (int m = 0; m < 4; ++m) {
                const size_t ro = (size_t)(rowt + ai * HALF + m * 16) * DM + col0;
#pragma unroll
                for (int bj = 0; bj < 2; ++bj)
#pragma unroll
                    for (int n = 0; n < 2; ++n) {
                        const f32x4 x = *(const f32x4*)(xi + ro + bj * HALF + n * 16);
                        *(f32x4*)(xo + ro + bj * HALF + n * 16) = x + gv[bj][n] * acc[ai][bj][m][n];
                    }
            }
    }
};
struct EpiP {
    static constexpr bool PERM = false;
    float* part; int kpiece;
    __device__ __forceinline__ void operator()(const f32x4 (&acc)[2][2][4][2], const Unit& u, int wr, int wc, int fr, int fq) const {
        const int kp = u.ko / kpiece;
        const int rowt = u.pm * BM + wr * 64 + fr, col0 = u.pn * BM + wc * 32 + 4 * fq;
        float* base = part + (size_t)kp * 512 * DM;
#pragma unroll
        for (int ai = 0; ai < 2; ++ai)
#pragma unroll
            for (int m = 0; m < 4; ++m) {
                const size_t ro = (size_t)(rowt + ai * HALF + m * 16) * DM + col0;
#pragma unroll
                for (int bj = 0; bj < 2; ++bj)
#pragma unroll
                    for (int n = 0; n < 2; ++n) *(f32x4*)(base + ro + bj * HALF + n * 16) = acc[ai][bj][m][n];
            }
    }
};
}

template <class Epi>
__device__ __forceinline__ void run_gemm(LAS unsigned char* lds, const bf16_t* A, int lda, const bf16_t* Bt, int ldb, int M, int N, int K, const Epi& E, bool rev = false) {
    pg8::Gemm g; g.A = A; g.Bt = Bt; g.lda = lda; g.ldb = ldb; g.M = M; g.N = N; g.K = K;
    pg8::StaticOrder S; S.init(M, N, (int)gridDim.x, rev ? (int)(gridDim.x - 1 - blockIdx.x) : (int)blockIdx.x);
    pg8::gemm_phase<Epi, pg8::StaticOrder>(lds, g, S, E);
}
__device__ __forceinline__ void run_pieces(LAS unsigned char* lds, const bf16_t* A, int lda, const bf16_t* Bt, int ldb, int nP, int Kp, float* part) {
    pg8::Gemm g; g.A = A; g.Bt = Bt; g.lda = lda; g.ldb = ldb; g.M = 512; g.N = 1024; g.K = Kp;
    pg8::PieceOrder S; S.nP = nP; S.Kp = Kp; S.G = (int)gridDim.x; S.c = (int)blockIdx.x;
    pg8::EpiP E; E.part = part; E.kpiece = Kp;
    pg8::gemm_phase<pg8::EpiP, pg8::PieceOrder>(lds, g, S, E);
}

__device__ void phase_ada(const Params& p, unsigned char* ldsg) {
    float* sl = (float*)ldsg;
    float* red = sl + 3072;
    const int tid = ltid();
    float* MOD = (float*)(p.ws + OFF_MOD);
    for (int idx = tid; idx < 3072; idx += 512) { const int var = idx >> 10, k = idx & 1023; const float v = var < 2 ? p.in[1][var * 1024 + k] : p.in[3][k]; sl[idx] = silu_f(v); }
    __syncthreads();
    for (int item = blockIdx.x; item < 192; item += gridDim.x) {
        const int i = item / 48, cb = item % 48, cc = tid & 127, kq = tid >> 7, col = cb * 128 + cc;
        const float* w = p.in[4] + ((size_t)i * 1024 + kq * 256) * 6144 + col;
        const float* s0 = sl + kq * 256;
        float a0 = 0.f, a1 = 0.f, a2 = 0.f;
#pragma unroll 8
        for (int k = 0; k < 256; ++k) { const float wv = w[(size_t)k * 6144]; a0 = fmaf(s0[k], wv, a0); a1 = fmaf(s0[1024 + k], wv, a1); a2 = fmaf(s0[2048 + k], wv, a2); }
        red[(kq * 3 + 0) * 128 + cc] = a0; red[(kq * 3 + 1) * 128 + cc] = a1; red[(kq * 3 + 2) * 128 + cc] = a2;
        __syncthreads();
        if (tid < 384) { const int var = tid >> 7, c2 = tid & 127; float s = p.in[5][i * 6144 + cb * 128 + c2];
#pragma unroll
            for (int q = 0; q < 4; ++q) s += red[(q * 3 + var) * 128 + c2];
            MOD[(size_t)(i * 3 + var) * 6144 + cb * 128 + c2] = s; }
        __syncthreads();
    }
}

__device__ void tjob(const float* src, int K, int N, int Npad, bf16_t* dst, const float* rs, float mult, unsigned char* ldsg) {
    float* tile = (float*)ldsg;
    const int tid = ltid(), ntk = K / 64, ntn = Npad / 64;
    for (int t = blockIdx.x; t < ntk * ntn; t += gridDim.x) {
        const int tk = t % ntk, tn = t / ntk;
        const int nl = tid & 63, kl0 = tid >> 6;
#pragma unroll
        for (int j = 0; j < 8; ++j) { const int kl = kl0 + 8 * j, k = tk * 64 + kl, n = tn * 64 + nl;
            float v = n < N ? src[(size_t)k * N + n] : 0.f; if (rs) v *= rs[k]; tile[kl * 65 + nl] = v * mult; }
        __syncthreads();
        const int nl2 = tid >> 3, kc = tid & 7;
        u32x4 o;
#pragma unroll
        for (int e = 0; e < 4; ++e) o[e] = pk2(tile[(kc * 8 + 2 * e) * 65 + nl2], tile[(kc * 8 + 2 * e + 1) * 65 + nl2]);
        *(u32x4*)(dst + (size_t)(tn * 64 + nl2) * K + tk * 64 + kc * 8) = o;
        __syncthreads();
    }
}
__device__ void phase_weights(const Params& p, int i, unsigned char* ldsg) {
    unsigned char* ws = p.ws; const int j = i >> 1;
    if (!(i & 1)) {
        tjob(p.in[10] + (size_t)j * 1024 * 1696, 1024, 1696, 1792, (bf16_t*)(ws + OFF_WIN), nullptr, 1.f, ldsg);
        tjob(p.in[12] + (size_t)j * 384 * 768, 384, 768, 768, (bf16_t*)(ws + OFF_WUQ), p.in[11] + j * 384, 0.10206207262f * 1.44269504089f, ldsg);
        tjob(p.in[14] + (size_t)j * 256 * 1024, 256, 1024, 1024, (bf16_t*)(ws + OFF_WUKV), p.in[13] + j * 256, 1.f, ldsg);
        tjob(p.in[18] + (size_t)j * 1024 * 1024, 1024, 1024, 1024, (bf16_t*)(ws + OFF_WOUT), nullptr, 1.f, ldsg);
        bf16_t* wcm = (bf16_t*)(ws + OFF_WCM); const float* src = p.in[16] + (size_t)j * 65536;
        for (int e = blockIdx.x * 512 + ltid(); e < 65536; e += gridDim.x * 512) wcm[e] = f2bf(src[e]);
    } else {
        tjob(p.in[19] + (size_t)j * 1024 * 3104, 1024, 3104, 3328, (bf16_t*)(ws + OFF_WIN), nullptr, 1.f, ldsg);
        tjob(p.in[25] + (size_t)j * 1024 * 1024, 1024, 1024, 1024, (bf16_t*)(ws + OFF_WOUT), nullptr, 1.f, ldsg);
    }
    tjob(p.in[8] + (size_t)i * 1024 * 4096, 1024, 4096, 4096, (bf16_t*)(ws + OFF_W1), nullptr, 1.f, ldsg);
    tjob(p.in[9] + (size_t)i * 4096 * 1024, 4096, 1024, 1024, (bf16_t*)(ws + OFF_W2), nullptr, 1.f, ldsg);
}

__device__ void phase_norm(const float* xl, const float* xc, const float* g, const float* mod  , int shift_i, int scale_i, bf16_t* H,
                           int nrows, const float* part, int npart, const float* pgate, float* xc_out) {
    const int lane = ltid() & 63, gw = blockIdx.x * 8 + (ltid() >> 6), nw = gridDim.x * 8;
    f32x4 xn[4];
    if (gw < nrows) { const float* src = gw < RL ? xl + (size_t)gw * DM : xc + (size_t)(gw - RL) * DM;
#pragma unroll
        for (int q = 0; q < 4; ++q) xn[q] = __builtin_nontemporal_load((const f32x4*)(src + q * 256 + lane * 4)); }
    for (int row = gw; row < nrows; row += nw) {
        const int var = row < 16384 ? 0 : (row < RL ? 1 : 2);
        const float* sh = mod + var * 6144 + shift_i * 1024; const float* sc = mod + var * 6144 + scale_i * 1024;
        f32x4 x[4]; float ss = 0.f;
#pragma unroll
        for (int q = 0; q < 4; ++q) x[q] = xn[q];
        { const int nr = row + nw;
          if (nr < nrows) { const float* src = nr < RL ? xl + (size_t)nr * DM : xc + (size_t)(nr - RL) * DM;
#pragma unroll
              for (int q = 0; q < 4; ++q) xn[q] = __builtin_nontemporal_load((const f32x4*)(src + q * 256 + lane * 4)); } }
        if (row >= RL && part) {
#pragma unroll
            for (int q = 0; q < 4; ++q) { const int c = q * 256 + lane * 4;
                f32x4 acc = {0.f, 0.f, 0.f, 0.f};
                for (int kp = 0; kp < npart; ++kp) acc += *(const f32x4*)(part + ((size_t)kp * 512 + (row - RL)) * DM + c);
                x[q] += *(const f32x4*)(pgate + c) * acc;
                *(f32x4*)(xc_out + (size_t)(row - RL) * DM + c) = x[q]; }
        }
#pragma unroll
        for (int q = 0; q < 4; ++q) ss += x[q][0] * x[q][0] + x[q][1] * x[q][1] + x[q][2] * x[q][2] + x[q][3] * x[q][3];
        ss = wsum(ss);
        const float rstd = rsqrtf(ss * (1.f / 1024.f) + 1e-6f);
#pragma unroll
        for (int q = 0; q < 4; ++q) { const int c = q * 256 + lane * 4;
            const f32x4 gg = *(const f32x4*)(g + c), s1 = *(const f32x4*)(sc + c), s0 = *(const f32x4*)(sh + c);
            float o[4];
#pragma unroll
            for (int e = 0; e < 4; ++e) o[e] = x[q][e] * rstd * gg[e] * (1.f + s1[e]) + s0[e];
            const u32x2 pk = {pk2(o[0], o[1]), pk2(o[2], o[3])};
            *(u32x2*)(H + (size_t)row * DM + c) = pk; }
    }
}
__device__ void phase_final(const float* g, float* X) {
    const int lane = ltid() & 63, gw = blockIdx.x * 8 + (ltid() >> 6), nw = gridDim.x * 8;
    f32x4 xn[4];
    if (gw < RL) {
#pragma unroll
        for (int q = 0; q < 4; ++q) xn[q] = __builtin_nontemporal_load((const f32x4*)(X + (size_t)gw * DM + q * 256 + lane * 4)); }
    for (int row = gw; row < RL; row += nw) {
        float* src = X + (size_t)row * DM;
        f32x4 x[4]; float ss = 0.f;
#pragma unroll
        for (int q = 0; q < 4; ++q) { x[q] = xn[q]; ss += x[q][0] * x[q][0] + x[q][1] * x[q][1] + x[q][2] * x[q][2] + x[q][3] * x[q][3]; }
        if (row + nw < RL) {
#pragma unroll
            for (int q = 0; q < 4; ++q) xn[q] = __builtin_nontemporal_load((const f32x4*)(X + (size_t)(row + nw) * DM + q * 256 + lane * 4)); }
        ss = wsum(ss);
        const float rstd = rsqrtf(ss * (1.f / 1024.f) + 1e-6f);
#pragma unroll
        for (int q = 0; q < 4; ++q) { const int c = q * 256 + lane * 4; const f32x4 gg = *(const f32x4*)(g + c); *(f32x4*)(src + c) = x[q] * rstd * gg; }
    }
}

__device__ void phase_even_prep(const Params& p, int j, unsigned char* ldsg) {
    unsigned char* ws = p.ws;
    const bf16_t* P = (const bf16_t*)(ws + OFF_BIG);
    float* RSQ = (float*)(ws + OFF_RSQ); float* RSKV = (float*)(ws + OFF_RSKV);
    bf16_t* KR = (bf16_t*)(ws + OFF_KR); bf16_t* MIX = (bf16_t*)(ws + OFF_MIX);
    const int tid = ltid(), lane = tid & 63, w = tid >> 6, l32 = lane & 31, hh = lane >> 5;
    {
        const int gw = blockIdx.x * 8 + w, nw = gridDim.x * 8;
        for (int row = gw; row < R; row += nw) {
            const bf16_t* pr = P + (size_t)row * LDPE;
            float ss = 0.f;
#pragma unroll
            for (int q = 0; q < 3; ++q) { const unsigned u = *(const unsigned*)(pr + 2 * lane + 128 * q); const float a = bflo(u), b = bfhi(u); ss += a * a + b * b; }
            ss = wsum(ss);
            const u32x2 u2 = *(const u32x2*)(pr + 384 + 4 * lane);
            float s2 = bflo(u2[0]) * bflo(u2[0]) + bfhi(u2[0]) * bfhi(u2[0]) + bflo(u2[1]) * bflo(u2[1]) + bfhi(u2[1]) * bfhi(u2[1]);
            s2 = wsum(s2);
            if (lane == 0) { RSQ[row] = rsqrtf(ss * (1.f / 384.f) + 1e-6f); RSKV[row] = rsqrtf(s2 * (1.f / 256.f) + 1e-6f); }
            const float x = bf2f(pr[640 + l32]); const float y = __shfl_xor(x, 8);
            float o = x;
            if (row < RL) { const int l = row & 16383; const float pos = (float)(l32 < 16 ? (l >> 6) : (l & 63));
                float s, c; sincos_red(pos * rope_inv(l32 & 7), s, c);
                o = (l32 & 8) ? x * c + y * s : x * c - y * s; }
            if (lane < 32) KR[(size_t)row * 32 + lane] = f2bf(o);
        }
    }
    LAS unsigned char* lds = (LAS unsigned char*)ldsg;
    const bf16_t* WCM = (const bf16_t*)(ws + OFF_WCM);
    const float* cmn = p.in[15] + j * 128; const float* bs = p.in[17] + j * 512;
    for (int item = blockIdx.x; item < 1040; item += gridDim.x) {
        const int n = item >> 2, g = item & 3, r0 = n * 128;
        {
            const int s = tid >> 2, cq = tid & 3;
            const bf16_t* src = P + (size_t)(r0 + s) * LDPE + 1184 + g * 128 + cq * 32;
            float v[32]; float ss = 0.f;
#pragma unroll
            for (int q = 0; q < 4; ++q) { const u32x4 u = *(const u32x4*)(src + q * 8);
#pragma unroll
                for (int e = 0; e < 4; ++e) { const float a = gelu_t(bflo(u[e])), b = gelu_t(bfhi(u[e])); v[q * 8 + 2 * e] = a; v[q * 8 + 2 * e + 1] = b; ss += a * a + b * b; } }
            ss += __shfl_xor(ss, 1); ss += __shfl_xor(ss, 2);
            const float rstd = rsqrtf(ss * (1.f / 128.f) + 1e-6f);
#pragma unroll
            for (int q = 0; q < 4; ++q) { u32x4 o;
#pragma unroll
                for (int e = 0; e < 4; ++e) { const int c = cq * 32 + q * 8 + 2 * e; o[e] = pk2(v[q * 8 + 2 * e] * rstd * cmn[c], v[q * 8 + 2 * e + 1] * rstd * cmn[c + 1]); }
                *(LAS u32x4*)(lds + s * 272 + (cq * 32 + q * 8) * 2) = o; }
        }
        __syncthreads();
        const int tt = w >> 1, cp = (w & 1) * 2;
        f32x16 acc[2];
#pragma unroll
        for (int e = 0; e < 16; ++e) { acc[0][e] = 0.f; acc[1][e] = 0.f; }
#pragma unroll
        for (int ks = 0; ks < 8; ++ks) {
            const bf16x8 a = *(const bf16x8*)(WCM + g * 16384 + (32 * tt + l32) * 128 + 16 * ks + 8 * hh);
#pragma unroll
            for (int ct = 0; ct < 2; ++ct) { const bf16x8 b = tr_nat(lds, 272, 16 * ks, 32 * (cp + ct), lane); acc[ct] = MFMA32(a, b, acc[ct]); }
        }
#pragma unroll
        for (int ct = 0; ct < 2; ++ct)
#pragma unroll
            for (int i = 0; i < 16; ++i) {
                const int t = 32 * tt + (i >> 2) * 8 + 4 * hh + (i & 3), c = 32 * (cp + ct) + l32;
                const float val = acc[ct][i] + bs[g * 128 + t];
                const float u = gelu_t(bf2f(P[(size_t)(r0 + t) * LDPE + 672 + g * 128 + c]));
                MIX[(size_t)(r0 + t) * DM + 512 + g * 128 + c] = f2bf(u * val);
            }
        __syncthreads();
    }
}

__device__ void phase_kmax(const Params& p, unsigned char* ldsg) {
    unsigned char* ws = p.ws;
    const bf16_t* KV = (const bf16_t*)(ws + OFF_KV); const bf16_t* KR = (const bf16_t*)(ws + OFF_KR);
    float* KMS = (float*)(ws + OFF_KMS);
    float* red = (float*)ldsg;
    const int tid = ltid(), lane = tid & 63, w = tid >> 6, h = lane >> 3, jj = lane & 7;
    float mx0 = 0.f, mx1 = 0.f;
    for (int row = blockIdx.x * 8 + w; row < R; row += gridDim.x * 8) {
        const u32x4 a = *(const u32x4*)(KV + (size_t)row * 1024 + h * 128 + jj * 8);
        const u32x4 r = *(const u32x4*)(KR + (size_t)row * 32 + (jj & 3) * 8);
        float ss = 0.f, sr = 0.f;
#pragma unroll
        for (int e = 0; e < 4; ++e) { ss += bflo(a[e]) * bflo(a[e]) + bfhi(a[e]) * bfhi(a[e]); sr += bflo(r[e]) * bflo(r[e]) + bfhi(r[e]) * bfhi(r[e]); }
        ss += 0.5f * sr;
        ss += __shfl_xor(ss, 1); ss += __shfl_xor(ss, 2); ss += __shfl_xor(ss, 4);
        const int b = row < 16384 ? 0 : (row < RL ? 1 : ((row - RL) >> 8));
        if (b == 0) mx0 = fmaxf(mx0, ss); else mx1 = fmaxf(mx1, ss);
    }
    if (jj == 0) { red[w * 16 + h] = mx0; red[w * 16 + 8 + h] = mx1; }
    __syncthreads();
    if (tid < 16) { float m = red[tid];
#pragma unroll
        for (int q = 1; q < 8; ++q) m = fmaxf(m, red[q * 16 + tid]);
        KMS[blockIdx.x * 16 + tid] = m; }
    __syncthreads();
}

__device__ void phase_attn(const Params& p, unsigned char* ldsg) {
    unsigned char* ws = p.ws;
    const bf16_t* Q = (const bf16_t*)(ws + OFF_Q); const bf16_t* KV = (const bf16_t*)(ws + OFF_KV); const bf16_t* KR = (const bf16_t*)(ws + OFF_KR);
    bf16_t* MIX = (bf16_t*)(ws + OFF_MIX);
    LAS unsigned char* lds = (LAS unsigned char*)ldsg;
    const int tid = ltid(), lane = tid & 63, w = tid >> 6, l32 = lane & 31, hh = lane >> 5;
    constexpr int KROW = 208, VROW = 192, KBUF = 64 * KROW, VBUF = 64 * VROW, VBASE = 4 * KBUF;
    for (int it = blockIdx.x; it < 1040; it += gridDim.x) {
        int b, h, q0row, nkt; bool isctx;
        if (it < 1024) { h = it & 7; const int rest = it >> 3; b = rest >> 6; q0row = b * 16384 + (rest & 63) * 256; nkt = 260; isctx = false; }
        else { const int e = it - 1024; b = e >> 3; h = e & 7; q0row = RL + b * 256; nkt = 4; isctx = true; }
        const int qrow = q0row + w * 32 + l32;
        const bf16_t* qp = Q + (size_t)qrow * 768 + h * 96;
        bf16x8 qf[6];
#pragma unroll
        for (int s = 0; s < 4; ++s) qf[s] = *(const bf16x8*)(qp + 16 * s + 8 * hh);
#pragma unroll
        for (int s = 4; s < 6; ++s) {
            const bf16x8 own = *(const bf16x8*)(qp + 16 * s + 8 * hh);
            const bf16x8 oth = *(const bf16x8*)(qp + 16 * s + 8 * (1 - hh));
            if (!isctx) {
                const int l = qrow & 16383; const float pos = (float)(s == 4 ? (l >> 6) : (l & 63));
                float r[8];
#pragma unroll
                for (int jj = 0; jj < 8; ++jj) { float sn, cs; sincos_red(pos * rope_inv(jj), sn, cs);
                    const float x = bf2f((bf16_t)own[jj]), y = bf2f((bf16_t)oth[jj]); r[jj] = hh ? x * cs + y * sn : x * cs - y * sn; }
                qf[s] = pack8(r[0], r[1], r[2], r[3], r[4], r[5], r[6], r[7]);
            } else qf[s] = own;
        }
        float negm;
        {
            float qs = 0.f;
#pragma unroll
            for (int s = 0; s < 6; ++s)
#pragma unroll
                for (int e = 0; e < 8; ++e) { const float x = bf2f((bf16_t)qf[s][e]); qs += x * x; }
            qs += __shfl_xor(qs, 32);
            const float* KMS = (const float*)(ws + OFF_KMS) + b * 8 + h;
            float km = 0.f;
            for (int q = lane; q < (int)gridDim.x; q += 64) km = fmaxf(km, KMS[q * 16]);
#pragma unroll
            for (int o2 = 32; o2 >= 1; o2 >>= 1) km = fmaxf(km, __shfl_xor(km, o2));
            negm = -sqrtf(qs * km) * 1.0001f - 1e-3f;
        }
        const bf16_t* kp[2]; int kst[2]; int kdo[2]; bool kv_[2];
#pragma unroll
        for (int pp = 0; pp < 2; ++pp) {
            int c = tid + 512 * pp; if (c >= 768) c -= 512; kv_[pp] = true; const int key = c / 12, part = c % 12;
            if (part < 8) { kp[pp] = KV + (size_t)key * 1024 + h * 128 + part * 8; kst[pp] = 1024; }
            else { kp[pp] = KR + (size_t)key * 32 + (part - 8) * 8; kst[pp] = 32; }
            kdo[pp] = key * KROW + part * 16;
        }
        const bf16_t* vp = KV + (size_t)(tid >> 3) * 1024 + h * 128 + 64 + (tid & 7) * 8; const int vdo = (tid >> 3) * VROW + (tid & 7) * 16;
        auto rowbase = [&](int kt) -> int { return isctx ? (RL + b * 256 + kt * 64) : (kt < 256 ? b * 16384 + kt * 64 : RL + b * 256 + (kt - 256) * 64); };
        u32x4 prk[2], prv;
        auto loadK = [&](int kt) { const int rb = rowbase(kt);
#pragma unroll
            for (int pp = 0; pp < 2; ++pp) prk[pp] = *(const u32x4*)(kp[pp] + (size_t)rb * kst[pp]); };
        auto storeK = [&](int buf) {
#pragma unroll
            for (int pp = 0; pp < 2; ++pp) *(LAS u32x4*)(lds + buf * KBUF + kdo[pp]) = prk[pp]; };
        auto loadV = [&](int kt) { prv = *(const u32x4*)(vp + (size_t)rowbase(kt) * 1024); };
        auto storeV = [&](int buf) { *(LAS u32x4*)(lds + VBASE + buf * VBUF + vdo) = prv; };
        f32x16 pA[2], pB[2];
        f32x16 o[2];
#pragma unroll
        for (int e = 0; e < 16; ++e) { o[0][e] = 0.f; o[1][e] = 0.f; }
        float lsum = 0.f;
        auto qk = [&](int buf, f32x16 (&st)[2]) {
            LAS unsigned char* kb = lds + buf * KBUF;
#pragma unroll
            for (int e = 0; e < 16; ++e) { st[0][e] = negm; st[1][e] = negm; }
#pragma unroll
            for (int half = 0; half < 2; ++half) {
                bf16x8 kf[6];
#pragma unroll
                for (int s = 0; s < 3; ++s) {
                    kf[2 * s] = *(const LAS bf16x8*)(kb + l32 * KROW + (16 * (3 * half + s) + 8 * hh) * 2);
                    kf[2 * s + 1] = *(const LAS bf16x8*)(kb + (32 + l32) * KROW + (16 * (3 * half + s) + 8 * hh) * 2);
                }
                __builtin_amdgcn_sched_barrier(0);
#pragma unroll
                for (int s = 0; s < 3; ++s) { st[0] = MFMA32(kf[2 * s], qf[3 * half + s], st[0]); st[1] = MFMA32(kf[2 * s + 1], qf[3 * half + s], st[1]); }
            }
        };
        auto partialSM = [&](f32x16 (&pp)[2]) {
#pragma unroll
            for (int e = 0; e < 16; ++e) pp[0][e] = __builtin_amdgcn_exp2f(pp[0][e]);
        };
        bf16x8 pa[4];
        auto finishSM = [&](f32x16 (&pp)[2]) {
#pragma unroll
            for (int e = 0; e < 16; ++e) pp[1][e] = __builtin_amdgcn_exp2f(pp[1][e]);
            float ps = 0.f;
#pragma unroll
            for (int e = 0; e < 16; ++e) ps += pp[0][e] + pp[1][e];
            lsum += ps;
            pa[0] = pack8(pp[0][0], pp[0][1], pp[0][2], pp[0][3], pp[0][4], pp[0][5], pp[0][6], pp[0][7]);
            pa[1] = pack8(pp[0][8], pp[0][9], pp[0][10], pp[0][11], pp[0][12], pp[0][13], pp[0][14], pp[0][15]);
            pa[2] = pack8(pp[1][0], pp[1][1], pp[1][2], pp[1][3], pp[1][4], pp[1][5], pp[1][6], pp[1][7]);
            pa[3] = pack8(pp[1][8], pp[1][9], pp[1][10], pp[1][11], pp[1][12], pp[1][13], pp[1][14], pp[1][15]);
        };
        auto pv = [&](int buf) {
            LAS unsigned char* vb = lds + VBASE + buf * VBUF;
#pragma unroll
            for (int vt = 0; vt < 2; ++vt) {
                bf16x8 vf[4];
#pragma unroll
                for (int q = 0; q < 4; ++q) vf[q] = tr_perm(vb, VROW, 16 * q, 32 * vt, lane);
                __builtin_amdgcn_sched_barrier(0);
#pragma unroll
                for (int q = 0; q < 4; ++q) o[vt] = MFMA32(vf[q], pa[q], o[vt]);
            }
        };
        auto step = [&](int j, f32x16 (&pc)[2], f32x16 (&pn)[2], bool bar) {
            const int jk = j + 3 < nkt ? j + 3 : nkt - 1, jv = j + 2 < nkt ? j + 2 : nkt - 1;
            __builtin_amdgcn_sched_barrier(0);
            qk((j + 1) & 3, pn);
            finishSM(pc);
            __builtin_amdgcn_sched_barrier(0);
            loadK(jk); loadV(jv);
            __builtin_amdgcn_sched_barrier(0);
            pv(j & 3);
            partialSM(pn);
            __builtin_amdgcn_sched_barrier(0);
            storeK((j + 3) & 3); storeV((j + 2) & 3);
            if (bar) __syncthreads();
        };
        {
            u32x4 k0[2], k1[2], v0, v1;
            loadK(0); k0[0] = prk[0]; k0[1] = prk[1]; loadV(0); v0 = prv;
            loadK(1); k1[0] = prk[0]; k1[1] = prk[1]; loadV(1); v1 = prv;
            loadK(2); storeK(2);
            prk[0] = k0[0]; prk[1] = k0[1]; prv = v0; storeK(0); storeV(0);
            prk[0] = k1[0]; prk[1] = k1[1]; prv = v1; storeK(1); storeV(1);
        }
        __syncthreads();
        qk(0, pA); partialSM(pA);
        __syncthreads();
        for (int kt = 0; kt + 2 < nkt; kt += 2) {
            step(kt, pA, pB, false);
            step(kt + 1, pB, pA, true);
        }
        step(nkt - 2, pA, pB, true);
        finishSM(pB);
        pv((nkt - 1) & 3);
        __syncthreads();
        lsum += __shfl_xor(lsum, 32);
        const float inv = 1.f / lsum;
        bf16_t* op = MIX + (size_t)qrow * DM + h * 64;
#pragma unroll
        for (int vt = 0; vt < 2; ++vt)
#pragma unroll
            for (int g4 = 0; g4 < 4; ++g4) {
                const u32x2 pk = {pk2(o[vt][4 * g4] * inv, o[vt][4 * g4 + 1] * inv), pk2(o[vt][4 * g4 + 2] * inv, o[vt][4 * g4 + 3] * inv)};
                *(u32x2*)(op + 32 * vt + 8 * g4 + 4 * hh) = pk;
            }
    }
}

__device__ void phase_gla_prep(const Params& p, int j, unsigned char* ldsg) {
    unsigned char* ws = p.ws;
    const bf16_t* P = (const bf16_t*)(ws + OFF_BIG);
    bf16_t* QTF = (bf16_t*)(ws + OFF_QTF); bf16_t* KTF = (bf16_t*)(ws + OFF_KTF); bf16_t* QTB = (bf16_t*)(ws + OFF_QTB); bf16_t* KTB = (bf16_t*)(ws + OFF_KTB);
    float* DECF = (float*)(ws + OFF_DECF); float* DECB = (float*)(ws + OFF_DECB);
    float* zl = (float*)ldsg;
    float* seg = zl + 2048;
    const int tid = ltid();
    const float* wgf = p.in[20] + (size_t)j * 16 * 512; const float* wgb = p.in[22] + (size_t)j * 16 * 512;
    const float* bgf = p.in[21] + j * 512; const float* bgb = p.in[23] + j * 512;
    for (int item = blockIdx.x; item < 2080; item += gridDim.x) {
        const int ck = item >> 2, h = item & 3, r0 = ck * 64;
        { const int t = tid >> 3, j0 = (tid & 7) * 4; const u32x2 u = *(const u32x2*)(P + (size_t)(r0 + t) * LDPO + 1536 + j0);
          zl[t * 32 + j0] = bflo(u[0]); zl[t * 32 + j0 + 1] = bfhi(u[0]); zl[t * 32 + j0 + 2] = bflo(u[1]); zl[t * 32 + j0 + 3] = bfhi(u[1]); }
        __syncthreads();
        const int d = tid & 127, tq = tid >> 7, hd = h * 128 + d;
        float wf[16], wb[16];
#pragma unroll
        for (int q = 0; q < 16; ++q) { wf[q] = wgf[q * 512 + hd]; wb[q] = wgb[q * 512 + hd]; }
        const float bf_ = bgf[hd], bb_ = bgb[hd];
        float lf[16], lb[16];
#pragma unroll
        for (int i = 0; i < 16; ++i) {
            const float* zr = zl + (tq * 16 + i) * 32;
            float gf = bf_, gb = bb_;
#pragma unroll
            for (int q = 0; q < 16; ++q) { gf = fmaf(zr[q], wf[q], gf); gb = fmaf(zr[16 + q], wb[q], gb); }
            lf[i] = (fminf(gf, 0.f) - __logf(1.f + __expf(-fabsf(gf)))) * 0.0625f;
            lb[i] = (fminf(gb, 0.f) - __logf(1.f + __expf(-fabsf(gb)))) * 0.0625f;
        }
        float run = 0.f;
#pragma unroll
        for (int i = 0; i < 16; ++i) { run += lf[i]; lf[i] = run; }
        const float segF = run; run = 0.f;
#pragma unroll
        for (int i = 15; i >= 0; --i) { run += lb[i]; lb[i] = run; }
        const float segB = run;
        seg[tq * 128 + d] = segF; seg[512 + tq * 128 + d] = segB;
        __syncthreads();
        float offF = 0.f, totF = 0.f, offB = 0.f, totB = 0.f;
#pragma unroll
        for (int q = 0; q < 4; ++q) { const float a = seg[q * 128 + d], b2 = seg[512 + q * 128 + d]; totF += a; totB += b2; if (q < tq) offF += a; if (q > tq) offB += b2; }
#pragma unroll
        for (int i = 0; i < 16; ++i) {
            const size_t row = (size_t)(r0 + tq * 16 + i);
            const float q = bf2f(P[row * LDPO + 1568 + hd]) * 0.08838834764f, k = bf2f(P[row * LDPO + hd]);
            const float cf = lf[i] + offF, cb = lb[i] + offB;
            QTF[row * 512 + hd] = f2bf(q * __expf(cf)); KTF[row * 512 + hd] = f2bf(k * __expf(-cf));
            QTB[row * 512 + hd] = f2bf(q * __expf(cb)); KTB[row * 512 + hd] = f2bf(k * __expf(-cb));
        }
        if (tq == 0) { DECF[(size_t)(ck * 4 + h) * 128 + d] = __expf(totF); DECB[(size_t)(ck * 4 + h) * 128 + d] = __expf(totB); }
        __syncthreads();
    }
}

constexpr int NGRP = 32, NSLOT = NGRP + 1;
__device__ __forceinline__ int gstart(int g) { return g < 27 ? 8 * g : (g < 31 ? 216 + 9 * (g - 27) : 252); }
__device__ __forceinline__ int gsize(int g) { return g < 27 ? 8 : (g < 31 ? 9 : 4); }
constexpr int G_QOFF = 0, G_KOFF = 17408, G_VOFF = 34816, G_DOFF = 68608, G_BUF = 69120, G_SSQ = 2 * G_BUF;
template <bool OUT>
__device__ __forceinline__ void gla_seq(const Params& p, int j, LAS unsigned char* lds, int b, int h, int dir, bool ctx, int g, f32x16 (&S)[4], float* gdout) {
    unsigned char* ws = p.ws;
    const bf16_t* P = (const bf16_t*)(ws + OFF_BIG);
    const bf16_t* QT = (const bf16_t*)(ws + (dir ? OFF_QTB : OFF_QTF)); const bf16_t* KT = (const bf16_t*)(ws + (dir ? OFF_KTB : OFF_KTF));
    const float* DEC = (const float*)(ws + (dir ? OFF_DECB : OFF_DECF));
    bf16_t* MIX = (bf16_t*)(ws + OFF_MIX);
    const float* onorm = p.in[24] + j * 256;
    const int tid = ltid(), lane = tid & 63, w = tid >> 6, l32 = lane & 31, hh = lane >> 5;
    const int nsteps = ctx ? 4 : gsize(g), g0 = gstart(g);
    auto chunk_of = [&](int i) -> int { const int c = ctx ? (dir ? 3 - i : i) : (dir ? g0 + nsteps - 1 - i : g0 + i); return ctx ? 512 + b * 4 + c : b * 256 + c; };
    u32x4 pq[2], pk[2], pv[4], pd;
    auto gload = [&](int ck, int tid) {
        const size_t rb = (size_t)ck * 64;
#pragma unroll
        for (int pp = 0; pp < 2; ++pp) { const int c = tid + 512 * pp, row = c >> 4, cc = c & 15;
            if (OUT) pq[pp] = *(const u32x4*)(QT + (rb + row) * 512 + h * 128 + cc * 8);
            pk[pp] = *(const u32x4*)(KT + (rb + row) * 512 + h * 128 + cc * 8); }
#pragma unroll
        for (int pp = 0; pp < 4; ++pp) { const int c = tid + 512 * pp, row = c >> 5, cc = c & 31; pv[pp] = *(const u32x4*)(P + (rb + row) * LDPO + 512 + h * 256 + cc * 8); }
        if (tid < 32) pd = *(const u32x4*)(DEC + (size_t)(ck * 4 + h) * 128 + tid * 4);
    };
    auto lstore = [&](LAS unsigned char* bb, int tid) {
#pragma unroll
        for (int pp = 0; pp < 2; ++pp) { const int c = tid + 512 * pp, row = c >> 4, cc = c & 15;
            if (OUT) *(LAS u32x4*)(bb + G_QOFF + row * 272 + cc * 16) = pq[pp];
            *(LAS u32x4*)(bb + G_KOFF + row * 272 + cc * 16) = pk[pp]; }
#pragma unroll
        for (int pp = 0; pp < 4; ++pp) { const int c = tid + 512 * pp, row = c >> 5, cc = c & 31; *(LAS u32x4*)(bb + G_VOFF + row * 528 + cc * 16) = pv[pp]; }
        if (tid < 32) *(LAS u32x4*)(bb + G_DOFF + tid * 16) = pd;
    };
    float gd = 1.f;
    gload(chunk_of(0), tid); lstore(lds, tid);
    __syncthreads();
    for (int i = 0; i < nsteps; ++i) {
        const bool more = i + 1 < nsteps;
        const int ck = chunk_of(i);
        const int tid2 = ltid();
        if (more) gload(chunk_of(i + 1), tid2);
        LAS unsigned char* bb = lds + (i & 1) * G_BUF;
        LAS unsigned char* qb = bb + G_QOFF; LAS unsigned char* kb = bb + G_KOFF; LAS unsigned char* vb = bb + G_VOFF;
        const LAS float* dec = (const LAS float*)(bb + G_DOFF);
        if (!OUT) { if (tid < 128) gd *= dec[tid]; }
        if (OUT) {
            f32x16 o[2];
#pragma unroll
            for (int e = 0; e < 16; ++e) { o[0][e] = 0.f; o[1][e] = 0.f; }
#pragma unroll
            for (int st = 0; st < 2; ++st)
#pragma unroll
                for (int tt = 0; tt < 2; ++tt) {
                    if (dir ? (st == 0 && tt == 1) : (st == 1 && tt == 0)) continue;
                    f32x16 am;
#pragma unroll
                    for (int e = 0; e < 16; ++e) am[e] = 0.f;
#pragma unroll
                    for (int ks = 0; ks < 8; ++ks) {
                        const bf16x8 a = *(const LAS bf16x8*)(kb + (32 * st + l32) * 272 + (16 * ks + 8 * hh) * 2);
                        const bf16x8 bq = *(const LAS bf16x8*)(qb + (32 * tt + l32) * 272 + (16 * ks + 8 * hh) * 2);
                        am = MFMA32(a, bq, am);
                    }
                    const int t = 32 * tt + l32;
#pragma unroll
                    for (int e = 0; e < 16; ++e) { const int s = 32 * st + (e >> 2) * 8 + 4 * hh + (e & 3); const bool keep = dir ? (t <= s) : (t >= s); am[e] = keep ? am[e] : 0.f; }
                    const bf16x8 pm0 = pack8(am[0], am[1], am[2], am[3], am[4], am[5], am[6], am[7]);
                    const bf16x8 pm1 = pack8(am[8], am[9], am[10], am[11], am[12], am[13], am[14], am[15]);
                    const bf16x8 a0 = tr_perm(vb, 528, 32 * st, 32 * w, lane);
                    o[tt] = MFMA32(a0, pm0, o[tt]);
                    const bf16x8 a1 = tr_perm(vb, 528, 32 * st + 16, 32 * w, lane);
                    o[tt] = MFMA32(a1, pm1, o[tt]);
                    __builtin_amdgcn_sched_barrier(0);
                }
#pragma unroll
            for (int dt = 0; dt < 4; ++dt)
#pragma unroll
                for (int ks2 = 0; ks2 < 2; ++ks2) {
                    const bf16x8 a = pack8(S[dt][8 * ks2], S[dt][8 * ks2 + 1], S[dt][8 * ks2 + 2], S[dt][8 * ks2 + 3], S[dt][8 * ks2 + 4], S[dt][8 * ks2 + 5], S[dt][8 * ks2 + 6], S[dt][8 * ks2 + 7]);
#pragma unroll
                    for (int tt = 0; tt < 2; ++tt) {
                        LAS unsigned char* qa = qb + (32 * tt + l32) * 272 + (32 * dt + 16 * ks2 + 4 * hh) * 2;
                        const bf16x4 x = *(const LAS bf16x4*)qa, y = *(const LAS bf16x4*)(qa + 16);
                        const bf16x8 bq = __builtin_shufflevector(x, y, 0, 1, 2, 3, 4, 5, 6, 7);
                        o[tt] = MFMA32(a, bq, o[tt]);
                    }
                    __builtin_amdgcn_sched_barrier(0);
                }
            {
                LAS unsigned char* stg = lds + ((i + 1) & 1) * G_BUF + G_VOFF;
#pragma unroll
                for (int tt = 0; tt < 2; ++tt)
#pragma unroll
                    for (int g4 = 0; g4 < 4; ++g4) {
                        const u32x2 pkv = {pk2(o[tt][4 * g4], o[tt][4 * g4 + 1]), pk2(o[tt][4 * g4 + 2], o[tt][4 * g4 + 3])};
                        *(LAS u32x2*)(stg + (32 * tt + l32) * 528 + (32 * w + 8 * g4 + 4 * hh) * 2) = pkv;
                    }
                __syncthreads();
                const size_t rbase = (size_t)ck * 64;
                const int tq = tid2 >> 5, cc = tid2 & 31;
                if (dir == 0) {
#pragma unroll
                    for (int pp = 0; pp < 4; ++pp) {
                        const int t = tq + 16 * pp;
                        *(u32x4*)(MIX + (rbase + t) * DM + h * 256 + cc * 8) = *(const LAS u32x4*)(stg + t * 528 + cc * 16);
                    }
                } else {
                    u32x4 of[4], rg[4];
#pragma unroll
                    for (int pp = 0; pp < 4; ++pp) {
                        const int t = tq + 16 * pp;
                        of[pp] = *(const u32x4*)(MIX + (rbase + t) * DM + h * 256 + cc * 8);
                        rg[pp] = *(const u32x4*)(P + (rbase + t) * LDPO + 2080 + h * 256 + cc * 8);
                    }
                    const f32x4 gn0 = *(const f32x4*)(onorm + cc * 8), gn1 = *(const f32x4*)(onorm + cc * 8 + 4);
#pragma unroll
                    for (int pp = 0; pp < 4; ++pp) {
                        const int t = tq + 16 * pp;
                        const u32x4 ob = *(const LAS u32x4*)(stg + t * 528 + cc * 16);
                        float v[8]; float ss = 0.f;
#pragma unroll
                        for (int e = 0; e < 4; ++e) { v[2 * e] = bflo(ob[e]) + bflo(of[pp][e]); v[2 * e + 1] = bfhi(ob[e]) + bfhi(of[pp][e]); ss += v[2 * e] * v[2 * e] + v[2 * e + 1] * v[2 * e + 1]; }
#pragma unroll
                        for (int o2 = 16; o2 >= 1; o2 >>= 1) ss += __shfl_xor(ss, o2);
                        const float rstd = rsqrtf(ss * (1.f / 256.f) + 1e-6f);
                        u32x4 ov;
#pragma unroll
                        for (int e = 0; e < 4; ++e) {
                            const float g0 = e < 2 ? gn0[2 * e] : gn1[2 * e - 4], g1 = e < 2 ? gn0[2 * e + 1] : gn1[2 * e - 3];
                            ov[e] = pk2(v[2 * e] * rstd * g0 * silu_f(bflo(rg[pp][e])), v[2 * e + 1] * rstd * g1 * silu_f(bfhi(rg[pp][e])));
                        }
                        *(u32x4*)(MIX + (rbase + t) * DM + h * 256 + cc * 8) = ov;
                    }
                }
            }
        }
        if (OUT) { __builtin_amdgcn_sched_barrier(0); }
#pragma unroll
        for (int ks = 0; ks < 4; ++ks) {
            const bf16x8 bv = tr_nat(vb, 528, 16 * ks, 32 * w, lane);
#pragma unroll
            for (int dt = 0; dt < 4; ++dt) { const bf16x8 a = tr_nat(kb, 272, 16 * ks, 32 * dt, lane); S[dt] = MFMA32(a, bv, S[dt]); }
        }
#pragma unroll
        for (int dt = 0; dt < 4; ++dt)
#pragma unroll
            for (int g4 = 0; g4 < 4; ++g4) { const f32x4 dv = *(const LAS f32x4*)(dec + 32 * dt + 8 * g4 + 4 * hh);
#pragma unroll
                for (int e = 0; e < 4; ++e) S[dt][4 * g4 + e] *= dv[e]; }
        if (OUT) __syncthreads();
        if (more) lstore(lds + ((i + 1) & 1) * G_BUF, tid2);
        __syncthreads();
    }
    if (!OUT) { if (tid < 128) gdout[tid] = gd; }
}
__device__ __forceinline__ void s_zero(f32x16 (&S)[4]) {
#pragma unroll
    for (int dt = 0; dt < 4; ++dt)
#pragma unroll
        for (int e = 0; e < 16; ++e) S[dt][e] = 0.f;
}
__device__ __forceinline__ void s_store(const f32x16 (&S)[4], bf16_t* slot) {
    const int lane = ltid() & 63, w = ltid() >> 6, l32 = lane & 31, hh = lane >> 5;
#pragma unroll
    for (int dt = 0; dt < 4; ++dt)
#pragma unroll
        for (int e = 0; e < 16; ++e) slot[(32 * dt + (e >> 2) * 8 + 4 * hh + (e & 3)) * 256 + 32 * w + l32] = f2bf(S[dt][e]);
}
__device__ __forceinline__ void s_load(f32x16 (&S)[4], const bf16_t* slot) {
    const int lane = ltid() & 63, w = ltid() >> 6, l32 = lane & 31, hh = lane >> 5;
#pragma unroll
    for (int dt = 0; dt < 4; ++dt)
#pragma unroll
        for (int e = 0; e < 16; ++e) S[dt][e] = bf2f(slot[(32 * dt + (e >> 2) * 8 + 4 * hh + (e & 3)) * 256 + 32 * w + l32]);
}
__device__ void phase_gla_a(const Params& p, int j, unsigned char* ldsg) {
    bf16_t* SLOC = (bf16_t*)(p.ws + OFF_SLOC); float* GD = (float*)(p.ws + OFF_GD);
    for (int item = blockIdx.x; item < 16 * NSLOT; item += gridDim.x) {
        const int combo = item < 16 * NGRP ? item / NGRP : item - 16 * NGRP, g = item < 16 * NGRP ? item % NGRP : NGRP;
        const int dir = combo & 1, h = (combo >> 1) & 3, b = combo >> 3, slot = combo * NSLOT + g;
        f32x16 S[4]; s_zero(S);
        gla_seq<false>(p, j, (LAS unsigned char*)ldsg, b, h, dir, g == NGRP, g, S, GD + (size_t)slot * 128);
        s_store(S, SLOC + (size_t)slot * 32768);
    }
}
__device__ void phase_gla_b(const Params& p) {
    bf16_t* SLOC = (bf16_t*)(p.ws + OFF_SLOC); const float* GD = (const float*)(p.ws + OFF_GD);
    for (int e = blockIdx.x * 512 + ltid(); e < 16 * 32768; e += gridDim.x * 512) {
        const int combo = e >> 15, dv = e & 32767, d = dv >> 8, dir = combo & 1, base = combo * NSLOT;
        float S = bf2f(SLOC[(size_t)(base + NGRP) * 32768 + dv]);
        bf16_t tl[NGRP]; float gl[NGRP];
#pragma unroll
        for (int q = 0; q < NGRP; ++q) { const int g = dir ? NGRP - 1 - q : q; tl[q] = SLOC[(size_t)(base + g) * 32768 + dv]; gl[q] = GD[(base + g) * 128 + d]; }
#pragma unroll
        for (int q = 0; q < NGRP; ++q) {
            const int g = dir ? NGRP - 1 - q : q;
            SLOC[(size_t)(base + g) * 32768 + dv] = f2bf(S); S = gl[q] * S + bf2f(tl[q]);
        }
    }
}
__device__ void phase_gla_c(const Params& p, int j, unsigned char* ldsg) {
    const bf16_t* SLOC = (const bf16_t*)(p.ws + OFF_SLOC);
    for (int item = blockIdx.x; item < 8 * NSLOT; item += gridDim.x) {
        const int bh = item < 8 * NGRP ? (item & 7) : item - 8 * NGRP, g = item < 8 * NGRP ? NGRP - 1 - (item >> 3) : NGRP;
        const int h = bh & 3, b = bh >> 2;
        f32x16 S[4];
        for (int dir = 0; dir < 2; ++dir) {
            if (g == NGRP) s_zero(S); else s_load(S, SLOC + (size_t)((bh * 2 + dir) * NSLOT + g) * 32768);
            gla_seq<true>(p, j, (LAS unsigned char*)ldsg, b, h, dir, g == NGRP, g, S, nullptr);
        }
    }
}

#define XB_TMO      128
#define XB_XCNT(j)  (256  + 64 * (j))
#define XB_XSUB(j)  (1280 + 64 * (j))
#define XB_XGEN(j)  (2304 + 64 * (j))
#define XB_TOP      3328
#define XB_TOPGEN   3392
#define XCD_BAR_WORDS 3456
#define XB_SPIN_CAP (1u << 18)
__device__ __forceinline__ unsigned xb_ld(unsigned* p)              { return __hip_atomic_load(p, __ATOMIC_RELAXED, __HIP_MEMORY_SCOPE_AGENT); }
__device__ __forceinline__ unsigned xb_add(unsigned* p, unsigned v) { return __hip_atomic_fetch_add(p, v, __ATOMIC_RELAXED, __HIP_MEMORY_SCOPE_AGENT); }
__device__ __forceinline__ unsigned xb_xcc_id() { return (unsigned)__builtin_amdgcn_s_getreg((3 << 11) | 20) & 0xFu; }
#define XB_SPIN(cond, bar) do { unsigned _sp = 0; while (cond) { __builtin_amdgcn_s_sleep(1); \
    if ((++_sp & 255u) == 0u) { if (xb_ld(&(bar)[XB_TMO])) break; if (_sp > XB_SPIN_CAP) { atomicAdd(&(bar)[XB_TMO], 1u); break; } } } } while (0)
struct XcdBarrier { unsigned* bar; unsigned x; volatile LAS unsigned* st; };
__device__ __forceinline__ XcdBarrier xcd_barrier_post(unsigned* bar, volatile LAS unsigned* st) {
    XcdBarrier b; b.bar = bar; b.x = xb_xcc_id(); b.st = st;
    if (threadIdx.x == 0) (void)xb_add(&bar[XB_XCNT(b.x)], 1u);
    return b;
}
__device__ __forceinline__ void xcd_barrier_complete(unsigned* bar, unsigned x, unsigned& nloc, unsigned& nx) {
    const unsigned G = gridDim.x * gridDim.y * gridDim.z;
    unsigned sum, cnt, mine, sp = 0u;
    for (;;) {
        sum = 0u; cnt = 0u; mine = 0u;
#pragma unroll
        for (unsigned j = 0; j < 16; ++j) { const unsigned c = xb_ld(&bar[XB_XCNT(j)]); sum += c; cnt += (c > 0u) ? 1u : 0u; mine = (j == x) ? c : mine; }
        if (sum == G) break;
        __builtin_amdgcn_s_sleep(1);
        if ((++sp & 255u) == 0u) { if (xb_ld(&bar[XB_TMO])) break; if (sp > XB_SPIN_CAP) { atomicAdd(&bar[XB_TMO], 1u); break; } }
    }
    nloc = mine > 0u ? mine : 1u; nx = cnt > 0u ? cnt : 1u;
}
__device__ __forceinline__ void xcd_barrier(const XcdBarrier& b) {
    asm volatile("s_waitcnt vmcnt(0)" ::: "memory");
    __syncthreads();
    if (threadIdx.x == 0) {
        unsigned* bar = b.bar;
        __builtin_amdgcn_s_waitcnt(0);
        unsigned nloc = b.st[0], nx = b.st[1];
        if (nloc == 0u) { xcd_barrier_complete(bar, b.x, nloc, nx); b.st[0] = nloc; b.st[1] = nx; }
        const unsigned old = xb_add(&bar[XB_XSUB(b.x)], 1u);
        const unsigned gen = old / nloc;
        if (old + 1u == (gen + 1u) * nloc) {
            __builtin_amdgcn_fence(__ATOMIC_RELEASE, "agent");
            asm volatile("s_waitcnt vmcnt(0)" ::: "memory");
            const unsigned og = xb_add(&bar[XB_TOP], 1u);
            const unsigned tg = og / nx;
            if (og + 1u == (tg + 1u) * nx) xb_add(&bar[XB_TOPGEN], 1u);
            else XB_SPIN(xb_ld(&bar[XB_TOPGEN]) == tg, bar);
            __builtin_amdgcn_fence(__ATOMIC_ACQUIRE, "agent");
            xb_add(&bar[XB_XGEN(b.x)], 1u);
            asm volatile("s_waitcnt vmcnt(0)" ::: "memory");
        } else {
            XB_SPIN(xb_ld(&bar[XB_XGEN(b.x)]) == gen, bar);
            __builtin_amdgcn_fence(__ATOMIC_ACQUIRE, "agent");
            asm volatile("s_waitcnt vmcnt(0)" ::: "memory");
        }
    }
    __syncthreads();
}
#ifndef PROBE_REP
#define PROBE_REP 0
#endif
#ifndef PHM
#define PHM 0xFFFF
#endif
#define PH(b) if (PHM & (1 << (b)))
enum { K_N1 = 0, K_GIN, K_PREP, K_GQ, K_GKV, K_ATT, K_GPREP, K_GA, K_GB, K_GC, K_GOUT, K_N2, K_GUP, K_GDN, K_COPY, K_NONE, K_KMAX };
__global__ void __launch_bounds__(512, 2) mega(Params p) {
    extern __shared__ __attribute__((aligned(16))) unsigned char ldsg[];
    LAS unsigned char* lds = (LAS unsigned char*)ldsg;
    cg::grid_group grid = cg::this_grid();
    unsigned char* ws = p.ws;
    float* MOD = (float*)(ws + OFF_MOD);
    float* XC = (float*)(ws + OFF_XC);
    bf16_t* H = (bf16_t*)(ws + OFF_H); bf16_t* MIX = (bf16_t*)(ws + OFF_MIX);
    bf16_t* PB = (bf16_t*)(ws + OFF_BIG);
    const bool en_even = p.flags & 1, en_odd = p.flags & 2, en_mlp = p.flags & 4;

    volatile LAS unsigned* xst = (volatile LAS unsigned*)(lds + LDS_BYTES - 16);
    if (threadIdx.x == 0) { xst[0] = 0u; xst[1] = 0u; }
    __syncthreads();
    const XcdBarrier xbar = xcd_barrier_post((unsigned*)(ws + OFF_BAR), xst);
    PH(0) phase_ada(p, ldsg);
    PH(1) phase_weights(p, 0, ldsg);
    grid.sync();
    for (int step = 0; step < 44; ++step) {
        const int i = step / 11, s = step % 11, j = i >> 1; const bool even = !(i & 1);
        const float* mod = MOD + (size_t)i * 3 * 6144;
        const bool en_mix = even ? en_even : en_odd;
        const bool first = (i == 0) && (s <= 7);
        const float* xl = first ? p.in[0] : p.out; const float* xc = ((i == 0) && (s <= 8)) ? p.in[2] : XC;
        float* PART = (float*)(ws + OFF_PART);
        int kind;
        switch (s) {
            case 0: kind = K_N1; break;
            case 1: kind = K_GIN; break;
            case 2: kind = even ? K_PREP : K_GPREP; break;
            case 3: kind = even ? K_GQ : K_GA; break;
            case 4: kind = even ? K_GKV : K_GB; break;
            case 5: kind = even ? K_KMAX : K_GC; break;
            case 6: kind = even ? K_ATT : K_NONE; break;
            case 7: kind = K_GOUT; break;
            case 8: kind = K_N2; break;
            case 9: kind = K_GUP; break;
            default: kind = K_GDN; break;
        }
        if (s <= 7 && !en_mix) kind = (s == 0) ? K_NONE : ((i == 0 && s == 7) ? K_COPY : K_NONE);
        if (s >= 8 && !en_mlp) kind = K_NONE;
        if (s == 0 && i > 0) { PH(1) phase_weights(p, i, ldsg); }
        if (kind == K_NONE) { if (s == 0) xcd_barrier(xbar); continue; }
        bool gemmB = false, gemmR = false, nosync = false;
        pg8::EpiB EB; EB.O = PB; EB.ldo = 0; EB.rs = nullptr; EB.mode = 0;
        pg8::EpiR ER; ER.xin_l = xl; ER.xin_c = xc; ER.xout_l = p.out; ER.xout_c = XC; ER.gate = mod;
        const bf16_t* gA = H; const bf16_t* gB = (const bf16_t*)(ws + OFF_WIN); int lda = 1024, ldb = 1024, gN = 1024, gK = 1024, gM = R, nP = 0, Kp = 256;
        const int reps = ((p.flags >> (8 + kind)) & 1) ? 2 : 1;
        for (int rep = 0; rep < reps; ++rep) {
        if (rep) __syncthreads();
        switch (kind) {
            case K_N1: PH(2) phase_norm(xl, xc, p.in[6] + i * 1024, mod, 0, 1, H, R, i > 0 ? PART : nullptr, 8, mod - 3 * 6144 + 2 * 6144 + 5 * 1024, XC); break;
            case K_N2: PH(2) phase_norm(xl, xc, p.in[7] + i * 1024, mod, 3, 4, H, i < 3 ? R : RL, PART, 4, mod + 2 * 6144 + 2 * 1024, XC); break;
            case K_GIN: gemmB = true; gN = even ? 1792 : 3328; EB.ldo = gN; break;
            case K_PREP: PH(4) phase_even_prep(p, j, ldsg); break;
            case K_GQ: gemmB = true; nosync = true; gA = PB; lda = LDPE; gB = (const bf16_t*)(ws + OFF_WUQ); ldb = 384; gN = 768; gK = 384; EB.O = (bf16_t*)(ws + OFF_Q); EB.ldo = 768; EB.rs = (const float*)(ws + OFF_RSQ); break;
            case K_GKV: gemmB = true; gA = PB + 384; lda = LDPE; gB = (const bf16_t*)(ws + OFF_WUKV); ldb = 256; gN = 1024; gK = 256; EB.O = (bf16_t*)(ws + OFF_KV); EB.ldo = 1024; EB.rs = (const float*)(ws + OFF_RSKV); break;
            case K_KMAX: PH(4) phase_kmax(p, ldsg); break;
            case K_ATT: PH(5) phase_attn(p, ldsg); break;
            case K_GPREP: PH(6) phase_gla_prep(p, j, ldsg); break;
            case K_GA: PH(7) phase_gla_a(p, j, ldsg); break;
            case K_GB: PH(8) phase_gla_b(p); break;
            case K_GC: PH(9) phase_gla_c(p, j, ldsg); break;
            case K_GOUT: gemmR = true; gA = MIX; gB = (const bf16_t*)(ws + OFF_WOUT); ER.gate = mod + 2 * 1024; gM = RL; nP = i < 3 ? 4 : 0; Kp = 256; break;
            case K_GUP: gemmB = true; gB = (const bf16_t*)(ws + OFF_W1); gN = 4096; EB.ldo = 4096; EB.mode = 1; gM = i < 3 ? R : RL; break;
            case K_GDN: gemmR = true; gA = PB; lda = 4096; gB = (const bf16_t*)(ws + OFF_W2); ldb = 4096; gK = 4096; ER.gate = mod + 5 * 1024; gM = RL; nP = i < 3 ? 8 : 0; Kp = 512; break;
            case K_COPY:
                for (size_t e = (size_t)blockIdx.x * 512 + ltid(); e < (size_t)R * 256; e += (size_t)gridDim.x * 512) {
                    const size_t row = e >> 8, c4 = (e & 255) * 4;
                    if (row < RL) *(f32x4*)(p.out + row * DM + c4) = *(const f32x4*)(xl + row * DM + c4);
                    else *(f32x4*)(XC + (row - RL) * DM + c4) = *(const f32x4*)(xc + (row - RL) * DM + c4);
                }
                break;
            default: break;
        }
        if (gemmB) { PH(3) run_gemm(lds, gA, lda, gB, ldb, gM, gN, gK, EB, kind == K_GKV); }
        if (gemmR) { PH(10) { run_gemm(lds, gA, lda, gB, ldb, gM, gN, gK, ER); if (nP) run_pieces(lds, gA + (size_t)RL * lda, lda, gB, ldb, nP, Kp, PART); } }
        }
        if (!nosync) xcd_barrier(xbar);
    }
    PH(11) phase_final(p.in[26], p.out);
}

extern "C" void kernel_launch(void* const* d_in, const int* in_sizes, int n_in, void* d_out, int out_size, void* d_ws, size_t ws_size, hipStream_t stream) {
    static int grid = 0;
    if (grid == 0) {
        if (n_in != 27 || ws_size < WS_NEED) { fprintf(stderr, "kernel_launch: unexpected n_in %d / ws %zu\n", n_in, ws_size); grid = -1; return; }
        int dev = 0, cus = 0, per_cu = 0;
        hipGetDevice(&dev);
        hipDeviceGetAttribute(&cus, hipDeviceAttributeMultiprocessorCount, dev);
        hipFuncSetAttribute((const void*)mega, hipFuncAttributeMaxDynamicSharedMemorySize, LDS_BYTES);
        hipOccupancyMaxActiveBlocksPerMultiprocessor(&per_cu, (const void*)mega, 512, LDS_BYTES);
        (void)hipGetLastError();
        if (per_cu < 1) fprintf(stderr, "kernel_launch: occupancy query reports %d blocks per CU\n", per_cu);
        grid = cus > 0 ? cus : 256;
    }
    if (grid < 0) return;
    if (hipMemsetAsync((char*)d_ws + OFF_BAR, 0, 16384, stream) != hipSuccess) { fprintf(stderr, "kernel_launch: memset failed\n"); return; }
    Params p{};
    for (int i = 0; i < 27; ++i) p.in[i] = (const float*)d_in[i];
    p.out = (float*)d_out; p.ws = (unsigned char*)d_ws; p.flags = 7 | PROBE_REP;
    void* args[] = {&p};
    hipError_t e = hipLaunchCooperativeKernel((const void*)mega, dim3(grid), dim3(512), args, LDS_BYTES, stream);
    if (e != hipSuccess) fprintf(stderr, "cooperative launch failed: %s (grid %d)\n", hipGetErrorString(e), grid);
}
```
